# Optimizing an MI355X kernel written in HIP

```python
import math
import functools
import numpy as np
import jax
import jax.numpy as jnp
from jax import lax

D_MODEL = 2048
BATCH = 2
SEQ = 4096
DEPTH = 2

GRID_W = 64
CTX_LEN = 256
EPS = 1e-6

D_MIX = D_MODEL
N_MIXERS = 4
GROUP_W = D_MIX // N_MIXERS
HEAD_DIM = 128

ATT_HEADS = GROUP_W // HEAD_DIM
ATT_KV_HEADS = 2
ROPE_THETA = 10000.0
Q_BLOCK = 128

NA_HEADS = GROUP_W // HEAD_DIM
NA_ROWS = 8
NA_COLS = 16

SGU_CHUNK = 128
SGU_GROUPS = 4
SGU_GROUP_W = GROUP_W // SGU_GROUPS

SSM_HEAD_DIM = 64
SSM_HEADS = GROUP_W // SSM_HEAD_DIM
SSM_GROUPS = 2
SSM_HPG = SSM_HEADS // SSM_GROUPS
SSM_STATE = 128
SSM_CHUNK = 128
CONV_K = 5
CONV_CH = GROUP_W + 2 * SSM_GROUPS * SSM_STATE

D_FF = 5632
N_EXPERTS = 8
TOP_K = 2
D_FF_EXPERT = 7168
MOE_BLOCK = 128
N_DENSE = (DEPTH + 1) // 2
N_MOE = DEPTH // 2

Q_SIDE = (ATT_HEADS * HEAD_DIM, NA_HEADS * HEAD_DIM, GROUP_W, GROUP_W, GROUP_W, SSM_GROUPS * SSM_STATE)
K_SIDE = (ATT_KV_HEADS * HEAD_DIM, ATT_KV_HEADS * HEAD_DIM, NA_HEADS * HEAD_DIM, NA_HEADS * HEAD_DIM,
          GROUP_W, SSM_GROUPS * SSM_STATE, 2 * SSM_HEADS)
Q_COLS = sum(Q_SIDE)
IN_COLS = Q_COLS + sum(K_SIDE)

kernel_name = 'hymba_style_diffusion_hybrid_trunk'


def rms_norm(x, g):
    xf = x.astype(jnp.float32)
    y = xf * lax.rsqrt(jnp.mean(xf * xf, axis=-1, keepdims=True) + EPS)
    return (y * g.astype(jnp.float32)).astype(x.dtype)


def split_cols(t, widths):
    cuts = [int(v) for v in np.cumsum(widths)[:-1]]
    return jnp.split(t, cuts, axis=-1)


def heads(t, n):
    return t.reshape(t.shape[:-1] + (n, t.shape[-1] // n))


def modulation(cond, w_mod, b_mod, n):
    m = jax.nn.silu(cond) @ w_mod[:, : n * D_MODEL] + b_mod[: n * D_MODEL]
    return jnp.split(m[..., None, :], n, axis=-1)


def axial_rope(n_tokens):
    t = jnp.arange(n_tokens)
    row = (t // GRID_W).astype(jnp.float32)
    col = (t % GRID_W).astype(jnp.float32)
    n_freq = HEAD_DIM // 4
    inv = jnp.power(ROPE_THETA, -jnp.arange(n_freq, dtype=jnp.float32) / n_freq)
    ang = jnp.concatenate([row[:, None] * inv, col[:, None] * inv], axis=-1)
    return jnp.cos(ang), jnp.sin(ang)


def apply_rope(x, cos, sin):
    xf = x.astype(jnp.float32).reshape(x.shape[:-1] + (HEAD_DIM // 2, 2))
    x0, x1 = xf[..., 0], xf[..., 1]
    cs, sn = cos[None, :, None, :], sin[None, :, None, :]
    out = jnp.stack([x0 * cs - x1 * sn, x0 * sn + x1 * cs], axis=-1)
    return out.reshape(x.shape).astype(x.dtype)


def gqa_block_attention(q, k, v):
    bsz, lq, g, r, dh = q.shape
    nb = lq // Q_BLOCK
    qb = jnp.moveaxis(q.reshape(bsz, nb, Q_BLOCK, g, r, dh), 1, 0)
    scale = dh ** -0.5

    def one_block(qi):
        s = jnp.einsum('bqgrd,bkgd->bgrqk', qi, k).astype(jnp.float32) * scale
        p = jax.nn.softmax(s, axis=-1).astype(v.dtype)
        return jnp.einsum('bgrqk,bkgd->bqgrd', p, v)

    o = lax.map(one_block, qb)
    return jnp.moveaxis(o, 0, 1).reshape(bsz, lq, g * r * dh)


def neighbourhood_attention(q, k, v, k_ctx, v_ctx, rpb):
    bsz, s_len, n_h, dh = q.shape
    rows = s_len // GRID_W
    kh = min(NA_ROWS, rows)
    n_cb = GRID_W // NA_COLS
    band = 2 * NA_COLS
    n_loc = kh * band
    scale = dh ** -0.5
    qcol = jnp.arange(GRID_W).reshape(n_cb, NA_COLS)
    win_c0 = jnp.clip(qcol - NA_COLS // 2, 0, GRID_W - NA_COLS)
    band_c0 = jnp.clip(jnp.arange(n_cb) * NA_COLS - NA_COLS // 2, 0, GRID_W - band)
    kcol = band_c0[:, None] + jnp.arange(band)
    col_ok = (kcol[:, None, :] >= win_c0[:, :, None]) & (kcol[:, None, :] < win_c0[:, :, None] + NA_COLS)
    mask = jnp.broadcast_to(col_ok[:, :, None, :], (n_cb, NA_COLS, kh, band)).reshape(n_cb, NA_COLS, n_loc)
    dcol = jnp.clip(kcol[:, None, :] - qcol[:, :, None], 1 - NA_COLS, NA_COLS - 1) + NA_COLS - 1
    rpb32 = rpb.astype(jnp.float32)
    q_rows = jnp.moveaxis(q.reshape(bsz, rows, GRID_W, n_h, dh), 1, 0)

    def one_row(args):
        r, q_r = args
        krow = jnp.clip(r - kh // 2, 0, rows - kh) + jnp.arange(kh)
        idx = (krow[None, :, None] * GRID_W + kcol[:, None, :]).reshape(n_cb, n_loc)
        kb = jnp.take(k, idx, axis=1)
        vb = jnp.take(v, idx, axis=1)
        drow = krow - r + NA_ROWS - 1
        bias = rpb32[:, drow[None, None, :, None], dcol[:, :, None, :]].reshape(n_h, n_cb, NA_COLS, n_loc)
        qb = q_r.reshape(bsz, n_cb, NA_COLS, n_h, dh)
        s_loc = jnp.einsum('bnqhd,bnkhd->bhnqk', qb, kb).astype(jnp.float32) * scale + bias
        s_loc = jnp.where(mask, s_loc, -1e30)
        s_ctx = jnp.einsum('bnqhd,bchd->bhnqc', qb, k_ctx).astype(jnp.float32) * scale
        p = jax.nn.softmax(jnp.concatenate([s_loc, s_ctx], axis=-1), axis=-1).astype(v.dtype)
        o = (jnp.einsum('bhnqk,bnkhd->bnqhd', p[..., :n_loc], vb)
             + jnp.einsum('bhnqc,bchd->bnqhd', p[..., n_loc:], v_ctx))
        return o.reshape(bsz, GRID_W, n_h, dh)

    o = lax.map(one_row, (jnp.arange(rows), q_rows))
    return jnp.moveaxis(o, 0, 1).reshape(bsz, s_len, n_h * dh)


def spatial_gating_unit(u, v, norm_g, w_s, b_s):
    bsz, length, _ = v.shape
    n = length // SGU_CHUNK
    vn = rms_norm(v, norm_g).reshape(bsz, n, SGU_CHUNK, SGU_GROUPS, SGU_GROUP_W)
    mixed = jnp.einsum('gij,bnjgc->bnigc', w_s, vn) + b_s.T[:, :, None]
    return u * mixed.reshape(bsz, length, GROUP_W)


def depthwise_conv(t, w, b):
    y = lax.conv_general_dilated(t, w[:, None, :].astype(t.dtype), window_strides=(1,),
                                 padding=[(CONV_K // 2, CONV_K // 2)],
                                 dimension_numbers=('NWC', 'WIO', 'NWC'),
                                 feature_group_count=t.shape[-1])
    return y + b


def ssm_inputs(dx, db, dc, ddt, conv_w, conv_b, dt_bias):
    parts = [dx, db] if dc is None else [dx, db, dc]
    xbc = jnp.concatenate(parts, axis=-1)
    n_ch = xbc.shape[-1]
    xbc = jax.nn.silu(depthwise_conv(xbc, conv_w[:, :n_ch], conv_b[:n_ch]))
    bsz, length = dx.shape[:2]
    bc_w = SSM_GROUPS * SSM_STATE
    xs = xbc[..., :GROUP_W].reshape(bsz, length, SSM_GROUPS, SSM_HPG, SSM_HEAD_DIM)
    bm = xbc[..., GROUP_W:GROUP_W + bc_w].reshape(bsz, length, SSM_GROUPS, SSM_STATE)
    cm = None if dc is None else xbc[..., GROUP_W + bc_w:].reshape(bsz, length, SSM_GROUPS, SSM_STATE)
    dt = jax.nn.softplus(ddt.astype(jnp.float32).reshape(bsz, length, 2, SSM_GROUPS, SSM_HPG)
                         + dt_bias.astype(jnp.float32).reshape(2, SSM_GROUPS, SSM_HPG))
    return xs, bm, cm, dt


def ssd_chunked(x, dt, a, bm, cm, h0):
    bsz, length, g, r, p = x.shape
    nc = length // SSM_CHUNK

    def chunks(t):
        return t.astype(jnp.float32).reshape((bsz, nc, SSM_CHUNK) + t.shape[2:])

    xc, dtc, bc, cc = chunks(x), chunks(dt), chunks(bm), chunks(cm)
    cum = jnp.cumsum(dtc * a, axis=2)
    xdt = xc * dtc[..., None]
    tri = jnp.tril(jnp.ones((SSM_CHUNK, SSM_CHUNK), dtype=bool))
    seg = jnp.where(tri[None, None, :, :, None, None], cum[:, :, :, None] - cum[:, :, None, :], -jnp.inf)
    scores = jnp.einsum('bcign,bcjgn->bcijg', cc, bc)
    y_diag = jnp.einsum('bcijg,bcijgr,bcjgrp->bcigrp', scores, jnp.exp(seg), xdt)
    decay_end = jnp.exp(cum[:, :, -1:] - cum)
    states = jnp.einsum('bcjgn,bcjgr,bcjgrp->bcgrpn', bc, decay_end, xdt)
    chunk_decay = jnp.exp(cum[:, :, -1])

    def carry_step(h, inp):
        s, dcy = inp
        return h * dcy[..., None, None] + s, h

    h_last, h_in = lax.scan(carry_step, h0.astype(jnp.float32),
                            (jnp.moveaxis(states, 1, 0), jnp.moveaxis(chunk_decay, 1, 0)))
    h_in = jnp.moveaxis(h_in, 0, 1)
    y_off = jnp.einsum('bcign,bcgrpn,bcigr->bcigrp', cc, h_in, jnp.exp(cum))
    return (y_diag + y_off).reshape(bsz, length, g, r, p), h_last


def ssd_final_state(x, dt, a, bm):
    dt = dt.astype(jnp.float32)
    cum = jnp.cumsum(dt * a, axis=1)
    w = jnp.exp(cum[:, -1:] - cum) * dt
    return jnp.einsum('blgn,blgr,blgrp->bgrpn', bm.astype(jnp.float32), w, x.astype(jnp.float32))


def orient(t, d):
    return jnp.flip(t, axis=1) if d == 1 else t


def bidirectional_ssd(lat, ctx, a_log, d_skip, ctx_out):
    x_l, b_l, c_l, dt_l = lat
    x_c, b_c, c_c, dt_c = ctx
    h0 = jnp.zeros((x_l.shape[0], SSM_GROUPS, SSM_HPG, SSM_HEAD_DIM, SSM_STATE), jnp.float32)
    y_l, y_c = 0.0, 0.0
    for d in range(2):
        a = -jnp.exp(a_log[d].astype(jnp.float32)).reshape(SSM_GROUPS, SSM_HPG)
        skip = d_skip[d].astype(jnp.float32).reshape(SSM_GROUPS, SSM_HPG, 1)
        if ctx_out:
            yc, h_c = ssd_chunked(orient(x_c, d), orient(dt_c[:, :, d], d), a, orient(b_c, d), orient(c_c, d), h0)
            y_c = y_c + orient(yc, d) + skip * x_c.astype(jnp.float32)
        else:
            h_c = ssd_final_state(orient(x_c, d), orient(dt_c[:, :, d], d), a, orient(b_c, d))
        yl, _ = ssd_chunked(orient(x_l, d), orient(dt_l[:, :, d], d), a, orient(b_l, d), orient(c_l, d), h_c)
        y_l = y_l + orient(yl, d) + skip * x_l.astype(jnp.float32)
    return y_l, (y_c if ctx_out else None)


def merge_groups(outs, out_norm, w_out):
    normed = [rms_norm(o, out_norm[g * GROUP_W:(g + 1) * GROUP_W]) for g, o in enumerate(outs)]
    return jnp.concatenate(normed, axis=-1) @ w_out


def swiglu(h, w13, w2):
    gate, up = jnp.split(h @ w13, 2, axis=-1)
    return (jax.nn.silu(gate) * up) @ w2


def moe_swiglu(h, router, w13, w2):
    lead = h.shape[:-1]
    t = h.reshape(-1, h.shape[-1])
    n_tok = t.shape[0]
    n_assign = n_tok * TOP_K
    n_blocks = -(-n_assign // MOE_BLOCK) + N_EXPERTS
    n_slots = n_blocks * MOE_BLOCK
    logits = (t @ router).astype(jnp.float32)
    top_v, top_e = lax.top_k(logits, TOP_K)
    top_w = jax.nn.softmax(top_v, axis=-1).reshape(-1)
    flat_e = top_e.reshape(-1)
    order = jnp.argsort(flat_e * n_assign + jnp.arange(n_assign))
    sorted_e = flat_e[order]
    counts = jnp.zeros((N_EXPERTS,), jnp.int32).at[flat_e].add(1)
    padded = (counts + MOE_BLOCK - 1) // MOE_BLOCK * MOE_BLOCK
    seg_start = jnp.cumsum(counts) - counts
    pad_end = jnp.cumsum(padded)
    dest = pad_end[sorted_e] - padded[sorted_e] + jnp.arange(n_assign) - seg_start[sorted_e]
    slot_tok = jnp.zeros((n_slots,), jnp.int32).at[dest].set(order // TOP_K)
    slot_w = jnp.zeros((n_slots,), jnp.float32).at[dest].set(top_w[order])
    block_e = jnp.minimum(jnp.searchsorted(pad_end, jnp.arange(n_blocks) * MOE_BLOCK, side='right'), N_EXPERTS - 1)
    xs = t[slot_tok].reshape(n_blocks, MOE_BLOCK, t.shape[-1])

    def expert_block(args):
        e, xb = args
        return swiglu(xb, w13[e], w2[e])

    ys = lax.map(expert_block, (block_e, xs)).reshape(n_slots, -1)
    out = jnp.zeros_like(t).at[slot_tok].add(ys * slot_w[:, None].astype(ys.dtype))
    return out.reshape(lead + (t.shape[-1],))


def hybrid_layer(x, xc, c, c_ctx, rope, ffn, ctx_out, w_mod, b_mod, norm_mix, norm_ffn, w_in, q_norm, k_norm,
                 rpb, sgu_norm, sgu_w, sgu_b, conv_w, conv_b, a_log, dt_bias, d_skip, out_norm, w_out):
    cos, sin = rope
    bsz, s_len, _ = x.shape
    rep = ATT_HEADS // ATT_KV_HEADS
    sh_l, sc_l, g_l, sh2_l, sc2_l, g2_l = modulation(c, w_mod, b_mod, 6)
    mod_c = modulation(c_ctx, w_mod, b_mod, 6 if ctx_out else 2)
    h_l = rms_norm(x, norm_mix) * (1 + sc_l) + sh_l
    h_c = rms_norm(xc, norm_mix) * (1 + mod_c[1]) + mod_c[0]

    (aq_l, bq_l, cu_l, cv_l, dz_l, dc_l, ak_l, av_l, bk_l, bv_l, dx_l, db_l, ddt_l) = split_cols(h_l @ w_in, Q_SIDE + K_SIDE)
    if ctx_out:
        (aq_c, bq_c, cu_c, cv_c, dz_c, dc_c, ak_c, av_c, bk_c, bv_c, dx_c, db_c, ddt_c) = split_cols(h_c @ w_in, Q_SIDE + K_SIDE)
    else:
        (ak_c, av_c, bk_c, bv_c, dx_c, db_c, ddt_c) = split_cols(h_c @ w_in[:, Q_COLS:], K_SIDE)
        dc_c = None

    qa_l = apply_rope(rms_norm(heads(aq_l, ATT_HEADS), q_norm), cos, sin)
    ka_l = apply_rope(rms_norm(heads(ak_l, ATT_KV_HEADS), k_norm), cos, sin)
    ka_c = rms_norm(heads(ak_c, ATT_KV_HEADS), k_norm)
    va_c = heads(av_c, ATT_KV_HEADS)
    o_a_l = gqa_block_attention(qa_l.reshape(bsz, s_len, ATT_KV_HEADS, rep, HEAD_DIM),
                                jnp.concatenate([ka_c, ka_l], axis=1),
                                jnp.concatenate([va_c, heads(av_l, ATT_KV_HEADS)], axis=1))

    kb_c, vb_c = heads(bk_c, NA_HEADS), heads(bv_c, NA_HEADS)
    o_b_l = neighbourhood_attention(heads(bq_l, NA_HEADS), heads(bk_l, NA_HEADS), heads(bv_l, NA_HEADS),
                                    kb_c, vb_c, rpb)

    o_c_l = spatial_gating_unit(jax.nn.gelu(cu_l), jax.nn.gelu(cv_l), sgu_norm, sgu_w, sgu_b)

    y_l, y_c = bidirectional_ssd(ssm_inputs(dx_l, db_l, dc_l, ddt_l, conv_w, conv_b, dt_bias),
                                 ssm_inputs(dx_c, db_c, dc_c, ddt_c, conv_w, conv_b, dt_bias),
                                 a_log, d_skip, ctx_out)
    o_d_l = y_l.reshape(bsz, s_len, GROUP_W).astype(x.dtype) * jax.nn.silu(dz_l)

    x = x + g_l * merge_groups((o_a_l, o_b_l, o_c_l, o_d_l), out_norm, w_out)
    x = x + g2_l * ffn(rms_norm(x, norm_ffn) * (1 + sc2_l) + sh2_l)
    if not ctx_out:
        return x, None

    n_ctx = xc.shape[1]
    o_a_c = gqa_block_attention(rms_norm(heads(aq_c, ATT_HEADS), q_norm).reshape(bsz, n_ctx, ATT_KV_HEADS, rep, HEAD_DIM),
                                ka_c, va_c)
    o_b_c = gqa_block_attention(heads(bq_c, NA_HEADS)[:, :, :, None, :], kb_c, vb_c)
    o_c_c = spatial_gating_unit(jax.nn.gelu(cu_c), jax.nn.gelu(cv_c), sgu_norm, sgu_w, sgu_b)
    o_d_c = y_c.reshape(bsz, n_ctx, GROUP_W).astype(xc.dtype) * jax.nn.silu(dz_c)
    xc = xc + mod_c[2] * merge_groups((o_a_c, o_b_c, o_c_c, o_d_c), out_norm, w_out)
    xc = xc + mod_c[5] * ffn(rms_norm(xc, norm_ffn) * (1 + mod_c[4]) + mod_c[3])
    return x, xc


def setup_inputs(seed: int = 0) -> dict:
    key = jax.random.key(seed)
    ks = jax.random.split(key, 28)
    d = D_MODEL
    f32 = jnp.float32

    def normal(k, shape, scale):
        return scale * jax.random.normal(k, shape, f32)

    def gain(k, shape):
        return 1.0 + 0.05 * jax.random.normal(k, shape, f32)

    dt0 = jnp.exp(jax.random.uniform(ks[17], (DEPTH, 2, SSM_HEADS), f32, math.log(1e-3), math.log(1e-1)))
    return {
        'x': normal(ks[0], (BATCH, SEQ, d), 1.0),
        'c': normal(ks[1], (BATCH, d), 1.0),
        'ctx': normal(ks[2], (BATCH, CTX_LEN, d), 1.0),
        'c_ctx': normal(ks[3], (d,), 1.0),
        'w_mod': normal(ks[4], (DEPTH, d, 6 * d), 0.5 * d ** -0.5),
        'b_mod': normal(ks[5], (DEPTH, 6 * d), 0.02),
        'norm_mix': gain(ks[6], (DEPTH, d)),
        'norm_ffn': gain(ks[7], (DEPTH, d)),
        'w_in': normal(ks[8], (DEPTH, d, IN_COLS), d ** -0.5),
        'q_norm': gain(ks[9], (DEPTH, HEAD_DIM)),
        'k_norm': gain(ks[10], (DEPTH, HEAD_DIM)),
        'rpb': normal(ks[11], (DEPTH, NA_HEADS, 2 * NA_ROWS - 1, 2 * NA_COLS - 1), 0.1),
        'sgu_norm': gain(ks[12], (DEPTH, GROUP_W)),
        'sgu_w': normal(ks[13], (DEPTH, SGU_GROUPS, SGU_CHUNK, SGU_CHUNK), SGU_CHUNK ** -0.5),
        'sgu_b': 1.0 + normal(ks[14], (DEPTH, SGU_GROUPS, SGU_CHUNK), 0.1),
        'conv_w': normal(ks[15], (DEPTH, CONV_K, CONV_CH), CONV_K ** -0.5),
        'conv_b': normal(ks[16], (DEPTH, CONV_CH), 0.02),
        'a_log': jnp.log(jax.random.uniform(ks[18], (DEPTH, 2, SSM_HEADS), f32, 1.0, 16.0)),
        'dt_bias': dt0 + jnp.log(-jnp.expm1(-dt0)),
        'd_skip': gain(ks[19], (DEPTH, 2, SSM_HEADS)),
        'out_norm': gain(ks[20], (DEPTH, D_MIX)),
        'w_out': normal(ks[21], (DEPTH, D_MIX, d), D_MIX ** -0.5),
        'ffn_w13': normal(ks[22], (N_DENSE, d, 2 * D_FF), d ** -0.5),
        'ffn_w2': normal(ks[23], (N_DENSE, D_FF, d), D_FF ** -0.5),
        'router': normal(ks[24], (N_MOE, d, N_EXPERTS), d ** -0.5),
        'moe_w13': normal(ks[25], (N_MOE, N_EXPERTS, d, 2 * D_FF_EXPERT), d ** -0.5),
        'moe_w2': normal(ks[26], (N_MOE, N_EXPERTS, D_FF_EXPERT, d), D_FF_EXPERT ** -0.5),
        'final_norm': gain(ks[27], (d,)),
    }


def reference(x, c, ctx, c_ctx, w_mod, b_mod, norm_mix, norm_ffn, w_in, q_norm, k_norm, rpb, sgu_norm, sgu_w,
              sgu_b, conv_w, conv_b, a_log, dt_bias, d_skip, out_norm, w_out, ffn_w13, ffn_w2, router, moe_w13,
              moe_w2, final_norm):
    rope = axial_rope(x.shape[1])
    xc = ctx
    for i in range(DEPTH):
        if i % 2 == 0:
            ffn = functools.partial(swiglu, w13=ffn_w13[i // 2], w2=ffn_w2[i // 2])
        else:
            ffn = functools.partial(moe_swiglu, router=router[i // 2], w13=moe_w13[i // 2], w2=moe_w2[i // 2])
        x, xc = hybrid_layer(x, xc, c, c_ctx, rope, ffn, i < DEPTH - 1, w_mod[i], b_mod[i], norm_mix[i],
                             norm_ffn[i], w_in[i], q_norm[i], k_norm[i], rpb[i], sgu_norm[i], sgu_w[i], sgu_b[i],
                             conv_w[i], conv_b[i], a_log[i], dt_bias[i], d_skip[i], out_norm[i], w_out[i])
    return rms_norm(x, final_norm)
```

```cpp
#include <hip/hip_runtime.h>
#include <hip/hip_bf16.h>
#include <cstdio>
#include <cstdint>
#include <cmath>

namespace pg8 {
#define PG8_LAS __attribute__((address_space(3)))
typedef unsigned short bf16_t;
typedef short bf16x8 __attribute__((ext_vector_type(8)));
typedef float f32x4 __attribute__((ext_vector_type(4)));
typedef unsigned u32x4 __attribute__((ext_vector_type(4)));
constexpr int BM = 256, BK = 64, HALF = 128, HTB = HALF * BK * 2  , STAGE_BYTES = 8 * HTB, NXCD = 8, WGM = 8;

__host__ __device__ __forceinline__ int lds_byte(int r, int c) { const int st = (r >> 4) * 2 + (c >> 5), rr = r & 15, cc = c & 31, ob = rr * 64 + cc * 2; return st * 1024 + (ob ^ (((ob >> 9) & 1) << 5)); }
__host__ __device__ __forceinline__ void stage_rc(int b, int& R, int& C) { const int st = b / 1024, sb = b % 1024, swz = sb ^ (((sb >> 9) & 1) << 5); R = (st >> 1) * 16 + swz / 64; C = (st & 1) * 32 + (swz % 64) / 2; }
__host__ __device__ __forceinline__ int perm32(int rho) { const int n = rho >> 4, i = rho & 15; return 8 * (i >> 2) + 4 * n + (i & 3); }

struct Unit { int pm, pn, pb; };
struct Gemm { const bf16_t* A; const bf16_t* Bt; int M, N, K; };

struct StaticOrder {
    int nM, nN, nwg, G, c;
    __host__ __device__ void init(int M, int N, int G_, int c_) { nM = M / BM; nN = N / BM; nwg = nM * nN; G = G_; c = c_; }
    __host__ __device__ bool next(int i, Unit& u) const {
        const long L = (long)i * G + c; if (L >= nwg) return false;
        int wgid = (int)L; { const int q = nwg / NXCD, r = nwg % NXCD, xcd = wgid % NXCD, off = wgid / NXCD; wgid = (xcd < r ? xcd * (q + 1) : r * (q + 1) + (xcd - r) * q) + off; }
        const int nig = WGM * nN, gid = wgid / nig, fm = gid * WGM, gsz = (nM - fm) < WGM ? (nM - fm) : WGM;
        u.pm = fm + ((wgid % nig) % gsz); u.pn = (wgid % nig) / gsz; u.pb = u.pn; return true;
    }
    __device__ __forceinline__ void a_ready(const Unit&) const {}
    __device__ __forceinline__ void done(const Unit&) const {}
};

__device__ __forceinline__ unsigned cvt_pk_bf16(float lo, float hi) { unsigned r; asm volatile("v_cvt_pk_bf16_f32 %0, %1, %2" : "=v"(r) : "v"(lo), "v"(hi)); return r; }

struct EpiBf16Plain {
    static constexpr bool PERM = true, AFTER_DRAIN = false;
    bf16_t* O; int ldc;
    __device__ __forceinline__ void operator()(const f32x4 (&acc)[2][2][4][2], const Unit& u, int wr, int wc, int fr, int fq) const {
        const int row0 = u.pm * BM + wr * 64 + fr, col0 = u.pn * BM + wc * 32 + 8 * fq;
#pragma unroll
        for (int ai = 0; ai < 2; ++ai)
#pragma unroll
            for (int m = 0; m < 4; ++m) { bf16_t* rowp = O + (size_t)(row0 + ai * HALF + m * 16) * ldc + col0;
#pragma unroll
                for (int bj = 0; bj < 2; ++bj) { const f32x4 v0 = acc[ai][bj][m][0], v1 = acc[ai][bj][m][1];
                    u32x4 w; w.x = cvt_pk_bf16(v0[0], v0[1]); w.y = cvt_pk_bf16(v0[2], v0[3]); w.z = cvt_pk_bf16(v1[0], v1[1]); w.w = cvt_pk_bf16(v1[2], v1[3]);
                    *(u32x4*)(rowp + bj * HALF) = w; } }
    }
};
struct EpiResGate {
    static constexpr bool PERM = false, AFTER_DRAIN = false;
    const float* baseL; const float* baseC; float* out; const float* gate;
    __device__ __forceinline__ void operator()(const f32x4 (&acc)[2][2][4][2], const Unit& u, int wr, int wc, int fr, int fq) const {
        const int row0 = u.pm * BM + wr * 64 + fr, col0 = u.pn * BM + wc * 32 + 4 * fq;
        const int v = u.pm < 16 ? 0 : (u.pm < 32 ? 1 : 2);
        const float* gp = gate + v * 12288 + col0;
        f32x4 gv[2][2];
#pragma unroll
        for (int bj = 0; bj < 2; ++bj)
#pragma unroll
            for (int n = 0; n < 2; ++n) gv[bj][n] = *(const f32x4*)(gp + bj * HALF + n * 16);
#pragma unroll
        for (int ai = 0; ai < 2; ++ai)
#pragma unroll
            for (int m = 0; m < 4; ++m) { const int row = row0 + ai * HALF + m * 16;
                const float* bp = (row < 8192 ? baseL + (size_t)row * 2048 : baseC + (size_t)(row - 8192) * 2048) + col0; float* op = out + (size_t)row * 2048 + col0;
#pragma unroll
                for (int bj = 0; bj < 2; ++bj)
#pragma unroll
                    for (int n = 0; n < 2; ++n) { const f32x4 b = *(const f32x4*)(bp + bj * HALF + n * 16); *(f32x4*)(op + bj * HALF + n * 16) = b + gv[bj][n] * acc[ai][bj][m][n]; } }
    }
};
__device__ __forceinline__ float silu_f(float v) { return v * __builtin_amdgcn_rcpf(1.0f + __expf(-v)); }
struct EpiSwiglu {
    static constexpr bool PERM = true, AFTER_DRAIN = false;
    bf16_t* O; int ldc;
    __device__ __forceinline__ void operator()(const f32x4 (&acc)[2][2][4][2], const Unit& u, int wr, int wc, int fr, int fq) const {
        const int row0 = u.pm * BM + wr * 64 + fr, col0 = u.pn * HALF + wc * 32 + 8 * fq;
#pragma unroll
        for (int ai = 0; ai < 2; ++ai)
#pragma unroll
            for (int m = 0; m < 4; ++m) { bf16_t* rowp = O + (size_t)(row0 + ai * HALF + m * 16) * ldc + col0;
                f32x4 a0, a1;
#pragma unroll
                for (int j = 0; j < 4; ++j) { a0[j] = silu_f(acc[ai][0][m][0][j]) * acc[ai][1][m][0][j]; a1[j] = silu_f(acc[ai][0][m][1][j]) * acc[ai][1][m][1][j]; }
                u32x4 w; w.x = cvt_pk_bf16(a0[0], a0[1]); w.y = cvt_pk_bf16(a0[2], a0[3]); w.z = cvt_pk_bf16(a1[0], a1[1]); w.w = cvt_pk_bf16(a1[2], a1[3]);
                *(u32x4*)rowp = w; }
    }
};
struct EpiF32Plain {
    static constexpr bool PERM = false, AFTER_DRAIN = false;
    float* C; int ldc;
    __device__ __forceinline__ void operator()(const f32x4 (&acc)[2][2][4][2], const Unit& u, int wr, int wc, int fr, int fq) const {
        const int row0 = u.pm * BM + wr * 64 + fr, col0 = u.pn * BM + wc * 32 + 4 * fq;
#pragma unroll
        for (int ai = 0; ai < 2; ++ai)
#pragma unroll
            for (int m = 0; m < 4; ++m) { float* rowp = C + (size_t)(row0 + ai * HALF + m * 16) * ldc + col0;
#pragma unroll
                for (int bj = 0; bj < 2; ++bj)
#pragma unroll
                    for (int n = 0; n < 2; ++n) *(f32x4*)(rowp + bj * HALF + n * 16) = acc[ai][bj][m][n]; }
    }
};
struct MoeOrder {
    int nM, nN, nwg, G, c; int t1, t2, t3, t4, t5, t6, t7;
    __device__ __forceinline__ void init(const volatile PG8_LAS unsigned* ts, int nN_, int G_, int c_) {
        t1 = __builtin_amdgcn_readfirstlane((int)ts[1]); t2 = __builtin_amdgcn_readfirstlane((int)ts[2]); t3 = __builtin_amdgcn_readfirstlane((int)ts[3]); t4 = __builtin_amdgcn_readfirstlane((int)ts[4]);
        t5 = __builtin_amdgcn_readfirstlane((int)ts[5]); t6 = __builtin_amdgcn_readfirstlane((int)ts[6]); t7 = __builtin_amdgcn_readfirstlane((int)ts[7]);
        nM = __builtin_amdgcn_readfirstlane((int)ts[8]); nN = nN_; nwg = nM * nN; G = G_; c = c_; }
    __device__ __forceinline__ bool next(int i, Unit& u) const {
        const long L = (long)i * G + c; if (L >= nwg) return false;
        int wgid = (int)L; { const int q = nwg / NXCD, r = nwg % NXCD, xcd = wgid % NXCD, off = wgid / NXCD; wgid = (xcd < r ? xcd * (q + 1) : r * (q + 1) + (xcd - r) * q) + off; }
        const int nig = WGM * nN, gid = wgid / nig, fm = gid * WGM, gsz = (nM - fm) < WGM ? (nM - fm) : WGM;
        u.pm = fm + ((wgid % nig) % gsz); u.pn = (wgid % nig) / gsz;
        const int e = (u.pm >= t1) + (u.pm >= t2) + (u.pm >= t3) + (u.pm >= t4) + (u.pm >= t5) + (u.pm >= t6) + (u.pm >= t7);
        u.pb = e * nN + u.pn; return true;
    }
    __device__ __forceinline__ void a_ready(const Unit&) const {}
    __device__ __forceinline__ void done(const Unit&) const {}
};


template <class Epi, class Sched, bool ALIGN_EPI = false, bool SP2 = false>
__device__ __forceinline__ void gemm_phase(PG8_LAS unsigned char* lds, const Gemm g, const Sched& S, const Epi& E) {
    int tid_ = threadIdx.x; asm volatile("" : "+v"(tid_));
    const int tid = tid_, wid = __builtin_amdgcn_readfirstlane(tid >> 6), lane = tid & 63, wr = wid >> 2, wc = wid & 3, fr = lane & 15, fq = lane >> 4;
    const int K = g.K, nt = K / BK;
    unsigned voffA[2], voffB[2];
#pragma unroll
    for (int i = 0; i < 2; ++i) { int R, C; stage_rc(tid * 16 + i * 8192, R, C); const int Rb = Epi::PERM ? ((R & ~31) + perm32(R & 31)) : R;
        voffA[i] = (unsigned)(R * K + C) * 2u; voffB[i] = (unsigned)(Rb * K + C) * 2u; }
    const size_t kstep = (size_t)(BK * 2);
    const size_t hstep = (size_t)HALF * K * 2;
    const size_t tstep = 2 * hstep;
    const unsigned ldsw = (unsigned)wid * 1024u;
    const int aoff = lds_byte(wr * 64 + fr, fq * 8), boff = lds_byte(wc * 32 + fr, fq * 8);
#define PG8_SA(b, h) (((b) * 2 + (h)) * HTB)
#define PG8_SB(b, h) ((4 + (b) * 2 + (h)) * HTB)
#define PG8_STAGE(bufoff, gbase, voff) do { _Pragma("unroll") for (int _i = 0; _i < 2; ++_i) \
        __builtin_amdgcn_global_load_lds((const unsigned*)((const char*)(gbase) + (voff)[_i]), (PG8_LAS unsigned*)(lds + (bufoff) + ldsw + _i * 8192), 16, 0, 0); } while (0)
#define PG8_LDA(dst, b, h) do { _Pragma("unroll") for (int m = 0; m < 4; ++m) _Pragma("unroll") for (int k = 0; k < 2; ++k) dst[m][k] = *(const PG8_LAS bf16x8*)(lds + PG8_SA(b, h) + aoff + m * 2048 + k * 1024); } while (0)
#define PG8_LDB(dst, b, h) do { _Pragma("unroll") for (int n = 0; n < 2; ++n) _Pragma("unroll") for (int k = 0; k < 2; ++k) dst[n][k] = *(const PG8_LAS bf16x8*)(lds + PG8_SB(b, h) + boff + n * 2048 + k * 1024); } while (0)
#define PG8_MMA(ai, bj, At, Bt) do { __builtin_amdgcn_s_setprio(1); _Pragma("unroll") for (int m = 0; m < 4; ++m) _Pragma("unroll") for (int n = 0; n < 2; ++n) _Pragma("unroll") for (int k = 0; k < 2; ++k) \
        acc[ai][bj][m][n] = __builtin_amdgcn_mfma_f32_16x16x32_bf16(Bt[n][k], At[m][k], acc[ai][bj][m][n], 0, 0, 0); __builtin_amdgcn_s_setprio(0); } while (0)
#define PG8_WAIT_V(n) asm volatile("s_waitcnt vmcnt(" #n ")" ::: "memory")
#define PG8_WAIT_L(n) asm volatile("s_waitcnt lgkmcnt(" #n ")" ::: "memory")
#define PG8_BAR __builtin_amdgcn_s_barrier()
#define PG8_SCHED __builtin_amdgcn_sched_barrier(0)
    Unit cur, nxt; int ui = 0;
    if (!S.next(0, cur)) return;
    f32x4 acc[2][2][4][2];
#pragma unroll
    for (int a = 0; a < 2; ++a)
#pragma unroll
        for (int b = 0; b < 2; ++b)
#pragma unroll
            for (int m = 0; m < 4; ++m)
#pragma unroll
                for (int n = 0; n < 2; ++n) acc[a][b][m][n] = (f32x4){0.f, 0.f, 0.f, 0.f};
    bf16x8 At[4][2], B0[2][2], B1[2][2];
    const char* cA = (const char*)g.A + (size_t)cur.pm * tstep; const char* cB = (const char*)g.Bt + (size_t)cur.pb * tstep;
    S.a_ready(cur);
    if constexpr (SP2) {
        PG8_STAGE(PG8_SB(0, 0), cB, voffB); PG8_STAGE(PG8_SB(0, 1), cB + hstep, voffB); PG8_STAGE(PG8_SA(0, 0), cA, voffA); PG8_STAGE(PG8_SA(0, 1), cA + hstep, voffA);
        if (wr == 1) PG8_BAR;
        PG8_WAIT_V(2); PG8_BAR;
        PG8_STAGE(PG8_SB(1, 0), cB + kstep, voffB); PG8_STAGE(PG8_SA(1, 0), cA + kstep, voffA); PG8_STAGE(PG8_SB(1, 1), cB + hstep + kstep, voffB);
        PG8_WAIT_V(6); PG8_BAR;
    } else {
        PG8_STAGE(PG8_SB(0, 0), cB, voffB); PG8_STAGE(PG8_SA(0, 0), cA, voffA); PG8_STAGE(PG8_SB(0, 1), cB + hstep, voffB); PG8_STAGE(PG8_SA(0, 1), cA + hstep, voffA);
        if (wr == 1) PG8_BAR;
        PG8_WAIT_V(4); PG8_BAR;
        PG8_STAGE(PG8_SB(1, 0), cB + kstep, voffB); PG8_STAGE(PG8_SA(1, 0), cA + kstep, voffA); PG8_STAGE(PG8_SB(1, 1), cB + hstep + kstep, voffB);
        PG8_WAIT_V(6); PG8_BAR;
    }
    for (;;) {
        const bool has_next = S.next(ui + 1, nxt);
        const char* nA = has_next ? (const char*)g.A + (size_t)nxt.pm * tstep : cA; const char* nB = has_next ? (const char*)g.Bt + (size_t)nxt.pb * tstep : cB;
        for (int t = 0; t < nt; t += 2) {
            const bool last = (t == nt - 2);
            const char* a1 = cA + (size_t)(t + 1) * kstep;
            const char* a2 = last ? nA : cA + (size_t)(t + 2) * kstep; const char* b2 = last ? nB : cB + (size_t)(t + 2) * kstep;
            const char* a3 = a2 + kstep; const char* b3 = b2 + kstep;
            if (last && has_next) S.a_ready(nxt);
            if constexpr (SP2) {
            PG8_LDB(B0, 0, 0); PG8_LDB(B1, 0, 1); PG8_SCHED; PG8_LDA(At, 0, 0); PG8_STAGE(PG8_SA(1, 1), a1 + hstep, voffA);
            PG8_WAIT_V(8); PG8_WAIT_L(0); PG8_BAR; PG8_MMA(0, 0, At, B0); PG8_MMA(0, 1, At, B1); PG8_BAR; PG8_SCHED;
            PG8_LDA(At, 0, 1); PG8_STAGE(PG8_SB(0, 0), b2, voffB); PG8_STAGE(PG8_SB(0, 1), b2 + hstep, voffB); PG8_STAGE(PG8_SA(0, 0), a2, voffA);
            PG8_WAIT_V(8); PG8_WAIT_L(0); PG8_BAR; PG8_MMA(1, 0, At, B0); PG8_MMA(1, 1, At, B1); PG8_BAR; PG8_SCHED;
            PG8_LDB(B0, 1, 0); PG8_LDB(B1, 1, 1); PG8_SCHED; PG8_LDA(At, 1, 0); PG8_STAGE(PG8_SA(0, 1), a2 + hstep, voffA);
            PG8_WAIT_V(8); PG8_WAIT_L(0); PG8_BAR; PG8_MMA(0, 0, At, B0); PG8_MMA(0, 1, At, B1); PG8_BAR; PG8_SCHED;
            PG8_LDA(At, 1, 1); PG8_STAGE(PG8_SB(1, 0), b3, voffB); PG8_STAGE(PG8_SB(1, 1), b3 + hstep, voffB); PG8_STAGE(PG8_SA(1, 0), a3, voffA);
            PG8_WAIT_V(8); PG8_WAIT_L(0); PG8_BAR; PG8_MMA(1, 0, At, B0); PG8_MMA(1, 1, At, B1); PG8_BAR; PG8_SCHED;
            } else {
            PG8_LDB(B0, 0, 0); PG8_SCHED; PG8_LDA(At, 0, 0); PG8_STAGE(PG8_SA(1, 1), a1 + hstep, voffA);
            PG8_WAIT_L(8); PG8_BAR; PG8_WAIT_L(0); PG8_MMA(0, 0, At, B0); PG8_BAR; PG8_SCHED;
            PG8_LDB(B1, 0, 1); PG8_STAGE(PG8_SB(0, 0), b2, voffB);
            PG8_BAR; PG8_WAIT_L(0); PG8_MMA(0, 1, At, B1); PG8_BAR;
            PG8_LDA(At, 0, 1); PG8_STAGE(PG8_SA(0, 0), a2, voffA);
            PG8_BAR; PG8_WAIT_L(0); PG8_MMA(1, 0, At, B0); PG8_BAR; PG8_SCHED;
            PG8_STAGE(PG8_SB(0, 1), b2 + hstep, voffB);
            PG8_WAIT_V(6); PG8_BAR; PG8_MMA(1, 1, At, B1); PG8_BAR;
            PG8_LDB(B0, 1, 0); PG8_SCHED; PG8_LDA(At, 1, 0); PG8_STAGE(PG8_SA(0, 1), a2 + hstep, voffA);
            PG8_WAIT_L(8); PG8_BAR; PG8_WAIT_L(0); PG8_MMA(0, 0, At, B0); PG8_BAR; PG8_SCHED;
            PG8_LDB(B1, 1, 1); PG8_STAGE(PG8_SB(1, 0), b3, voffB);
            PG8_BAR; PG8_WAIT_L(0); PG8_MMA(0, 1, At, B1); PG8_BAR;
            PG8_LDA(At, 1, 1); PG8_STAGE(PG8_SA(1, 0), a3, voffA);
            PG8_BAR; PG8_WAIT_L(0); PG8_MMA(1, 0, At, B0); PG8_BAR; PG8_SCHED;
            PG8_STAGE(PG8_SB(1, 1), b3 + hstep, voffB);
            PG8_WAIT_V(6); PG8_BAR; PG8_MMA(1, 1, At, B1); PG8_BAR;
            }
        }
        if constexpr (ALIGN_EPI) { if (wr == 0) PG8_BAR; }
        if constexpr (!Epi::AFTER_DRAIN) { E(acc, cur, wr, wc, fr, fq); S.done(cur); }
        if (!has_next) break;
#pragma unroll
        for (int a = 0; a < 2; ++a)
#pragma unroll
            for (int b = 0; b < 2; ++b)
#pragma unroll
                for (int m = 0; m < 4; ++m)
#pragma unroll
                    for (int n = 0; n < 2; ++n) acc[a][b][m][n] = (f32x4){0.f, 0.f, 0.f, 0.f};
        cur = nxt; cA = nA; cB = nB; ++ui;
        if constexpr (ALIGN_EPI) { if (wr == 1) PG8_BAR; }
    }
    PG8_WAIT_V(0);
    if constexpr (!ALIGN_EPI) { if (wr == 0) PG8_BAR; }
    PG8_BAR;
    if constexpr (Epi::AFTER_DRAIN) { E.fused(acc, cur, wr, wc, fr, fq, lds, wid, lane); S.done(cur); }
#undef PG8_SA
#undef PG8_SB
#undef PG8_STAGE
#undef PG8_LDA
#undef PG8_LDB
#undef PG8_MMA
#undef PG8_WAIT_V
#undef PG8_WAIT_L
#undef PG8_BAR
#undef PG8_SCHED
}
}

namespace att {
using bf16 = __hip_bfloat16;
constexpr int   D = 128, NW = 8, QBLK = 32, KVBLK = 64;
constexpr float SCALE = 0.088388347648318440f;
constexpr float THR = 8.f;
constexpr int SDEPTH = 2;
constexpr int LDQ = 512, LDK = 256, LDO = 2048;
constexpr size_t SHM_V = KVBLK * D * 2, SHM_K = KVBLK * D * 2, SHM_ATTN = 2 * SHM_V + 2 * SHM_K + NW * 64 * 4;
using bf16x8 = __attribute__((ext_vector_type(8))) short;
using s16x4  = __attribute__((ext_vector_type(4))) short;
using f32x16 = __attribute__((ext_vector_type(16))) float;
using f32x8  = __attribute__((ext_vector_type(8))) float;
using u32x4  = __attribute__((ext_vector_type(4))) unsigned;
#define KSWZ(row, colB) ((row) * 256 + ((colB) ^ (((row) & 7) << 4)))
#define SBAR() __builtin_amdgcn_sched_barrier(0)
__device__ __forceinline__ int crow(int r, int hi) { return (r & 3) + 8 * (r >> 2) + 4 * hi; }
__device__ __forceinline__ unsigned cvtpk(float lo, float hi) {
  unsigned r; asm volatile("v_cvt_pk_bf16_f32 %0, %1, %2" : "=v"(r) : "v"(lo), "v"(hi)); return r;
}
template <typename TIn> struct Stage;
template <> struct Stage<bf16>  { using T = bf16x8;
  __device__ static __forceinline__ T ld8(const bf16* p) { return *reinterpret_cast<const bf16x8*>(p); }
  __device__ static __forceinline__ bf16x8 tobf(T x) { return x; } };
template <> struct Stage<float> { using T = f32x8;
  __device__ static __forceinline__ T ld8(const float* p) { return *reinterpret_cast<const f32x8*>(p); }
  __device__ static __forceinline__ bf16x8 tobf(T x) {
    u32x4 w = {cvtpk(x[0], x[1]), cvtpk(x[2], x[3]), cvtpk(x[4], x[5]), cvtpk(x[6], x[7])}; return *reinterpret_cast<bf16x8*>(&w); } };

__device__ __forceinline__ void partialSM(f32x16& p0, f32x16& p1, float& m_reg, float& mn, float& alpha) {
  constexpr float C = SCALE * 1.4426950408889634f;
  float pmax = p0[0]; for (int r = 1; r < 16; ++r) pmax = fmaxf(pmax, p0[r]); for (int r = 0; r < 16; ++r) pmax = fmaxf(pmax, p1[r]);
  { auto rr = __builtin_amdgcn_permlane32_swap(__float_as_uint(pmax), __float_as_uint(pmax), false, false);
    pmax = fmaxf(__uint_as_float(rr[0]), __uint_as_float(rr[1])); }
  if (__builtin_expect(__all(pmax - m_reg <= THR / SCALE), 1)) { mn = m_reg; alpha = 1.f; }
  else { mn = fmaxf(m_reg, pmax); alpha = __builtin_amdgcn_exp2f((m_reg - mn) * C); m_reg = mn; }
  float mnC = -mn * C;
  for (int r = 0; r < 16; ++r) p0[r] = fmaf(p0[r], C, mnC); for (int r = 0; r < 16; ++r) p1[r] = fmaf(p1[r], C, mnC);
  for (int r = 0; r < 16; ++r) p0[r] = __builtin_amdgcn_exp2f(p0[r]);
}
__device__ __forceinline__ void finishSM(f32x16& p0, f32x16& p1, float alpha, float& l_reg, bf16x8& pa0, bf16x8& pa1, bf16x8& pa2, bf16x8& pa3) {
  for (int r = 0; r < 16; ++r) p1[r] = __builtin_amdgcn_exp2f(p1[r]);
  float ps = 0; for (int r = 0; r < 16; ++r) ps += p0[r]; for (int r = 0; r < 16; ++r) ps += p1[r];
  { auto rr = __builtin_amdgcn_permlane32_swap(__float_as_uint(ps), __float_as_uint(ps), false, false);
    ps = __uint_as_float(rr[0]) + __uint_as_float(rr[1]); }
  l_reg = l_reg * alpha + ps;
#define PK4(P, BASE, OUT) do { unsigned a0 = cvtpk(P[BASE + 0], P[BASE + 1]), a1 = cvtpk(P[BASE + 2], P[BASE + 3]);   \
    unsigned b0 = cvtpk(P[BASE + 4], P[BASE + 5]), b1 = cvtpk(P[BASE + 6], P[BASE + 7]);                              \
    auto r0 = __builtin_amdgcn_permlane32_swap(a0, b0, false, false); auto r1 = __builtin_amdgcn_permlane32_swap(a1, b1, false, false); \
    u32x4 w = {r0[0], r1[0], r0[1], r1[1]}; OUT = *reinterpret_cast<bf16x8*>(&w); } while (0)
  PK4(p0, 0, pa0); PK4(p0, 8, pa1); PK4(p1, 0, pa2); PK4(p1, 8, pa3);
#undef PK4
}
__device__ __forceinline__ void qkt(f32x16& p0, f32x16& p1, const bf16* Ks, const bf16x8* qr, int r32, int hi) {
  p0 = f32x16{}; p1 = f32x16{};
  for (int d0 = 0; d0 < 8; ++d0) { int cb = (d0 * 16 + hi * 8) * 2;
    bf16x8 b0 = *reinterpret_cast<const bf16x8*>((const char*)Ks + KSWZ(r32, cb));
    bf16x8 b1 = *reinterpret_cast<const bf16x8*>((const char*)Ks + KSWZ(32 + r32, cb));
    p0 = __builtin_amdgcn_mfma_f32_32x32x16_bf16(b0, qr[d0], p0, 0, 0, 0);
    p1 = __builtin_amdgcn_mfma_f32_32x32x16_bf16(b1, qr[d0], p1, 0, 0, 0); }
}
__device__ __forceinline__ int v_st(int k, int c) { const int kk = (k & ~0xC) | ((k & 4) << 1) | ((k & 8) >> 1); return ((kk >> 3) * 4 + (c >> 5)) * 512 + ((kk & 7) * 32 + (c & 31)) * 2; }
__device__ __forceinline__ int v_rd_base(int lane) { return ((lane & 3) << 3) | (((lane >> 2) & 3) << 6) | (((lane >> 4) & 1) << 5) | (((lane >> 5) & 1) << 8); }
constexpr int v_rd_off(int d0, int ks, int half) { return d0 * 512 + ks * 4096 + half * 2048; }
template <int OFF> __device__ __forceinline__ s16x4 tr_read(int vb) {
  s16x4 r; asm volatile("ds_read_b64_tr_b16 %0, %1 offset:%2" : "=&v"(r) : "v"(vb), "i"(OFF) : "memory"); return r;
}
template <int D0> __device__ __forceinline__ void pv_one(f32x16& od, int vb, bf16x8 pa0, bf16x8 pa1, bf16x8 pa2, bf16x8 pa3) {
  const s16x4 l0 = tr_read<v_rd_off(D0, 0, 0)>(vb), h0 = tr_read<v_rd_off(D0, 0, 1)>(vb), l1 = tr_read<v_rd_off(D0, 1, 0)>(vb), h1 = tr_read<v_rd_off(D0, 1, 1)>(vb);
  const s16x4 l2 = tr_read<v_rd_off(D0, 2, 0)>(vb), h2 = tr_read<v_rd_off(D0, 2, 1)>(vb), l3 = tr_read<v_rd_off(D0, 3, 0)>(vb), h3 = tr_read<v_rd_off(D0, 3, 1)>(vb);
  asm volatile("s_waitcnt lgkmcnt(0)" ::: "memory"); SBAR();
#define PK(L, H) (bf16x8){L[0], L[1], L[2], L[3], H[0], H[1], H[2], H[3]}
  od = __builtin_amdgcn_mfma_f32_32x32x16_bf16(pa0, PK(l0, h0), od, 0, 0, 0);
  od = __builtin_amdgcn_mfma_f32_32x32x16_bf16(pa1, PK(l1, h1), od, 0, 0, 0);
  od = __builtin_amdgcn_mfma_f32_32x32x16_bf16(pa2, PK(l2, h2), od, 0, 0, 0);
  od = __builtin_amdgcn_mfma_f32_32x32x16_bf16(pa3, PK(l3, h3), od, 0, 0, 0);
#undef PK
}
__device__ __forceinline__ void pv_d0(f32x16* o, int vb, bf16x8 pa0, bf16x8 pa1, bf16x8 pa2, bf16x8 pa3) {
  pv_one<0>(o[0], vb, pa0, pa1, pa2, pa3); pv_one<1>(o[1], vb, pa0, pa1, pa2, pa3); pv_one<2>(o[2], vb, pa0, pa1, pa2, pa3); pv_one<3>(o[3], vb, pa0, pa1, pa2, pa3);
}

template <typename TQ>
__device__ __forceinline__ void attn_dense_body(const TQ* __restrict__ Qb, const bf16* __restrict__ Kh, const bf16* __restrict__ Vh,
                                                float* __restrict__ Ob, int seq, char* lds) {
  using St = Stage<bf16>; using SQ = Stage<TQ>;
  int tid_ = threadIdx.x; asm volatile("" : "+v"(tid_));
  const int tid = tid_, wid = tid >> 6, lane = tid & 63, r32 = lane & 31, hi = lane >> 5;
  bf16* V_lds = (bf16*)lds; bf16* K_lds = (bf16*)(lds + 2 * SHM_V);
  float* ws = (float*)(lds + 2 * SHM_V + 2 * SHM_K) + wid * 64; float* li_l = ws; float* al_l = ws + 32;
  float m_reg = -1e30f, l_reg = 0; f32x16 o[4] = {}; bf16x8 qr[8];
  const TQ* Qw = Qb + (long)(wid * QBLK + r32) * LDQ + hi * 8;
#pragma unroll
  for (int d0 = 0; d0 < 8; ++d0) qr[d0] = SQ::tobf(SQ::ld8(Qw + d0 * 16));
  const int sr = tid >> 4, sc = (tid & 15) * 8, vst0 = v_st(sr, sc), vst1 = v_st(32 + sr, sc);
  const int vb0 = (int)(uintptr_t)V_lds + v_rd_base(lane);
  struct { typename St::T vs0, vs1, ks0, ks1; } sr_[SDEPTH];
#define SLOAD(i, k0) do { sr_[i].vs0 = St::ld8(&Vh[(long)((k0) + sr) * LDK + sc]); sr_[i].vs1 = St::ld8(&Vh[(long)((k0) + 32 + sr) * LDK + sc]); \
    sr_[i].ks0 = St::ld8(&Kh[(long)((k0) + sr) * LDK + sc]); sr_[i].ks1 = St::ld8(&Kh[(long)((k0) + 32 + sr) * LDK + sc]); } while (0)
#define SWRITE(b, i) do { *(bf16x8*)((char*)V_lds + (b) * SHM_V + vst0) = St::tobf(sr_[i].vs0);          \
    *(bf16x8*)((char*)V_lds + (b) * SHM_V + vst1) = St::tobf(sr_[i].vs1); int kc = sc * 2;               \
    *(bf16x8*)((char*)K_lds + (b) * SHM_K + KSWZ(sr, kc)) = St::tobf(sr_[i].ks0);                       \
    *(bf16x8*)((char*)K_lds + (b) * SHM_K + KSWZ(32 + sr, kc)) = St::tobf(sr_[i].ks1); } while (0)
#define SWAIT() do { if constexpr (SDEPTH == 2) asm volatile("s_waitcnt vmcnt(4)" ::: "memory"); else asm volatile("s_waitcnt vmcnt(0)" ::: "memory"); } while (0)
#define RESC(a) do { if (__any((a) < 1.f)) { if (hi == 0) al_l[r32] = (a); asm volatile("s_waitcnt lgkmcnt(0)" ::: "memory"); \
    for (int d = 0; d < 4; ++d) for (int r = 0; r < 16; ++r) o[d][r] *= al_l[crow(r, hi)]; } } while (0)
  f32x16 pA0, pA1, pB0, pB1; float mnA, mnB, alA, alB; bf16x8 pa0, pa1, pa2, pa3; const int NT = seq / KVBLK;
  constexpr int SE = 0, SO = SDEPTH - 1;
  SLOAD(SE, 0); asm volatile("s_waitcnt vmcnt(0)" ::: "memory"); SWRITE(0, SE); __syncthreads();
  qkt(pA0, pA1, K_lds, qr, r32, hi); partialSM(pA0, pA1, m_reg, mnA, alA);
  SLOAD(SO, KVBLK); if constexpr (SDEPTH == 2) { if (2 < NT) SLOAD(SE, 2 * KVBLK); }
  SWAIT(); SWRITE(1, SO); __syncthreads();
  for (int j = 1; j + 1 < NT; j += 2) {
    SBAR(); qkt(pB0, pB1, (bf16*)((char*)K_lds + SHM_K), qr, r32, hi);
    finishSM(pA0, pA1, alA, l_reg, pa0, pa1, pa2, pa3); SBAR();
    SLOAD(SO, (j + SDEPTH) * KVBLK); SBAR();
    pv_d0(o, vb0, pa0, pa1, pa2, pa3); partialSM(pB0, pB1, m_reg, mnB, alB);
    __syncthreads(); SWAIT(); SWRITE(0, SE);
    RESC(alB); __syncthreads();
    SBAR(); qkt(pA0, pA1, K_lds, qr, r32, hi);
    finishSM(pB0, pB1, alB, l_reg, pa0, pa1, pa2, pa3); SBAR();
    if (SDEPTH == 1 || j + 3 < NT) SLOAD(SE, (j + 1 + SDEPTH) * KVBLK); SBAR();
    pv_d0(o, vb0 + (int)SHM_V, pa0, pa1, pa2, pa3); partialSM(pA0, pA1, m_reg, mnA, alA);
    __syncthreads(); SWAIT(); SWRITE(1, SO);
    RESC(alA); __syncthreads();
  }
  SBAR(); qkt(pB0, pB1, (bf16*)((char*)K_lds + SHM_K), qr, r32, hi);
  finishSM(pA0, pA1, alA, l_reg, pa0, pa1, pa2, pa3); SBAR();
  pv_d0(o, vb0, pa0, pa1, pa2, pa3); partialSM(pB0, pB1, m_reg, mnB, alB);
  __syncthreads(); RESC(alB);
  finishSM(pB0, pB1, alB, l_reg, pa0, pa1, pa2, pa3); SBAR();
  pv_d0(o, vb0 + (int)SHM_V, pa0, pa1, pa2, pa3);
  if (hi == 0) li_l[r32] = l_reg; asm volatile("s_waitcnt lgkmcnt(0)" ::: "memory");
  float rli[16];
#pragma unroll
  for (int r = 0; r < 16; ++r) rli[r] = __builtin_amdgcn_rcpf(li_l[crow(r, hi)]);
  float* Ow = Ob + (long)(wid * QBLK) * LDO;
#pragma unroll
  for (int r = 0; r < 16; ++r) { int orow = crow(r, hi);
    for (int d0 = 0; d0 < 4; ++d0) Ow[(long)orow * LDO + d0 * 32 + r32] = o[d0][r] * rli[r]; }
#undef SLOAD
#undef SWRITE
#undef SWAIT
#undef RESC
}

}

#ifndef PG8_SP2
#define PG8_SP2 true
#endif
#ifndef PG8_ALIGN
#define PG8_ALIGN true
#endif

constexpr int NWAVES = 8;
constexpr int DM = 2048, SEQ = 4096, NB = 2, CTX = 256;
constexpr int ML = NB * SEQ, MC = NB * CTX, MT = ML + MC;
constexpr int NIN = 5136, NINP = 5376;
constexpr int DFF = 5632, DFE = 7168, NE = 8;
constexpr int LK = CTX + SEQ;
constexpr int MODW = 6 * DM;
constexpr int MSLOT = 18432;
constexpr float EPS = 1e-6f;
constexpr int C_AQ = 0, C_BQ = 512, C_CU = 1024, C_CV = 1536, C_DZ = 2048, C_DC = 2560, C_AK = 2816, C_AV = 3072, C_BK = 3328, C_BV = 3840, C_DX = 4352, C_DB = 4864, C_DT = 5120;

constexpr size_t MiB = 1u << 20;
constexpr size_t WS_CTL = 0, CTL_ZERO_BYTES = 1 * MiB;
constexpr size_t WS_MODP = 1 * MiB;
constexpr size_t WS_MOD = 12 * MiB;
constexpr size_t WS_ROPE = 13 * MiB;
constexpr size_t WS_WIN = 16 * MiB;
constexpr size_t WS_WOUT = 64 * MiB;
constexpr size_t WS_W13 = 80 * MiB;
constexpr size_t WS_W2 = 128 * MiB;
constexpr size_t WS_WM13 = 152 * MiB;
constexpr size_t WS_WM2 = 600 * MiB;
constexpr size_t WS_H = 824 * MiB;
constexpr size_t WS_P = 860 * MiB;
constexpr size_t WS_QA = 952 * MiB;
constexpr size_t WS_KA = 962 * MiB;
constexpr size_t WS_VA = 968 * MiB;
constexpr size_t WS_VN = 974 * MiB;
constexpr size_t WS_XBC = 992 * MiB;
constexpr size_t WS_DT = 1028 * MiB;
constexpr size_t WS_Y = 1030 * MiB;
constexpr size_t WS_OM = 1066 * MiB;
constexpr size_t WS_OB = 1136 * MiB;
constexpr size_t WS_XA = 1172 * MiB;
constexpr size_t WS_XB = 1240 * MiB;
constexpr size_t WS_ACT = 1308 * MiB;
constexpr size_t WS_HS = 1404 * MiB;
constexpr size_t WS_ACTM = 1476 * MiB;
constexpr size_t WS_YM = 1728 * MiB;
constexpr size_t WS_ROUTE = 1872 * MiB;
constexpr size_t WS_END = 1874 * MiB;
constexpr int CW_BAR = 4096;
constexpr int CW_CNT = 16384;

constexpr int RING_BYTES = 131072;
constexpr int LDSCTL_OFF = RING_BYTES, MISC_OFF = LDSCTL_OFF + 320;
constexpr int LDS_BYTES = 147456;

#define GAS __attribute__((address_space(1)))
#define LAS __attribute__((address_space(3)))
typedef unsigned short bf16;
typedef unsigned v4u __attribute__((ext_vector_type(4)));
typedef unsigned v2u __attribute__((ext_vector_type(2)));
typedef float f32x4 __attribute__((ext_vector_type(4)));
typedef float f32x2 __attribute__((ext_vector_type(2)));
typedef GAS unsigned gu32;
#define RLX_AGENT __ATOMIC_RELAXED, __HIP_MEMORY_SCOPE_AGENT
#define LDS_WAIT() asm volatile("s_waitcnt lgkmcnt(0)" ::: "memory")
#define VM_WAIT() asm volatile("s_waitcnt vmcnt(0)" ::: "memory")
__device__ __forceinline__ unsigned f2bf(float f) { unsigned u = __builtin_bit_cast(unsigned, f); return (u + 0x7fffu + ((u >> 16) & 1u)) >> 16; }
__device__ __forceinline__ unsigned pk2(float lo, float hi) { return f2bf(lo) | (f2bf(hi) << 16); }
__device__ __forceinline__ float bf2f(unsigned short b) { return __builtin_bit_cast(float, (unsigned)b << 16); }
__device__ __forceinline__ float bflo(unsigned w) { return __builtin_bit_cast(float, w << 16); }
__device__ __forceinline__ float bfhi(unsigned w) { return __builtin_bit_cast(float, w & 0xffff0000u); }
__device__ __forceinline__ float wave_sum(float v) {
#pragma unroll
    for (int o = 1; o < 64; o <<= 1) v += __shfl_xor(v, o);
    return v;
}
__device__ __forceinline__ float wave_max(float v) {
#pragma unroll
    for (int o = 1; o < 64; o <<= 1) v = fmaxf(v, __shfl_xor(v, o));
    return v;
}
__device__ __forceinline__ float silu1(float v) { return v / (1.0f + expf(-v)); }
__device__ __forceinline__ float gelu_tanh(float v) { const float u = 0.7978845608028654f * (v + 0.044715f * v * v * v); return 0.5f * v * (1.0f + tanhf(u)); }
__device__ __forceinline__ float softplus1(float v) { return v > 20.f ? v : log1pf(expf(v)); }

#define XB_TMO      128
#define XB_XCNT(j)  (256  + 64 * (j))
#define XB_XSUB(j)  (1280 + 64 * (j))
#define XB_XGEN(j)  (2304 + 64 * (j))
#define XB_TOP      3328
#define XB_TOPGEN   3392
#define XCD_BAR_WORDS 3456
#define XB_SPIN_CAP (1u << 18)
__device__ __forceinline__ unsigned xb_ld(unsigned* p)              { return __hip_atomic_load(p, __ATOMIC_RELAXED, __HIP_MEMORY_SCOPE_AGENT); }
__device__ __forceinline__ unsigned xb_add(unsigned* p, unsigned v) { return __hip_atomic_fetch_add(p, v, __ATOMIC_RELAXED, __HIP_MEMORY_SCOPE_AGENT); }
__device__ __forceinline__ unsigned xb_xcc_id() { return (unsigned)__builtin_amdgcn_s_getreg((3 << 11) | 20) & 0xFu; }
#define XB_SPIN(cond, bar) do { unsigned _sp = 0; while (cond) { __builtin_amdgcn_s_sleep(1); \
    if ((++_sp & 255u) == 0u) { if (xb_ld(&(bar)[XB_TMO])) break; if (_sp > XB_SPIN_CAP) { atomicAdd(&(bar)[XB_TMO], 1u); break; } } } } while (0)
struct XcdBarrier { unsigned* bar; unsigned x; volatile LAS unsigned* st; };
__device__ __forceinline__ XcdBarrier xcd_barrier_post(unsigned* bar, volatile LAS unsigned* st) {
    XcdBarrier b; b.bar = bar; b.x = xb_xcc_id(); b.st = st;
    if (threadIdx.x == 0) (void)xb_add(&bar[XB_XCNT(b.x)], 1u);
    return b;
}
__device__ __forceinline__ void xcd_barrier_complete(unsigned* bar, unsigned x, unsigned& nloc, unsigned& nx) {
    const unsigned G = gridDim.x * gridDim.y * gridDim.z;
    unsigned sum, cnt, mine, sp = 0u;
    for (;;) {
        sum = 0u; cnt = 0u; mine = 0u;
#pragma unroll
        for (unsigned j = 0; j < 16; ++j) { const unsigned c = xb_ld(&bar[XB_XCNT(j)]); sum += c; cnt += (c > 0u) ? 1u : 0u; mine = (j == x) ? c : mine; }
        if (sum == G) break;
        __builtin_amdgcn_s_sleep(1);
        if ((++sp & 255u) == 0u) { if (xb_ld(&bar[XB_TMO])) break; if (sp > XB_SPIN_CAP) { atomicAdd(&bar[XB_TMO], 1u); break; } }
    }
    nloc = mine > 0u ? mine : 1u; nx = cnt > 0u ? cnt : 1u;
}
__device__ __forceinline__ void xcd_barrier(const XcdBarrier& b) {
    asm volatile("s_waitcnt vmcnt(0)" ::: "memory");
    __syncthreads();
    if (threadIdx.x == 0) {
        unsigned* bar = b.bar;
        __builtin_amdgcn_s_waitcnt(0);
        unsigned nloc = b.st[0], nx = b.st[1];
        if (nloc == 0u) { xcd_barrier_complete(bar, b.x, nloc, nx); b.st[0] = nloc; b.st[1] = nx; }
        const unsigned old = xb_add(&bar[XB_XSUB(b.x)], 1u);
        const unsigned gen = old / nloc;
        if (old + 1u == (gen + 1u) * nloc) {
            __builtin_amdgcn_fence(__ATOMIC_RELEASE, "agent");
            asm volatile("s_waitcnt vmcnt(0)" ::: "memory");
            const unsigned og = xb_add(&bar[XB_TOP], 1u);
            const unsigned tg = og / nx;
            if (og + 1u == (tg + 1u) * nx) xb_add(&bar[XB_TOPGEN], 1u);
            else XB_SPIN(xb_ld(&bar[XB_TOPGEN]) == tg, bar);
            __builtin_amdgcn_fence(__ATOMIC_ACQUIRE, "agent");
            xb_add(&bar[XB_XGEN(b.x)], 1u);
            asm volatile("s_waitcnt vmcnt(0)" ::: "memory");
        } else {
            XB_SPIN(xb_ld(&bar[XB_XGEN(b.x)]) == gen, bar);
            __builtin_amdgcn_fence(__ATOMIC_ACQUIRE, "agent");
            asm volatile("s_waitcnt vmcnt(0)" ::: "memory");
        }
    }
    __syncthreads();
}

struct Args { const float* in[28]; float* out; unsigned char* ws; int ph_lo, ph_hi; };
struct Frame {
    LAS unsigned char* lds;
    unsigned char* ldsg;
    volatile LAS unsigned* MISC;
    gu32* ctl;
    int tid, lane, wave;
    int vcu, G;
    float* out;
    unsigned char* ws;
};
enum { I_X = 0, I_C, I_CTX, I_CCTX, I_WMOD, I_BMOD, I_NMIX, I_NFFN, I_WIN, I_QN, I_KN, I_RPB, I_SGUN, I_SGUW, I_SGUB, I_CONVW, I_CONVB, I_ALOG, I_DTB, I_DSKIP, I_ONORM, I_WOUT, I_W13, I_W2, I_ROUTER, I_MW13, I_MW2, I_FNORM };

__device__ __forceinline__ void cvt_item(const float* W, int K, int N, bf16* WT, int drow0, LAS float* scr, int k0, int n0, int lane) {
    const int r8 = lane >> 3, c4 = (lane & 7) * 4;
    f32x4 v[8];
    const bool ok = (n0 + c4) < N;
#pragma unroll
    for (int i = 0; i < 8; ++i) { v[i] = ok ? *(const GAS f32x4*)(W + (size_t)(k0 + r8 + 8 * i) * N + n0 + c4) : (f32x4){0.f, 0.f, 0.f, 0.f}; }
#pragma unroll
    for (int i = 0; i < 8; ++i) { LAS float* s = scr + (r8 + 8 * i) * 33 + c4; s[0] = v[i][0]; s[1] = v[i][1]; s[2] = v[i][2]; s[3] = v[i][3]; }
    LDS_WAIT(); asm volatile("" ::: "memory");
    const int c = lane & 7;
#pragma unroll
    for (int j = 0; j < 4; ++j) { const int n = (lane >> 3) + 8 * j; const LAS float* s = scr + (8 * c) * 33 + n;
        v4u o; o.x = pk2(s[0 * 33], s[1 * 33]); o.y = pk2(s[2 * 33], s[3 * 33]); o.z = pk2(s[4 * 33], s[5 * 33]); o.w = pk2(s[6 * 33], s[7 * 33]);
        *(GAS v4u*)(WT + (size_t)(drow0 + n) * K + k0 + 8 * c) = o; }
    LDS_WAIT(); asm volatile("" ::: "memory");
}
__device__ __forceinline__ int map13(int n0, int dff) { const int h = n0 >= dff ? 1 : 0, j = n0 - h * dff; return (j >> 7) * 256 + h * 128 + (j & 127); }

__device__ __forceinline__ void phase_pro_a(Frame& F, const Args& A) {
    LAS float* scr = (LAS float*)(F.lds + F.wave * 16384);
    const int gw = F.vcu * NWAVES + F.wave, NGW = F.G * NWAVES, lane = F.lane;
    constexpr int I_IN = 32 * 161, I_OUT = 32 * 64, I_13 = 32 * 352, I_2 = 88 * 64, I_M13 = 32 * 448, I_M2 = 112 * 64;
    constexpr int NITEMS = 2 * I_IN + 2 * I_OUT + I_13 + I_2 + 8 * I_M13 + 8 * I_M2;
    for (int it = gw; it < NITEMS; it += NGW) {
        int r = it;
        if (r < 2 * I_IN) { const int l = r / I_IN; r -= l * I_IN; const int kb = r / 161, nb = r % 161;
            cvt_item(A.in[I_WIN] + (size_t)l * DM * NIN, DM, NIN, (bf16*)(F.ws + WS_WIN) + (size_t)l * NINP * DM, 32 * nb, scr, 64 * kb, 32 * nb, lane); continue; }
        r -= 2 * I_IN;
        if (r < 2 * I_OUT) { const int l = r / I_OUT; r -= l * I_OUT; const int kb = r / 64, nb = r % 64;
            cvt_item(A.in[I_WOUT] + (size_t)l * DM * DM, DM, DM, (bf16*)(F.ws + WS_WOUT) + (size_t)l * DM * DM, 32 * nb, scr, 64 * kb, 32 * nb, lane); continue; }
        r -= 2 * I_OUT;
        if (r < I_13) { const int kb = r / 352, nb = r % 352;
            cvt_item(A.in[I_W13], DM, 2 * DFF, (bf16*)(F.ws + WS_W13), map13(32 * nb, DFF), scr, 64 * kb, 32 * nb, lane); continue; }
        r -= I_13;
        if (r < I_2) { const int kb = r / 64, nb = r % 64;
            cvt_item(A.in[I_W2], DFF, DM, (bf16*)(F.ws + WS_W2), 32 * nb, scr, 64 * kb, 32 * nb, lane); continue; }
        r -= I_2;
        if (r < 8 * I_M13) { const int e = r / I_M13; r -= e * I_M13; const int kb = r / 448, nb = r % 448;
            cvt_item(A.in[I_MW13] + (size_t)e * DM * 2 * DFE, DM, 2 * DFE, (bf16*)(F.ws + WS_WM13) + (size_t)e * 2 * DFE * DM, map13(32 * nb, DFE), scr, 64 * kb, 32 * nb, lane); continue; }
        r -= 8 * I_M13;
        { const int e = r / I_M2; r -= e * I_M2; const int kb = r / 64, nb = r % 64;
            cvt_item(A.in[I_MW2] + (size_t)e * DFE * DM, DFE, DM, (bf16*)(F.ws + WS_WM2) + (size_t)e * DM * DFE, 32 * nb, scr, 64 * kb, 32 * nb, lane); }
    }
    float* modp = (float*)(F.ws + WS_MODP);
    for (int it = gw; it < 2 * 32 * 48; it += NGW) {
        const int l = it / (32 * 48), r = it % (32 * 48), ks = r / 48, cb = r % 48;
        const float* wm = A.in[I_WMOD] + (size_t)l * DM * MODW + (size_t)(ks * 64) * MODW + cb * 256 + 4 * lane;
        f32x4 a0 = {0.f, 0.f, 0.f, 0.f}, a1 = a0, a2 = a0;
#pragma unroll 8
        for (int k = 0; k < 64; ++k) {
            const f32x4 w = *(const GAS f32x4*)(wm + (size_t)k * MODW);
            const int kk = ks * 64 + k;
            const float s0 = silu1(A.in[I_C][kk]), s1 = silu1(A.in[I_C][DM + kk]), s2 = silu1(A.in[I_CCTX][kk]);
            a0 += w * s0; a1 += w * s1; a2 += w * s2;
        }
        float* o = modp + ((size_t)(l * 32 + ks) * 3) * MODW + cb * 256 + 4 * lane;
        *(GAS f32x4*)(o) = a0; *(GAS f32x4*)(o + MODW) = a1; *(GAS f32x4*)(o + 2 * MODW) = a2;
    }
    f32x2* rope = (f32x2*)(F.ws + WS_ROPE);
    for (int idx = (F.vcu * NWAVES * 64) + F.tid; idx < SEQ * 64; idx += F.G * NWAVES * 64) {
        const int t = idx >> 6, i = idx & 63;
        const float pos = (float)(i < 32 ? (t >> 6) : (t & 63));
        const float inv = powf(10000.0f, -(float)(i & 31) / 32.0f);
        const float ang = pos * inv;
        rope[idx] = (f32x2){cosf(ang), sinf(ang)};
    }
}
__device__ __forceinline__ void phase_pro_b(Frame& F, const Args& A) {
    const float* modp = (const float*)(F.ws + WS_MODP); float* mod = (float*)(F.ws + WS_MOD);
    for (int idx = (F.vcu * NWAVES * 64) + F.tid; idx < 2 * 3 * MODW; idx += F.G * NWAVES * 64) {
        const int l = idx / (3 * MODW), r = idx % (3 * MODW), j = r % MODW;
        float s = A.in[I_BMOD][l * MODW + j];
        for (int ks = 0; ks < 32; ++ks) s += modp[(size_t)(l * 32 + ks) * 3 * MODW + r];
        mod[idx] = s;
    }
}
__device__ __forceinline__ void norm_mod_row(const float* xrow, const float* gain, const float* sh, const float* sc, bf16* orow, int lane, f32x4 (&y)[8]) {
    f32x4 v[8]; float ss = 0.f;
#pragma unroll
    for (int j = 0; j < 8; ++j) { v[j] = *(const GAS f32x4*)(xrow + 4 * lane + 256 * j); ss += (v[j].x * v[j].x + v[j].y * v[j].y) + (v[j].z * v[j].z + v[j].w * v[j].w); }
    const float r = 1.0f / sqrtf(wave_sum(ss) * (1.0f / DM) + EPS);
#pragma unroll
    for (int j = 0; j < 8; ++j) { const int c = 4 * lane + 256 * j;
        const f32x4 g = *(const GAS f32x4*)(gain + c), s1 = *(const GAS f32x4*)(sc + c), s0 = *(const GAS f32x4*)(sh + c);
        y[j] = (v[j] * r) * g * (s1 + 1.0f) + s0;
        v2u o; o.x = pk2(y[j].x, y[j].y); o.y = pk2(y[j].z, y[j].w);
        *(GAS v2u*)(orow + c) = o; }
}
__device__ __forceinline__ const float* xrow_ptr(Frame& F, const Args& A, int l, int row) {
    if (l == 0) return row < ML ? A.in[I_X] + (size_t)row * DM : A.in[I_CTX] + (size_t)(row - ML) * DM;
    return (const float*)(F.ws + WS_XB) + (size_t)row * DM;
}
__device__ __forceinline__ int row_vec(int row) { return row < SEQ ? 0 : (row < ML ? 1 : 2); }
__device__ __forceinline__ void phase_n1(Frame& F, const Args& A, int l) {
    const int gw = F.vcu * NWAVES + F.wave, NGW = F.G * NWAVES;
    const float* mod = (const float*)(F.ws + WS_MOD) + (size_t)l * 3 * MODW;
    bf16* H = (bf16*)(F.ws + WS_H);
    for (int row = gw; row < MT; row += NGW) {
        const float* m = mod + row_vec(row) * MODW; f32x4 y[8];
        norm_mod_row(xrow_ptr(F, A, l, row), A.in[I_NMIX] + l * DM, m, m + DM, H + (size_t)row * DM, F.lane, y);
    }
}
__device__ __forceinline__ void phase_prep(Frame& F, const Args& A, int l) {
    const int gw = F.vcu * NWAVES + F.wave, NGW = F.G * NWAVES, lane = F.lane;
    const bf16* P = (const bf16*)(F.ws + WS_P);
    bf16* QA = (bf16*)(F.ws + WS_QA); bf16* KA = (bf16*)(F.ws + WS_KA); bf16* VA = (bf16*)(F.ws + WS_VA);
    float* VN = (float*)(F.ws + WS_VN); float* XBC = (float*)(F.ws + WS_XBC); float* DT = (float*)(F.ws + WS_DT);
    const f32x2* rope = (const f32x2*)(F.ws + WS_ROPE);
    const float* qn = A.in[I_QN] + l * 128; const float* kn = A.in[I_KN] + l * 128;
    const float* cw = A.in[I_CONVW] + (size_t)l * 5 * 1024; const float* cb = A.in[I_CONVB] + l * 1024;
    for (int row = gw; row < MT; row += NGW) {
        const bool lat = row < ML;
        const int b = lat ? row / SEQ : (row - ML) / CTX, tpos = lat ? row % SEQ : (row - ML) % CTX, slen = lat ? SEQ : CTX;
        const bf16* pr = P + (size_t)row * NINP;
        f32x2 cs = {1.f, 0.f}; if (lat) cs = rope[tpos * 64 + lane];
#pragma unroll
        for (int hh = 0; hh < 6; ++hh) {
            const int src = hh < 4 ? C_AQ + hh * 128 : C_AK + (hh - 4) * 128;
            const unsigned w = *(const GAS unsigned*)(pr + src + 2 * lane);
            const float v0 = bflo(w), v1 = bfhi(w);
            const float r = 1.0f / sqrtf(wave_sum(v0 * v0 + v1 * v1) * (1.0f / 128.f) + EPS);
            const float* gn = hh < 4 ? qn : kn;
            const float y0 = v0 * r * gn[2 * lane], y1 = v1 * r * gn[2 * lane + 1];
            const float o0 = y0 * cs.x - y1 * cs.y, o1 = y0 * cs.y + y1 * cs.x;
            bf16* dst = hh < 4 ? QA + (size_t)row * 512 + hh * 128 : KA + ((size_t)b * LK + (lat ? CTX + tpos : tpos)) * 256 + (hh - 4) * 128;
            *(GAS unsigned*)(dst + 2 * lane) = pk2(o0, o1);
        }
        { const v2u w = *(const GAS v2u*)(pr + C_AV + 4 * lane);
          *(GAS v2u*)(VA + ((size_t)b * LK + (lat ? CTX + tpos : tpos)) * 256 + 4 * lane) = w; }
        { const v4u w = *(const GAS v4u*)(pr + C_CV + 8 * lane);
          float g[8]; g[0] = gelu_tanh(bflo(w.x)); g[1] = gelu_tanh(bfhi(w.x)); g[2] = gelu_tanh(bflo(w.y)); g[3] = gelu_tanh(bfhi(w.y));
          g[4] = gelu_tanh(bflo(w.z)); g[5] = gelu_tanh(bfhi(w.z)); g[6] = gelu_tanh(bflo(w.w)); g[7] = gelu_tanh(bfhi(w.w));
          float ss = 0.f;
#pragma unroll
          for (int i = 0; i < 8; ++i) ss += g[i] * g[i];
          const float r = 1.0f / sqrtf(wave_sum(ss) * (1.0f / 512.f) + EPS);
          const float* sn = A.in[I_SGUN] + l * 512 + 8 * lane;
          f32x4 o0, o1;
#pragma unroll
          for (int i = 0; i < 4; ++i) { o0[i] = g[i] * r * sn[i]; o1[i] = g[4 + i] * r * sn[4 + i]; }
          *(GAS f32x4*)(VN + (size_t)row * 512 + 8 * lane) = o0; *(GAS f32x4*)(VN + (size_t)row * 512 + 8 * lane + 4) = o1; }
#pragma unroll 4
        for (int i = 0; i < 16; ++i) {
            const int ch = lane + 64 * i;
            const int col = ch < 512 ? C_DX + ch : (ch < 768 ? C_DB + (ch - 512) : C_DC + (ch - 768));
            float acc = cb[ch];
#pragma unroll
            for (int k = 0; k < 5; ++k) { const int tt = tpos + k - 2;
                if (tt >= 0 && tt < slen) acc += cw[k * 1024 + ch] * bf2f(pr[(ptrdiff_t)(k - 2) * NINP + col]); }
            XBC[(size_t)row * 1024 + ch] = silu1(acc);
        }
        if (lane < 16) DT[(size_t)row * 16 + lane] = softplus1(bf2f(pr[C_DT + lane]) + A.in[I_DTB][l * 16 + lane]);
    }
}
template <bool WIN>
__device__ __forceinline__ void naive_attn_row(const bf16* q, const bf16* Pk, const bf16* Pv, int r, int c, int brow0, const float* rpb_h,
                                               const bf16* kc, int kcs, const bf16* vc, int vcs, float* out, LAS float* wq, int lane) {
    { const unsigned w = *(const GAS unsigned*)(q + 2 * lane); wq[2 * lane] = bflo(w); wq[2 * lane + 1] = bfhi(w); }
    LDS_WAIT(); asm volatile("" ::: "memory");
    constexpr int NBLK = WIN ? 6 : 4;
    float s[NBLK];
    const int r0 = min(max(r - 4, 0), 56), c0 = min(max(c - 8, 0), 48);
#pragma unroll
    for (int blk = 0; blk < NBLK; ++blk) {
        const bf16* kp; float bias = 0.f;
        if (WIN && blk < 2) { const int kk = blk * 64 + lane, kr = r0 + (kk >> 4), kcol = c0 + (kk & 15);
            kp = Pk + (size_t)(brow0 + kr * 64 + kcol) * NINP; bias = rpb_h[(kr - r + 7) * 31 + (kcol - c + 15)]; }
        else { const int j = (blk - (WIN ? 2 : 0)) * 64 + lane; kp = kc + (size_t)j * kcs; }
        float dot = 0.f;
#pragma unroll 4
        for (int d8 = 0; d8 < 16; ++d8) {
            const v4u w = *(const GAS v4u*)(kp + 8 * d8);
            const LAS f32x4* qq = (const LAS f32x4*)(wq + 8 * d8); const f32x4 q0 = qq[0], q1 = qq[1];
            dot += bflo(w.x) * q0.x + bfhi(w.x) * q0.y + bflo(w.y) * q0.z + bfhi(w.y) * q0.w + bflo(w.z) * q1.x + bfhi(w.z) * q1.y + bflo(w.w) * q1.z + bfhi(w.w) * q1.w;
        }
        s[blk] = dot * 0.088388347648318440f + bias;
    }
    float m = s[0];
#pragma unroll
    for (int blk = 1; blk < NBLK; ++blk) m = fmaxf(m, s[blk]);
    m = wave_max(m);
    float lsum = 0.f;
#pragma unroll
    for (int blk = 0; blk < NBLK; ++blk) { s[blk] = expf(s[blk] - m); lsum += s[blk]; }
    lsum = wave_sum(lsum);
    float o0 = 0.f, o1 = 0.f;
#pragma unroll
    for (int blk = 0; blk < NBLK; ++blk) {
        for (int j = 0; j < 64; ++j) {
            const float pj = __shfl(s[blk], j);
            const bf16* vp;
            if (WIN && blk < 2) { const int kk = blk * 64 + j, kr = r0 + (kk >> 4), kcol = c0 + (kk & 15); vp = Pv + (size_t)(brow0 + kr * 64 + kcol) * NINP; }
            else { const int jj = (blk - (WIN ? 2 : 0)) * 64 + j; vp = vc + (size_t)jj * vcs; }
            const unsigned w = *(const GAS unsigned*)(vp + 2 * lane);
            o0 += pj * bflo(w); o1 += pj * bfhi(w);
        }
    }
    const float inv = 1.0f / lsum;
    *(GAS f32x2*)(out + 2 * lane) = (f32x2){o0 * inv, o1 * inv};
    asm volatile("" ::: "memory");
}
__device__ __forceinline__ void phase_mix(Frame& F, const Args& A, int l) {
    const int gw = F.vcu * NWAVES + F.wave, NGW = F.G * NWAVES, lane = F.lane;
    const bf16* P = (const bf16*)(F.ws + WS_P);
    const bf16* QA = (const bf16*)(F.ws + WS_QA); const bf16* KA = (const bf16*)(F.ws + WS_KA); const bf16* VA = (const bf16*)(F.ws + WS_VA);
    const float* VN = (const float*)(F.ws + WS_VN); const float* XBC = (const float*)(F.ws + WS_XBC); const float* DT = (const float*)(F.ws + WS_DT);
    float* Y = (float*)(F.ws + WS_Y); float* OM = (float*)(F.ws + WS_OM);
    for (int task = gw; task < 2 * 2 * 8 * 64; task += NGW) {
        const int p = task & 63, hh = (task >> 6) & 7, d = (task >> 9) & 1, b = task >> 10, g = hh >> 2;
        const float a = -expf(A.in[I_ALOG][l * 16 + d * 8 + hh]);
        float h0 = 0.f, h1 = 0.f;
        float* Yd = Y + (size_t)d * MT * 512;
        for (int seg = 0; seg < 2; ++seg) {
            const int len = seg ? SEQ : CTX, rowbase = seg ? b * SEQ : ML + b * CTX;
            for (int s0 = 0; s0 < len; s0 += 8) {
                float dtv[8], xv[8]; f32x2 Bv[8], Cv[8];
#pragma unroll
                for (int u = 0; u < 8; ++u) { const int t = d ? len - 1 - (s0 + u) : s0 + u; const size_t row = (size_t)(rowbase + t);
                    dtv[u] = DT[row * 16 + d * 8 + hh]; xv[u] = XBC[row * 1024 + hh * 64 + p];
                    Bv[u] = *(const GAS f32x2*)(XBC + row * 1024 + 512 + g * 128 + 2 * lane); Cv[u] = *(const GAS f32x2*)(XBC + row * 1024 + 768 + g * 128 + 2 * lane); }
                float yv[8];
#pragma unroll
                for (int u = 0; u < 8; ++u) { const float dec = expf(dtv[u] * a), dx = dtv[u] * xv[u];
                    h0 = h0 * dec + dx * Bv[u].x; h1 = h1 * dec + dx * Bv[u].y; yv[u] = Cv[u].x * h0 + Cv[u].y * h1; }
#pragma unroll
                for (int u = 0; u < 8; ++u) yv[u] = wave_sum(yv[u]);
                if (lane == 0) {
#pragma unroll
                    for (int u = 0; u < 8; ++u) { const int t = d ? len - 1 - (s0 + u) : s0 + u; Yd[(size_t)(rowbase + t) * 512 + hh * 64 + p] = yv[u]; } }
            }
        }
    }
    for (int u = blockIdx.x; u < 128; u += F.G) {
        const int b = u >> 6, h = (u >> 4) & 3, qb = u & 15;
        const size_t row0 = (size_t)b * SEQ + qb * 256;
        att::attn_dense_body<att::bf16>((const att::bf16*)QA + row0 * 512 + h * 128, (const att::bf16*)KA + (size_t)b * LK * 256 + (h >> 1) * 128,
                                        (const att::bf16*)VA + (size_t)b * LK * 256 + (h >> 1) * 128, OM + row0 * DM + h * 128, LK, (char*)F.ldsg);
        __syncthreads();
    }
    LAS float* wq = (LAS float*)(F.lds + F.wave * 512);
    if (l == 0) {
        for (int it = gw; it < MC * 4; it += NGW) {
            const int h = it & 3, cr = it >> 2, b = cr / CTX; const int row = ML + cr;
            naive_attn_row<false>(QA + (size_t)row * 512 + h * 128, nullptr, nullptr, 0, 0, 0, nullptr,
                                  KA + (size_t)b * LK * 256 + (h >> 1) * 128, 256, VA + (size_t)b * LK * 256 + (h >> 1) * 128, 256, OM + (size_t)row * DM + h * 128, wq, lane);
        }
        for (int it = gw; it < MC * 4; it += NGW) {
            const int h = it & 3, cr = it >> 2, b = cr / CTX; const int row = ML + cr;
            const bf16* pc = P + (size_t)(ML + b * CTX) * NINP;
            naive_attn_row<false>(P + (size_t)row * NINP + C_BQ + h * 128, nullptr, nullptr, 0, 0, 0, nullptr,
                                  pc + C_BK + h * 128, NINP, pc + C_BV + h * 128, NINP, OM + (size_t)row * DM + 512 + h * 128, wq, lane);
        }
    }
    for (int it = gw; it < ML * 4; it += NGW) {
        const int h = it & 3, row = it >> 2, b = row / SEQ, t = row % SEQ;
        const bf16* pc = P + (size_t)(ML + b * CTX) * NINP;
        naive_attn_row<true>(P + (size_t)row * NINP + C_BQ + h * 128, P + C_BK + h * 128, P + C_BV + h * 128, t >> 6, t & 63, b * SEQ,
                             A.in[I_RPB] + (size_t)(l * 4 + h) * 15 * 31, pc + C_BK + h * 128, NINP, pc + C_BV + h * 128, NINP, OM + (size_t)row * DM + 512 + h * 128, wq, lane);
    }
    {
        const int nrow = l == 0 ? MT : ML;
        const float* sw = A.in[I_SGUW] + (size_t)l * 4 * 128 * 128; const float* sb = A.in[I_SGUB] + l * 4 * 128;
        for (int idx = (F.vcu * NWAVES * 64) + F.tid; idx < nrow * 512; idx += F.G * NWAVES * 64) {
            const int row = idx >> 9, ch = idx & 511, g = ch >> 7;
            const int i = (row < ML ? row : row - ML) & 127, base = row - i;
            const float* wr = sw + ((size_t)g * 128 + i) * 128;
            float acc = 0.f;
#pragma unroll 8
            for (int j = 0; j < 128; ++j) acc += wr[j] * VN[(size_t)(base + j) * 512 + ch];
            const float u = gelu_tanh(bf2f(P[(size_t)row * NINP + C_CU + ch]));
            OM[(size_t)row * DM + 1024 + ch] = u * (acc + sb[g * 128 + i]);
        }
    }
}
__device__ __forceinline__ void phase_merge(Frame& F, const Args& A, int l) {
    const int gw = F.vcu * NWAVES + F.wave, NGW = F.G * NWAVES, lane = F.lane;
    const bf16* P = (const bf16*)(F.ws + WS_P);
    const float* XBC = (const float*)(F.ws + WS_XBC); const float* Y = (const float*)(F.ws + WS_Y); const float* OM = (const float*)(F.ws + WS_OM);
    bf16* OB = (bf16*)(F.ws + WS_OB);
    const float* on = A.in[I_ONORM] + l * DM;
    const int nrow = l == 0 ? MT : ML;
    const int hh = lane >> 3;
    const float skip = A.in[I_DSKIP][l * 16 + hh] + A.in[I_DSKIP][l * 16 + 8 + hh];
    for (int row = gw; row < nrow; row += NGW) {
#pragma unroll
        for (int g = 0; g < 4; ++g) {
            float v[8];
            if (g < 3) { const f32x4 a = *(const GAS f32x4*)(OM + (size_t)row * DM + g * 512 + 8 * lane), c = *(const GAS f32x4*)(OM + (size_t)row * DM + g * 512 + 8 * lane + 4);
#pragma unroll
                for (int i = 0; i < 4; ++i) { v[i] = a[i]; v[4 + i] = c[i]; } }
            else {
                const v4u z = *(const GAS v4u*)(P + (size_t)row * NINP + C_DZ + 8 * lane);
                float zf[8]; zf[0] = bflo(z.x); zf[1] = bfhi(z.x); zf[2] = bflo(z.y); zf[3] = bfhi(z.y); zf[4] = bflo(z.z); zf[5] = bfhi(z.z); zf[6] = bflo(z.w); zf[7] = bfhi(z.w);
#pragma unroll
                for (int i = 0; i < 8; ++i) { const int ch = 8 * lane + i;
                    const float y = Y[(size_t)row * 512 + ch] + Y[(size_t)(MT + row) * 512 + ch] + skip * XBC[(size_t)row * 1024 + ch];
                    v[i] = y * silu1(zf[i]); }
            }
            float ss = 0.f;
#pragma unroll
            for (int i = 0; i < 8; ++i) ss += v[i] * v[i];
            const float r = 1.0f / sqrtf(wave_sum(ss) * (1.0f / 512.f) + EPS);
            const float* gn = on + g * 512 + 8 * lane;
            v4u o; o.x = pk2(v[0] * r * gn[0], v[1] * r * gn[1]); o.y = pk2(v[2] * r * gn[2], v[3] * r * gn[3]); o.z = pk2(v[4] * r * gn[4], v[5] * r * gn[5]); o.w = pk2(v[6] * r * gn[6], v[7] * r * gn[7]);
            *(GAS v4u*)(OB + (size_t)row * DM + g * 512 + 8 * lane) = o;
        }
    }
}
__device__ __forceinline__ void phase_n2(Frame& F, const Args& A, int l) {
    const int gw = F.vcu * NWAVES + F.wave, NGW = F.G * NWAVES, lane = F.lane;
    const float* mod = (const float*)(F.ws + WS_MOD) + (size_t)l * 3 * MODW;
    const float* XA = (const float*)(F.ws + WS_XA);
    bf16* H = (bf16*)(F.ws + WS_H);
    int* route = (int*)(F.ws + WS_ROUTE);
    const int nrow = l == 0 ? MT : ML;
    for (int row = gw; row < nrow; row += NGW) {
        const float* m = mod + row_vec(row) * MODW; f32x4 y[8];
        norm_mod_row(XA + (size_t)row * DM, A.in[I_NFFN] + l * DM, m + 3 * DM, m + 4 * DM, H + (size_t)row * DM, lane, y);
        if (l == 1) {
            float lg[8];
#pragma unroll
            for (int e = 0; e < 8; ++e) lg[e] = 0.f;
            const float* rt = A.in[I_ROUTER];
#pragma unroll
            for (int j = 0; j < 8; ++j) {
#pragma unroll
                for (int i = 0; i < 4; ++i) { const int k = 4 * lane + 256 * j + i;
                    const f32x4 r0 = *(const GAS f32x4*)(rt + (size_t)k * 8), r1 = *(const GAS f32x4*)(rt + (size_t)k * 8 + 4);
                    const float yy = y[j][i];
                    lg[0] += yy * r0.x; lg[1] += yy * r0.y; lg[2] += yy * r0.z; lg[3] += yy * r0.w; lg[4] += yy * r1.x; lg[5] += yy * r1.y; lg[6] += yy * r1.z; lg[7] += yy * r1.w; }
            }
#pragma unroll
            for (int e = 0; e < 8; ++e) lg[e] = wave_sum(lg[e]);
            int e0 = 0; float v0 = lg[0];
#pragma unroll
            for (int e = 1; e < 8; ++e) if (lg[e] > v0) { v0 = lg[e]; e0 = e; }
            int e1 = -1; float v1 = -3.4e38f;
#pragma unroll
            for (int e = 0; e < 8; ++e) if (e != e0 && lg[e] > v1) { v1 = lg[e]; e1 = e; }
            const float ex = expf(v1 - v0), w0 = 1.0f / (1.0f + ex), w1 = ex / (1.0f + ex);
            if (lane == 0) {
                const int p0 = (int)__hip_atomic_fetch_add((unsigned*)(F.ctl + CW_CNT + 64 * e0), 1u, RLX_AGENT);
                const int p1 = (int)__hip_atomic_fetch_add((unsigned*)(F.ctl + CW_CNT + 64 * e1), 1u, RLX_AGENT);
                int* rr = route + (size_t)row * 8;
                rr[0] = e0; rr[1] = e1; rr[2] = p0; rr[3] = p1; rr[4] = __builtin_bit_cast(int, w0); rr[5] = __builtin_bit_cast(int, w1);
            }
        }
    }
}
__device__ __forceinline__ void moe_tiles(Frame& F) {
    __syncthreads();
    if (F.tid == 0) { unsigned acc = 0;
        for (int e = 0; e < 8; ++e) { F.MISC[16 + e] = acc; const unsigned c = __hip_atomic_load((unsigned*)(F.ctl + CW_CNT + 64 * e), RLX_AGENT); acc += (c + 255u) >> 8; }
        F.MISC[24] = acc; }
    __syncthreads();
}
__device__ __forceinline__ void phase_gather(Frame& F) {
    const int gw = F.vcu * NWAVES + F.wave, NGW = F.G * NWAVES, lane = F.lane;
    moe_tiles(F);
    const bf16* H = (const bf16*)(F.ws + WS_H); bf16* HS = (bf16*)(F.ws + WS_HS);
    int* route = (int*)(F.ws + WS_ROUTE);
    for (int it = gw; it < ML * 2; it += NGW) {
        const int tok = it >> 1, k = it & 1;
        const int e = route[(size_t)tok * 8 + k], pos = route[(size_t)tok * 8 + 2 + k];
        const int slot = (int)F.MISC[16 + e] * 256 + pos;
        const v4u* src = (const v4u*)(H + (size_t)tok * DM); v4u* dst = (v4u*)(HS + (size_t)slot * DM);
#pragma unroll
        for (int j = 0; j < 4; ++j) dst[lane + 64 * j] = src[lane + 64 * j];
        if (lane == 0) route[(size_t)tok * 8 + 6 + k] = slot;
    }
}
__device__ __forceinline__ void phase_final(Frame& F, const Args& A) {
    const int gw = F.vcu * NWAVES + F.wave, NGW = F.G * NWAVES, lane = F.lane;
    const float* mod = (const float*)(F.ws + WS_MOD) + (size_t)1 * 3 * MODW;
    const float* XA = (const float*)(F.ws + WS_XA); const float* YM = (const float*)(F.ws + WS_YM);
    const int* route = (const int*)(F.ws + WS_ROUTE);
    for (int row = gw; row < ML; row += NGW) {
        const int* rr = route + (size_t)row * 8;
        const float w0 = __builtin_bit_cast(float, rr[4]), w1 = __builtin_bit_cast(float, rr[5]);
        const float* y0 = YM + (size_t)rr[6] * DM; const float* y1 = YM + (size_t)rr[7] * DM;
        const float* g2 = mod + row_vec(row) * MODW + 5 * DM;
        f32x4 v[8]; float ss = 0.f;
#pragma unroll
        for (int j = 0; j < 8; ++j) { const int c = 4 * lane + 256 * j;
            const f32x4 x = *(const GAS f32x4*)(XA + (size_t)row * DM + c), a = *(const GAS f32x4*)(y0 + c), bb = *(const GAS f32x4*)(y1 + c), g = *(const GAS f32x4*)(g2 + c);
            v[j] = x + g * (a * w0 + bb * w1);
            ss += (v[j].x * v[j].x + v[j].y * v[j].y) + (v[j].z * v[j].z + v[j].w * v[j].w); }
        const float r = 1.0f / sqrtf(wave_sum(ss) * (1.0f / DM) + EPS);
#pragma unroll
        for (int j = 0; j < 8; ++j) { const int c = 4 * lane + 256 * j; const f32x4 g = *(const GAS f32x4*)(A.in[I_FNORM] + c);
            *(GAS f32x4*)(F.out + (size_t)row * DM + c) = v[j] * r * g; }
    }
}

#ifndef MK_N_LAUNCHES
#define MK_N_LAUNCHES 1
#endif
constexpr int NPH = 22;
__global__ void __launch_bounds__(NWAVES * 64, 2) hymba_fwd(Args args) {
    extern __shared__ __attribute__((aligned(16))) unsigned char lds[];
#define MKFRAME() Frame F; { int t_ = threadIdx.x; asm volatile("" : "+v"(t_)); unsigned char* w_ = args.ws; asm volatile("" : "+s"(w_)); unsigned lb_ = 0; asm volatile("" : "+s"(lb_)); \
    F.lds = (LAS unsigned char*)lds + lb_; F.ldsg = lds + lb_; F.MISC = (volatile LAS unsigned*)(F.lds + MISC_OFF); \
    F.tid = t_; F.lane = t_ & 63; F.wave = __builtin_amdgcn_readfirstlane(t_ >> 6); \
    F.G = gridDim.x; { const int bx = blockIdx.x; F.vcu = (F.G % 8 == 0) ? (bx % 8) * (F.G / 8) + bx / 8 : bx; } \
    F.ws = w_; F.out = args.out; F.ctl = (gu32*)(w_ + WS_CTL); }
    for (int u = threadIdx.x; u < (LDS_BYTES - LDSCTL_OFF) / 4; u += NWAVES * 64) ((LAS unsigned*)((LAS unsigned char*)lds + LDSCTL_OFF))[u] = 0u;
    __syncthreads();
    const int lo = args.ph_lo, hi = args.ph_hi;
    const bool multi = (hi - lo) > 1;
    XcdBarrier bar; bar.bar = (unsigned*)(args.ws + WS_CTL) + CW_BAR; bar.x = 0; bar.st = nullptr;
    if (multi) bar = xcd_barrier_post((unsigned*)(args.ws + WS_CTL) + CW_BAR, (volatile LAS unsigned*)((LAS unsigned char*)lds + MISC_OFF) + 8);
#define IN(k) (lo <= (k) && (k) < hi)
#define SEAM(k) do { if (IN((k) + 1)) xcd_barrier(bar); } while (0)

    if (IN(0)) { MKFRAME(); phase_pro_a(F, args); SEAM(0); }
    if (IN(1)) { MKFRAME(); phase_pro_b(F, args); SEAM(1); }
#pragma unroll 1
    for (int l = 0; l < 2; ++l) {
        const int pb = l ? 11 : 2;
        if (IN(pb + 0)) { MKFRAME(); phase_n1(F, args, l); SEAM(pb + 0); }
        if (IN(pb + 1)) {
            MKFRAME();
            pg8::Gemm g{(const pg8::bf16_t*)(F.ws + WS_H), (const pg8::bf16_t*)(F.ws + WS_WIN) + (size_t)l * NINP * DM, MT, NINP, DM};
            pg8::StaticOrder S; S.init(MT, NINP, F.G, (int)blockIdx.x);
            pg8::EpiBf16Plain E{(pg8::bf16_t*)(F.ws + WS_P), NINP};
            pg8::gemm_phase<pg8::EpiBf16Plain, pg8::StaticOrder, PG8_ALIGN, PG8_SP2>(F.lds, g, S, E);
            SEAM(pb + 1);
        }
        if (IN(pb + 2)) { MKFRAME(); phase_prep(F, args, l); SEAM(pb + 2); }
        if (IN(pb + 3)) { MKFRAME(); phase_mix(F, args, l); SEAM(pb + 3); }
        if (IN(pb + 4)) { MKFRAME(); phase_merge(F, args, l); SEAM(pb + 4); }
        if (IN(pb + 5)) {
            const int M = l == 0 ? MT : ML;
            MKFRAME();
            pg8::Gemm g{(const pg8::bf16_t*)(F.ws + WS_OB), (const pg8::bf16_t*)(F.ws + WS_WOUT) + (size_t)l * DM * DM, M, DM, DM};
            pg8::StaticOrder S; S.init(M, DM, F.G, (int)blockIdx.x);
            const float* bL = l == 0 ? args.in[I_X] : (const float*)(F.ws + WS_XB);
            const float* bC = l == 0 ? args.in[I_CTX] : (const float*)(F.ws + WS_XB) + (size_t)ML * DM;
            pg8::EpiResGate E{bL, bC, (float*)(F.ws + WS_XA), (const float*)(F.ws + WS_MOD) + (size_t)l * 3 * MODW + 2 * DM};
            pg8::gemm_phase<pg8::EpiResGate, pg8::StaticOrder, PG8_ALIGN, PG8_SP2>(F.lds, g, S, E);
            SEAM(pb + 5);
        }
        if (IN(pb + 6)) { MKFRAME(); phase_n2(F, args, l); SEAM(pb + 6); }
        if (l == 0) {
        if (IN(9)) {
            MKFRAME();
            pg8::Gemm g{(const pg8::bf16_t*)(F.ws + WS_H), (const pg8::bf16_t*)(F.ws + WS_W13), MT, 2 * DFF, DM};
            pg8::StaticOrder S; S.init(MT, 2 * DFF, F.G, (int)blockIdx.x);
            pg8::EpiSwiglu E{(pg8::bf16_t*)(F.ws + WS_ACT), DFF};
            pg8::gemm_phase<pg8::EpiSwiglu, pg8::StaticOrder, PG8_ALIGN, PG8_SP2>(F.lds, g, S, E);
            SEAM(9);
        }
        if (IN(10)) {
            MKFRAME();
            pg8::Gemm g{(const pg8::bf16_t*)(F.ws + WS_ACT), (const pg8::bf16_t*)(F.ws + WS_W2), MT, DM, DFF};
            pg8::StaticOrder S; S.init(MT, DM, F.G, (int)blockIdx.x);
            pg8::EpiResGate E{(const float*)(F.ws + WS_XA), (const float*)(F.ws + WS_XA) + (size_t)ML * DM, (float*)(F.ws + WS_XB), (const float*)(F.ws + WS_MOD) + 5 * DM};
            pg8::gemm_phase<pg8::EpiResGate, pg8::StaticOrder, PG8_ALIGN, PG8_SP2>(F.lds, g, S, E);
            SEAM(10);
        }
        }
    }
    if (IN(18)) { MKFRAME(); phase_gather(F); SEAM(18); }
    if (IN(19)) {
        MKFRAME();
        moe_tiles(F);
        pg8::Gemm g{(const pg8::bf16_t*)(F.ws + WS_HS), (const pg8::bf16_t*)(F.ws + WS_WM13), MSLOT, 2 * DFE, DM};
        pg8::MoeOrder S; S.init(F.MISC + 16, (2 * DFE) / 256, F.G, (int)blockIdx.x);
        pg8::EpiSwiglu E{(pg8::bf16_t*)(F.ws + WS_ACTM), DFE};
        pg8::gemm_phase<pg8::EpiSwiglu, pg8::MoeOrder, PG8_ALIGN, PG8_SP2>(F.lds, g, S, E);
        SEAM(19);
    }
    if (IN(20)) {
        MKFRAME();
        moe_tiles(F);
        pg8::Gemm g{(const pg8::bf16_t*)(F.ws + WS_ACTM), (const pg8::bf16_t*)(F.ws + WS_WM2), MSLOT, DM, DFE};
        pg8::MoeOrder S; S.init(F.MISC + 16, DM / 256, F.G, (int)blockIdx.x);
        pg8::EpiF32Plain E{(float*)(F.ws + WS_YM), DM};
        pg8::gemm_phase<pg8::EpiF32Plain, pg8::MoeOrder, PG8_ALIGN, PG8_SP2>(F.lds, g, S, E);
        SEAM(20);
    }
    if (IN(21)) { MKFRAME(); phase_final(F, args); }
#undef IN
#undef MKFRAME
#undef SEAM
}

extern "C" void kernel_launch(void* const* d_in, const int* in_sizes, int n_in, void* d_out, int out_size, void* d_ws, size_t ws_size, hipStream_t stream) {
    static int grid = 0;
    if (grid == 0) {
        if (n_in != 28 || out_size != ML * DM || ws_size < WS_END) { fprintf(stderr, "kernel_launch: unexpected shapes: n_in %d out %d ws %zu (need %zu)\n", n_in, out_size, ws_size, (size_t)WS_END); grid = -1; return; }
        int dev = 0, cus = 0, per_cu = 0;
        if (hipGetDevice(&dev) != hipSuccess || hipDeviceGetAttribute(&cus, hipDeviceAttributeMultiprocessorCount, dev) != hipSuccess) { grid = -1; return; }
        if (hipFuncSetAttribute((const void*)hymba_fwd, hipFuncAttributeMaxDynamicSharedMemorySize, LDS_BYTES) != hipSuccess) { fprintf(stderr, "kernel_launch: hipFuncSetAttribute failed\n"); grid = -1; return; }
        if (hipOccupancyMaxActiveBlocksPerMultiprocessor(&per_cu, (const void*)hymba_fwd, NWAVES * 64, LDS_BYTES) != hipSuccess || per_cu < 1)
            fprintf(stderr, "kernel_launch: note: occupancy query reports %d workgroups per CU\n", per_cu);
        (void)hipGetLastError();
        grid = cus;
    }
    if (grid < 0) return;
    if (hipMemsetAsync((char*)d_ws + WS_CTL, 0, CTL_ZERO_BYTES, stream) != hipSuccess) { fprintf(stderr, "kernel_launch: memset failed\n"); return; }
    Args a{};
    for (int i = 0; i < 28; ++i) a.in[i] = (const float*)d_in[i];
    a.out = (float*)d_out; a.ws = (unsigned char*)d_ws;
#if MK_N_LAUNCHES == 1
    a.ph_lo = 0; a.ph_hi = NPH;
    hipLaunchKernelGGL(hymba_fwd, dim3(grid), dim3(NWAVES * 64), LDS_BYTES, stream, a);
#else
    for (int ph = 0; ph < NPH; ++ph) {
        a.ph_lo = ph; a.ph_hi = ph + 1;
        hipLaunchKernelGGL(hymba_fwd, dim3(grid), dim3(NWAVES * 64), LDS_BYTES, stream, a);
    }
#endif
    const hipError_t le = hipPeekAtLastError();
    if (le != hipSuccess) fprintf(stderr, "kernel_launch: launch failed: %s\n", hipGetErrorName(le));
}
```

```cpp
#include <hip/hip_runtime.h>
#include <hip/hip_bf16.h>
#include <cstdio>
#include <cstdint>
#include <cmath>

namespace pg8 {
#define PG8_LAS __attribute__((address_space(3)))
typedef unsigned short bf16_t;
typedef short bf16x8 __attribute__((ext_vector_type(8)));
typedef float f32x4 __attribute__((ext_vector_type(4)));
typedef unsigned u32x4 __attribute__((ext_vector_type(4)));
typedef int i32x8 __attribute__((ext_vector_type(8)));
constexpr int BM = 256, BK = 64, HALF = 128, HTB = HALF * BK * 2  , STAGE_BYTES = 8 * HTB, NXCD = 8, WGM = 8;

__host__ __device__ __forceinline__ int lds_byte(int r, int c) { const int st = (r >> 4) * 2 + (c >> 5), rr = r & 15, cc = c & 31, ob = rr * 64 + cc * 2; return st * 1024 + (ob ^ (((ob >> 9) & 1) << 5)); }
__host__ __device__ __forceinline__ void stage_rc(int b, int& R, int& C) { const int st = b / 1024, sb = b % 1024, swz = sb ^ (((sb >> 9) & 1) << 5); R = (st >> 1) * 16 + swz / 64; C = (st & 1) * 32 + (swz % 64) / 2; }
__host__ __device__ __forceinline__ int perm32(int rho) { const int n = rho >> 4, i = rho & 15; return 8 * (i >> 2) + 4 * n + (i & 3); }

struct Unit { int pm, pn, pb, koff, ks; };
struct Gemm { const bf16_t* A; const bf16_t* Bt; int M, N, K, wid, nt, sw, sa; };

struct StaticOrder {
    int nM, nN, nwg, G, c;
    __host__ __device__ void init(int M, int N, int G_, int c_) { nM = M / BM; nN = N / BM; nwg = nM * nN; G = G_; c = c_; }
    __device__ bool next(int i, Unit& u) const {
        const long L = (long)i * G + c; if (L >= nwg) return false;
        int wgid = (int)L; { const int q = nwg / NXCD, r = nwg % NXCD, xcd = wgid % NXCD, off = wgid / NXCD; wgid = (xcd < r ? xcd * (q + 1) : r * (q + 1) + (xcd - r) * q) + off; }
        const int nig = WGM * nN, gid = wgid / nig, fm = gid * WGM, gsz = (nM - fm) < WGM ? (nM - fm) : WGM;
        u.pm = fm + ((wgid % nig) % gsz); u.pn = (wgid % nig) / gsz; u.pm = __builtin_amdgcn_readfirstlane(u.pm); u.pn = __builtin_amdgcn_readfirstlane(u.pn); u.pb = u.pn; u.koff = 0; u.ks = 0; return true;
    }
    __device__ __forceinline__ void a_ready(const Unit&) const {}
    __device__ __forceinline__ void done(const Unit&) const {}
};

__device__ __forceinline__ unsigned cvt_pk_bf16(float lo, float hi) { unsigned r; asm volatile("v_cvt_pk_bf16_f32 %0, %1, %2" : "=v"(r) : "v"(lo), "v"(hi)); return r; }

struct EpiBf16Plain {
    static constexpr bool PERM = true, AFTER_DRAIN = false;
    bf16_t* O; int ldc;
    __device__ __forceinline__ void operator()(const f32x4 (&acc)[2][2][4][2], const Unit& u, int wr, int wc, int fr, int fq) const {
        const int row0 = u.pm * BM + wr * 64 + fr, col0 = u.pn * BM + wc * 32 + 8 * fq;
#pragma unroll
        for (int ai = 0; ai < 2; ++ai)
#pragma unroll
            for (int m = 0; m < 4; ++m) { bf16_t* rowp = O + (size_t)(row0 + ai * HALF + m * 16) * ldc + col0;
#pragma unroll
                for (int bj = 0; bj < 2; ++bj) { const f32x4 v0 = acc[ai][bj][m][0], v1 = acc[ai][bj][m][1];
                    u32x4 w; w.x = cvt_pk_bf16(v0[0], v0[1]); w.y = cvt_pk_bf16(v0[2], v0[3]); w.z = cvt_pk_bf16(v1[0], v1[1]); w.w = cvt_pk_bf16(v1[2], v1[3]);
                    *(u32x4*)(rowp + bj * HALF) = w; } }
    }
};
struct EpiResGate {
    static constexpr bool PERM = false, AFTER_DRAIN = false;
    const float* baseL; const float* baseC; float* out; const float* gate;
    __device__ __forceinline__ void operator()(const f32x4 (&acc)[2][2][4][2], const Unit& u, int wr, int wc, int fr, int fq) const {
        const int row0 = u.pm * BM + wr * 64 + fr, col0 = u.pn * BM + wc * 32 + 4 * fq;
        const int v = u.pm < 16 ? 0 : (u.pm < 32 ? 1 : 2);
        const float* gp = gate + v * 12288 + col0;
        f32x4 gv[2][2];
#pragma unroll
        for (int bj = 0; bj < 2; ++bj)
#pragma unroll
            for (int n = 0; n < 2; ++n) gv[bj][n] = *(const f32x4*)(gp + bj * HALF + n * 16);
#pragma unroll
        for (int ai = 0; ai < 2; ++ai)
#pragma unroll
            for (int m = 0; m < 4; ++m) { const int row = row0 + ai * HALF + m * 16;
                const float* bp = (row < 8192 ? baseL + (size_t)row * 2048 : baseC + (size_t)(row - 8192) * 2048) + col0; float* op = out + (size_t)row * 2048 + col0;
#pragma unroll
                for (int bj = 0; bj < 2; ++bj)
#pragma unroll
                    for (int n = 0; n < 2; ++n) { const f32x4 b = *(const f32x4*)(bp + bj * HALF + n * 16); *(f32x4*)(op + bj * HALF + n * 16) = b + gv[bj][n] * acc[ai][bj][m][n]; } }
    }
};
__device__ __forceinline__ float silu_f(float v) { return v * __builtin_amdgcn_rcpf(1.0f + __expf(-v)); }
struct EpiSwiglu {
    static constexpr bool PERM = true, AFTER_DRAIN = false;
    bf16_t* O; int ldc;
    __device__ __forceinline__ void operator()(const f32x4 (&acc)[2][2][4][2], const Unit& u, int wr, int wc, int fr, int fq) const {
        const int row0 = u.pm * BM + wr * 64 + fr, col0 = u.pn * HALF + wc * 32 + 8 * fq;
#pragma unroll
        for (int ai = 0; ai < 2; ++ai)
#pragma unroll
            for (int m = 0; m < 4; ++m) { bf16_t* rowp = O + (size_t)(row0 + ai * HALF + m * 16) * ldc + col0;
                f32x4 a0, a1;
#pragma unroll
                for (int j = 0; j < 4; ++j) { a0[j] = silu_f(acc[ai][0][m][0][j]) * acc[ai][1][m][0][j]; a1[j] = silu_f(acc[ai][0][m][1][j]) * acc[ai][1][m][1][j]; }
                u32x4 w; w.x = cvt_pk_bf16(a0[0], a0[1]); w.y = cvt_pk_bf16(a0[2], a0[3]); w.z = cvt_pk_bf16(a1[0], a1[1]); w.w = cvt_pk_bf16(a1[2], a1[3]);
                *(u32x4*)rowp = w; }
    }
};
__device__ __forceinline__ float sat_fp8(float v) { return __builtin_amdgcn_fmed3f(v, -448.0f, 448.0f); }
__device__ __forceinline__ unsigned pack_fp8x4(float a, float b, float c, float d) { int r = __builtin_amdgcn_cvt_pk_fp8_f32(sat_fp8(a), sat_fp8(b), 0, false); r = __builtin_amdgcn_cvt_pk_fp8_f32(sat_fp8(c), sat_fp8(d), r, true); return (unsigned)r; }
struct EpiSwiglu8 {
    static constexpr bool PERM = true, AFTER_DRAIN = false;
    unsigned char* O; int ldc; float oscale;
    __device__ __forceinline__ void operator()(const f32x4 (&acc)[2][2][4][2], const Unit& u, int wr, int wc, int fr, int fq) const {
        const int row0 = u.pm * BM + wr * 64 + fr, col0 = u.pn * HALF + wc * 32 + 8 * fq;
#pragma unroll
        for (int ai = 0; ai < 2; ++ai)
#pragma unroll
            for (int m = 0; m < 4; ++m) { unsigned char* rowp = O + (size_t)(row0 + ai * HALF + m * 16) * ldc + col0;
                f32x4 a0, a1;
#pragma unroll
                for (int j = 0; j < 4; ++j) { a0[j] = silu_f(acc[ai][0][m][0][j]) * acc[ai][1][m][0][j] * oscale; a1[j] = silu_f(acc[ai][0][m][1][j]) * acc[ai][1][m][1][j] * oscale; }
                typedef unsigned u32x2 __attribute__((ext_vector_type(2)));
                u32x2 w; w.x = pack_fp8x4(a0[0], a0[1], a0[2], a0[3]); w.y = pack_fp8x4(a1[0], a1[1], a1[2], a1[3]);
                *(u32x2*)rowp = w; }
    }
};
struct EpiF32Plain {
    static constexpr bool PERM = false, AFTER_DRAIN = false;
    float* C; int ldc;
    __device__ __forceinline__ void operator()(const f32x4 (&acc)[2][2][4][2], const Unit& u, int wr, int wc, int fr, int fq) const {
        const int row0 = u.pm * BM + wr * 64 + fr, col0 = u.pn * BM + wc * 32 + 4 * fq;
#pragma unroll
        for (int ai = 0; ai < 2; ++ai)
#pragma unroll
            for (int m = 0; m < 4; ++m) { float* rowp = C + (size_t)(row0 + ai * HALF + m * 16) * ldc + col0;
#pragma unroll
                for (int bj = 0; bj < 2; ++bj)
#pragma unroll
                    for (int n = 0; n < 2; ++n) *(f32x4*)(rowp + bj * HALF + n * 16) = acc[ai][bj][m][n]; }
    }
};
struct MoeOrder {
    int nM, nN, nwg, G, c; int t1, t2, t3, t4, t5, t6, t7; int hi;
    __device__ __forceinline__ void init(const volatile PG8_LAS unsigned* ts, int nN_, int G_, int c_) {
        t1 = __builtin_amdgcn_readfirstlane((int)ts[1]); t2 = __builtin_amdgcn_readfirstlane((int)ts[2]); t3 = __builtin_amdgcn_readfirstlane((int)ts[3]); t4 = __builtin_amdgcn_readfirstlane((int)ts[4]);
        t5 = __builtin_amdgcn_readfirstlane((int)ts[5]); t6 = __builtin_amdgcn_readfirstlane((int)ts[6]); t7 = __builtin_amdgcn_readfirstlane((int)ts[7]);
        nM = __builtin_amdgcn_readfirstlane((int)ts[8]); nN = nN_; nwg = nM * nN; G = G_; c = c_; hi = nwg; }
    __device__ __forceinline__ void decode(int L, Unit& u) const {
        int wgid = L; { const int q = nwg / NXCD, r = nwg % NXCD, xcd = wgid % NXCD, off = wgid / NXCD; wgid = (xcd < r ? xcd * (q + 1) : r * (q + 1) + (xcd - r) * q) + off; }
        const int nig = WGM * nN, gid = wgid / nig, fm = gid * WGM, gsz = (nM - fm) < WGM ? (nM - fm) : WGM;
        u.pm = fm + ((wgid % nig) % gsz); u.pn = (wgid % nig) / gsz;
        const int e = (u.pm >= t1) + (u.pm >= t2) + (u.pm >= t3) + (u.pm >= t4) + (u.pm >= t5) + (u.pm >= t6) + (u.pm >= t7);
        u.pb = e * nN + u.pn; u.koff = 0; u.ks = 0;
        u.pm = __builtin_amdgcn_readfirstlane(u.pm); u.pn = __builtin_amdgcn_readfirstlane(u.pn); u.pb = __builtin_amdgcn_readfirstlane(u.pb);
    }
    __device__ __forceinline__ bool next(int i, Unit& u) const {
        const int L = i * G + c; if (L >= hi) return false;
        decode(L, u); return true;
    }
    __device__ __forceinline__ void a_ready(const Unit&) const {}
    __device__ __forceinline__ void done(const Unit&) const {}
};
struct MoeTailOrder {
    MoeOrder M; int lo, S, kbytes;
    __device__ __forceinline__ bool next(int i, Unit& u) const {
        const int Lp = i * M.G + M.c; if (Lp >= (M.nwg - lo) * S) return false;
        M.decode(lo + Lp / S, u); u.ks = __builtin_amdgcn_readfirstlane(Lp % S); u.koff = __builtin_amdgcn_readfirstlane(u.ks * kbytes); return true;
    }
    __device__ __forceinline__ void a_ready(const Unit&) const {}
    __device__ __forceinline__ void done(const Unit&) const {}
};
struct EpiPartFlag {
    static constexpr bool PERM = false, AFTER_DRAIN = false;
    float* C; size_t slab; unsigned* flags; unsigned S;
    __device__ __forceinline__ void operator()(const f32x4 (&acc)[2][2][4][2], const Unit& u, int wr, int wc, int fr, int fq) const {
        const int row0 = u.pm * BM + wr * 64 + fr, col0 = u.pn * BM + wc * 32 + 4 * fq;
        float* base = C + (size_t)u.ks * slab;
        if (u.ks == 0 && wr == 0 && wc == 0 && fr == 0 && fq == 0) flags[u.pm * 8 + u.pn] = S;
#pragma unroll
        for (int ai = 0; ai < 2; ++ai)
#pragma unroll
            for (int m = 0; m < 4; ++m) { float* rowp = base + (size_t)(row0 + ai * HALF + m * 16) * 2048 + col0;
#pragma unroll
                for (int bj = 0; bj < 2; ++bj)
#pragma unroll
                    for (int n = 0; n < 2; ++n) *(f32x4*)(rowp + bj * HALF + n * 16) = acc[ai][bj][m][n]; }
    }
};
struct SplitOrder {
    int nN, S, nwg, G, c, kbytes;
    __device__ __forceinline__ void init(int nM, int nN_, int S_, int kbytes_, int G_, int c_) { nN = nN_; S = S_; nwg = nM * nN_ * S_; G = G_; c = c_; kbytes = kbytes_; }
    __device__ __forceinline__ bool next(int i, Unit& u) const {
        const int L = i * G + c; if (L >= nwg) return false;
        u.ks = __builtin_amdgcn_readfirstlane(L % S); const int t = L / S; u.pn = __builtin_amdgcn_readfirstlane(t % nN); u.pm = __builtin_amdgcn_readfirstlane(t / nN); u.pb = u.pn; u.koff = u.ks * kbytes; return true;
    }
    __device__ __forceinline__ void a_ready(const Unit&) const {}
    __device__ __forceinline__ void done(const Unit&) const {}
};
struct EpiPart {
    static constexpr bool PERM = false, AFTER_DRAIN = false;
    float* C; int rows;
    __device__ __forceinline__ void operator()(const f32x4 (&acc)[2][2][4][2], const Unit& u, int wr, int wc, int fr, int fq) const {
        const int row0 = u.pm * BM + wr * 64 + fr, col0 = u.pn * BM + wc * 32 + 4 * fq;
        float* base = C + (size_t)u.ks * rows * 2048;
#pragma unroll
        for (int ai = 0; ai < 2; ++ai)
#pragma unroll
            for (int m = 0; m < 4; ++m) { float* rowp = base + (size_t)(row0 + ai * HALF + m * 16) * 2048 + col0;
#pragma unroll
                for (int bj = 0; bj < 2; ++bj)
#pragma unroll
                    for (int n = 0; n < 2; ++n) *(f32x4*)(rowp + bj * HALF + n * 16) = acc[ai][bj][m][n]; }
    }
};


template <class Epi, class Sched, bool ALIGN_EPI = false, bool SP2 = false, bool F8 = false>
__device__ __forceinline__ void gemm_phase(PG8_LAS unsigned char* lds, const Gemm g, const Sched& S, const Epi& E) {
    int tid_; asm volatile("v_mbcnt_lo_u32_b32 %0, -1, 0\n\tv_mbcnt_hi_u32_b32 %0, -1, %0" : "=v"(tid_)); tid_ += g.wid * 64; asm volatile("" : "+v"(tid_));
    const int tid = tid_, wid = __builtin_amdgcn_readfirstlane(tid >> 6), lane = tid & 63, wr = wid >> 2, wc = wid & 3, fr = lane & 15, fq = lane >> 4;
    const int K = g.K, nt = g.nt;
    unsigned voffA[2], voffB[2];
#pragma unroll
    for (int i = 0; i < 2; ++i) { int R, C; stage_rc(tid * 16 + i * 8192, R, C); const int Rb = Epi::PERM ? ((R & ~31) + perm32(R & 31)) : R;
        voffA[i] = (unsigned)(R * K + C) * 2u; voffB[i] = (unsigned)(Rb * K + C) * 2u; }
    const size_t q64 = (size_t)64 * K * 2;
    const size_t kstep = (size_t)(BK * 2);
    const size_t hstep = (size_t)HALF * K * 2;
    const size_t tstep = 2 * hstep;
    const unsigned ldsw = (unsigned)wid * 1024u;
    const int aoff = lds_byte(wr * 64 + fr, fq * 8), boff = lds_byte(wc * 32 + fr, fq * 8);
    PG8_LAS unsigned char* ldsa = lds + aoff; PG8_LAS unsigned char* ldsb = lds + 4 * HTB + boff;
    asm volatile("" : "+v"(ldsa), "+v"(ldsb));
#define PG8_SA(b, h) (((b) * 2 + (h)) * HTB)
#define PG8_SB(b, h) ((4 + (b) * 2 + (h)) * HTB)
#define PG8_STAGE(bufoff, gbase, voff) do { _Pragma("unroll") for (int _i = 0; _i < 2; ++_i) \
        __builtin_amdgcn_global_load_lds((const unsigned*)((const char*)(gbase) + (size_t)_i * q64 + (voff)[0]), (PG8_LAS unsigned*)(lds + (bufoff) + ldsw + _i * 8192), 16, 0, 0); } while (0)
#define PG8_LD8(base, off) __builtin_shufflevector(*(const PG8_LAS u32x4*)((base) + (off)), *(const PG8_LAS u32x4*)((base) + (off) + 1024), 0, 1, 2, 3, 4, 5, 6, 7)
#define PG8_LDA(dst, b, h) do { if constexpr (F8) { _Pragma("unroll") for (int m = 0; m < 4; ++m) dst##8[m] = PG8_LD8(ldsa, PG8_SA(b, h) + m * 2048); } \
        else { _Pragma("unroll") for (int m = 0; m < 4; ++m) _Pragma("unroll") for (int k = 0; k < 2; ++k) dst[m][k] = *(const PG8_LAS bf16x8*)(ldsa + PG8_SA(b, h) + m * 2048 + k * 1024); } } while (0)
#define PG8_LDB(dst, b, h) do { if constexpr (F8) { _Pragma("unroll") for (int n = 0; n < 2; ++n) dst##8[n] = PG8_LD8(ldsb, PG8_SB(b, h) - 4 * HTB + n * 2048); } \
        else { _Pragma("unroll") for (int n = 0; n < 2; ++n) _Pragma("unroll") for (int k = 0; k < 2; ++k) dst[n][k] = *(const PG8_LAS bf16x8*)(ldsb + PG8_SB(b, h) - 4 * HTB + n * 2048 + k * 1024); } } while (0)
#define PG8_MMA(ai, bj, At, Bt) do { __builtin_amdgcn_s_setprio(1); \
        if constexpr (F8) { _Pragma("unroll") for (int m = 0; m < 4; ++m) _Pragma("unroll") for (int n = 0; n < 2; ++n) \
            acc[ai][bj][m][n] = __builtin_amdgcn_mfma_scale_f32_16x16x128_f8f6f4(__builtin_bit_cast(i32x8, Bt##8[n]), __builtin_bit_cast(i32x8, At##8[m]), acc[ai][bj][m][n], 0, 0, 0, g.sw, 0, g.sw); } \
        else { _Pragma("unroll") for (int m = 0; m < 4; ++m) _Pragma("unroll") for (int n = 0; n < 2; ++n) _Pragma("unroll") for (int k = 0; k < 2; ++k) \
            acc[ai][bj][m][n] = __builtin_amdgcn_mfma_f32_16x16x32_bf16(Bt[n][k], At[m][k], acc[ai][bj][m][n], 0, 0, 0); } \
        __builtin_amdgcn_s_setprio(0); } while (0)
#define PG8_WAIT_V(n) asm volatile("s_waitcnt vmcnt(" #n ")" ::: "memory")
#define PG8_WAIT_L(n) asm volatile("s_waitcnt lgkmcnt(" #n ")" ::: "memory")
#define PG8_BAR __builtin_amdgcn_s_barrier()
#define PG8_SCHED __builtin_amdgcn_sched_barrier(0)
    Unit cur, nxt; int ui = 0;
    if (!S.next(0, cur)) return;
    f32x4 acc[2][2][4][2];
#pragma unroll
    for (int a = 0; a < 2; ++a)
#pragma unroll
        for (int b = 0; b < 2; ++b)
#pragma unroll
            for (int m = 0; m < 4; ++m)
#pragma unroll
                for (int n = 0; n < 2; ++n) acc[a][b][m][n] = (f32x4){0.f, 0.f, 0.f, 0.f};
    bf16x8 At[4][2], B0[2][2], B1[2][2];
    typedef unsigned u32x8 __attribute__((ext_vector_type(8)));
    u32x8 At8[4], B08[2], B18[2];
    const char* cA = (const char*)g.A + (size_t)cur.pm * tstep + cur.koff; const char* cB = (const char*)g.Bt + (size_t)cur.pb * tstep + cur.koff;
    S.a_ready(cur);
    if constexpr (SP2) {
        PG8_STAGE(PG8_SB(0, 0), cB, voffB); PG8_STAGE(PG8_SB(0, 1), cB + hstep, voffB); PG8_STAGE(PG8_SA(0, 0), cA, voffA); PG8_STAGE(PG8_SA(0, 1), cA + hstep, voffA);
        if (wr == 1) PG8_BAR;
        PG8_WAIT_V(2); PG8_BAR;
        PG8_STAGE(PG8_SB(1, 0), cB + kstep, voffB); PG8_STAGE(PG8_SA(1, 0), cA + kstep, voffA); PG8_STAGE(PG8_SB(1, 1), cB + hstep + kstep, voffB);
        PG8_WAIT_V(6); PG8_BAR;
    } else {
        PG8_STAGE(PG8_SB(0, 0), cB, voffB); PG8_STAGE(PG8_SA(0, 0), cA, voffA); PG8_STAGE(PG8_SB(0, 1), cB + hstep, voffB); PG8_STAGE(PG8_SA(0, 1), cA + hstep, voffA);
        if (wr == 1) PG8_BAR;
        PG8_WAIT_V(4); PG8_BAR;
        PG8_STAGE(PG8_SB(1, 0), cB + kstep, voffB); PG8_STAGE(PG8_SA(1, 0), cA + kstep, voffA); PG8_STAGE(PG8_SB(1, 1), cB + hstep + kstep, voffB);
        PG8_WAIT_V(6); PG8_BAR;
    }
    for (;;) {
        const bool has_next = S.next(ui + 1, nxt);
        const char* nA = has_next ? (const char*)g.A + (size_t)nxt.pm * tstep + nxt.koff : cA; const char* nB = has_next ? (const char*)g.Bt + (size_t)nxt.pb * tstep + nxt.koff : cB;
#pragma unroll 1
        for (int t = 0; t < nt; t += 2) {
            const bool last = (t == nt - 2);
            const char* a1 = cA + (size_t)(t + 1) * kstep;
            const char* a2 = last ? nA : cA + (size_t)(t + 2) * kstep; const char* b2 = last ? nB : cB + (size_t)(t + 2) * kstep;
            const char* a3 = a2 + kstep; const char* b3 = b2 + kstep;
            if (last && has_next) S.a_ready(nxt);
            if constexpr (SP2) {
            PG8_LDB(B0, 0, 0); PG8_LDB(B1, 0, 1); PG8_SCHED; PG8_LDA(At, 0, 0); PG8_STAGE(PG8_SA(1, 1), a1 + hstep, voffA);
            PG8_WAIT_V(8); PG8_WAIT_L(0); PG8_BAR; PG8_MMA(0, 0, At, B0); PG8_MMA(0, 1, At, B1); PG8_BAR; PG8_SCHED;
            PG8_LDA(At, 0, 1); PG8_STAGE(PG8_SB(0, 0), b2, voffB); PG8_STAGE(PG8_SB(0, 1), b2 + hstep, voffB); PG8_STAGE(PG8_SA(0, 0), a2, voffA);
            PG8_WAIT_V(8); PG8_WAIT_L(0); PG8_BAR; PG8_MMA(1, 0, At, B0); PG8_MMA(1, 1, At, B1); PG8_BAR; PG8_SCHED;
            PG8_LDB(B0, 1, 0); PG8_LDB(B1, 1, 1); PG8_SCHED; PG8_LDA(At, 1, 0); PG8_STAGE(PG8_SA(0, 1), a2 + hstep, voffA);
            PG8_WAIT_V(8); PG8_WAIT_L(0); PG8_BAR; PG8_MMA(0, 0, At, B0); PG8_MMA(0, 1, At, B1); PG8_BAR; PG8_SCHED;
            PG8_LDA(At, 1, 1); PG8_STAGE(PG8_SB(1, 0), b3, voffB); PG8_STAGE(PG8_SB(1, 1), b3 + hstep, voffB); PG8_STAGE(PG8_SA(1, 0), a3, voffA);
            PG8_WAIT_V(8); PG8_WAIT_L(0); PG8_BAR; PG8_MMA(1, 0, At, B0); PG8_MMA(1, 1, At, B1); PG8_BAR; PG8_SCHED;
            } else {
            PG8_LDB(B0, 0, 0); PG8_SCHED; PG8_LDA(At, 0, 0); PG8_STAGE(PG8_SA(1, 1), a1 + hstep, voffA);
            PG8_WAIT_L(8); PG8_BAR; PG8_WAIT_L(0); PG8_MMA(0, 0, At, B0); PG8_BAR; PG8_SCHED;
            PG8_LDB(B1, 0, 1); PG8_STAGE(PG8_SB(0, 0), b2, voffB);
            PG8_BAR; PG8_WAIT_L(0); PG8_MMA(0, 1, At, B1); PG8_BAR;
            PG8_LDA(At, 0, 1); PG8_STAGE(PG8_SA(0, 0), a2, voffA);
            PG8_BAR; PG8_WAIT_L(0); PG8_MMA(1, 0, At, B0); PG8_BAR; PG8_SCHED;
            PG8_STAGE(PG8_SB(0, 1), b2 + hstep, voffB);
            PG8_WAIT_V(6); PG8_BAR; PG8_MMA(1, 1, At, B1); PG8_BAR;
            PG8_LDB(B0, 1, 0); PG8_SCHED; PG8_LDA(At, 1, 0); PG8_STAGE(PG8_SA(0, 1), a2 + hstep, voffA);
            PG8_WAIT_L(8); PG8_BAR; PG8_WAIT_L(0); PG8_MMA(0, 0, At, B0); PG8_BAR; PG8_SCHED;
            PG8_LDB(B1, 1, 1); PG8_STAGE(PG8_SB(1, 0), b3, voffB);
            PG8_BAR; PG8_WAIT_L(0); PG8_MMA(0, 1, At, B1); PG8_BAR;
            PG8_LDA(At, 1, 1); PG8_STAGE(PG8_SA(1, 0), a3, voffA);
            PG8_BAR; PG8_WAIT_L(0); PG8_MMA(1, 0, At, B0); PG8_BAR; PG8_SCHED;
            PG8_STAGE(PG8_SB(1, 1), b3 + hstep, voffB);
            PG8_WAIT_V(6); PG8_BAR; PG8_MMA(1, 1, At, B1); PG8_BAR;
            }
        }
        if constexpr (ALIGN_EPI) { if (wr == 0) PG8_BAR; }
        if constexpr (!Epi::AFTER_DRAIN) { int l2_; asm volatile("v_mbcnt_lo_u32_b32 %0, -1, 0\n\tv_mbcnt_hi_u32_b32 %0, -1, %0" : "=v"(l2_));
            E(acc, cur, wr, wc, l2_ & 15, l2_ >> 4); S.done(cur); }
        if (!has_next) break;
#pragma unroll
        for (int a = 0; a < 2; ++a)
#pragma unroll
            for (int b = 0; b < 2; ++b)
#pragma unroll
                for (int m = 0; m < 4; ++m)
#pragma unroll
                    for (int n = 0; n < 2; ++n) acc[a][b][m][n] = (f32x4){0.f, 0.f, 0.f, 0.f};
        cur = nxt; cA = nA; cB = nB; ++ui;
        if constexpr (ALIGN_EPI) { if (wr == 1) PG8_BAR; }
    }
    PG8_WAIT_V(0);
    if constexpr (!ALIGN_EPI) { if (wr == 0) PG8_BAR; }
    PG8_BAR;
    if constexpr (Epi::AFTER_DRAIN) { E.fused(acc, cur, wr, wc, fr, fq, lds, wid, lane); S.done(cur); }
#undef PG8_SA
#undef PG8_SB
#undef PG8_STAGE
#undef PG8_LDA
#undef PG8_LDB
#undef PG8_MMA
#undef PG8_LD8
#undef PG8_WAIT_V
#undef PG8_WAIT_L
#undef PG8_BAR
#undef PG8_SCHED
}
}

namespace att {
using bf16 = __hip_bfloat16;
constexpr int   D = 128, NW = 8, QBLK = 32, KVBLK = 64;
constexpr float SCALE = 0.088388347648318440f;
constexpr float THR = 8.f;
constexpr int SDEPTH = 1;
constexpr int LDQ = 512, LDK = 256;
constexpr size_t SHM_V = KVBLK * D * 2, SHM_K = KVBLK * D * 2, SHM_ATTN = 2 * SHM_V + 2 * SHM_K + NW * 64 * 4;
using bf16x8 = __attribute__((ext_vector_type(8))) short;
using s16x4  = __attribute__((ext_vector_type(4))) short;
using f32x16 = __attribute__((ext_vector_type(16))) float;
using f32x8  = __attribute__((ext_vector_type(8))) float;
using u32x4  = __attribute__((ext_vector_type(4))) unsigned;
#define KSWZ(row, colB) ((row) * 256 + ((colB) ^ (((row) & 7) << 4)))
#define SBAR() __builtin_amdgcn_sched_barrier(0)
__device__ __forceinline__ int crow(int r, int hi) { return (r & 3) + 8 * (r >> 2) + 4 * hi; }
__device__ __forceinline__ unsigned cvtpk(float lo, float hi) {
  unsigned r; asm volatile("v_cvt_pk_bf16_f32 %0, %1, %2" : "=v"(r) : "v"(lo), "v"(hi)); return r;
}
template <typename TIn> struct Stage;
template <> struct Stage<bf16>  { using T = bf16x8;
  __device__ static __forceinline__ T ld8(const bf16* p) { return *reinterpret_cast<const bf16x8*>(p); }
  __device__ static __forceinline__ bf16x8 tobf(T x) { return x; } };
template <> struct Stage<float> { using T = f32x8;
  __device__ static __forceinline__ T ld8(const float* p) { return *reinterpret_cast<const f32x8*>(p); }
  __device__ static __forceinline__ bf16x8 tobf(T x) {
    u32x4 w = {cvtpk(x[0], x[1]), cvtpk(x[2], x[3]), cvtpk(x[4], x[5]), cvtpk(x[6], x[7])}; return *reinterpret_cast<bf16x8*>(&w); } };

__device__ __forceinline__ void partialSM(f32x16& p0, f32x16& p1, float& m_reg, float& mn, float& alpha) {
  constexpr float C = SCALE * 1.4426950408889634f;
  float pmax = p0[0]; for (int r = 1; r < 16; ++r) pmax = fmaxf(pmax, p0[r]); for (int r = 0; r < 16; ++r) pmax = fmaxf(pmax, p1[r]);
  { auto rr = __builtin_amdgcn_permlane32_swap(__float_as_uint(pmax), __float_as_uint(pmax), false, false);
    pmax = fmaxf(__uint_as_float(rr[0]), __uint_as_float(rr[1])); }
  if (__builtin_expect(__all(pmax - m_reg <= THR / SCALE), 1)) { mn = m_reg; alpha = 1.f; }
  else { mn = fmaxf(m_reg, pmax); alpha = __builtin_amdgcn_exp2f((m_reg - mn) * C); m_reg = mn; }
  float mnC = -mn * C;
  for (int r = 0; r < 16; ++r) p0[r] = fmaf(p0[r], C, mnC); for (int r = 0; r < 16; ++r) p1[r] = fmaf(p1[r], C, mnC);
  for (int r = 0; r < 16; ++r) p0[r] = __builtin_amdgcn_exp2f(p0[r]);
}
__device__ __forceinline__ void finishSM(f32x16& p0, f32x16& p1, float alpha, float& l_reg, bf16x8& pa0, bf16x8& pa1, bf16x8& pa2, bf16x8& pa3) {
  for (int r = 0; r < 16; ++r) p1[r] = __builtin_amdgcn_exp2f(p1[r]);
  float ps = 0; for (int r = 0; r < 16; ++r) ps += p0[r]; for (int r = 0; r < 16; ++r) ps += p1[r];
  { auto rr = __builtin_amdgcn_permlane32_swap(__float_as_uint(ps), __float_as_uint(ps), false, false);
    ps = __uint_as_float(rr[0]) + __uint_as_float(rr[1]); }
  l_reg = l_reg * alpha + ps;
#define PK4(P, BASE, OUT) do { unsigned a0 = cvtpk(P[BASE + 0], P[BASE + 1]), a1 = cvtpk(P[BASE + 2], P[BASE + 3]);   \
    unsigned b0 = cvtpk(P[BASE + 4], P[BASE + 5]), b1 = cvtpk(P[BASE + 6], P[BASE + 7]);                              \
    auto r0 = __builtin_amdgcn_permlane32_swap(a0, b0, false, false); auto r1 = __builtin_amdgcn_permlane32_swap(a1, b1, false, false); \
    u32x4 w = {r0[0], r1[0], r0[1], r1[1]}; OUT = *reinterpret_cast<bf16x8*>(&w); } while (0)
  PK4(p0, 0, pa0); PK4(p0, 8, pa1); PK4(p1, 0, pa2); PK4(p1, 8, pa3);
#undef PK4
}
__device__ __forceinline__ void qkt(f32x16& p0, f32x16& p1, const bf16* Ks, const bf16x8* qr, int r32, int hi) {
  p0 = f32x16{}; p1 = f32x16{};
  for (int d0 = 0; d0 < 8; ++d0) { int cb = (d0 * 16 + hi * 8) * 2;
    bf16x8 b0 = *reinterpret_cast<const bf16x8*>((const char*)Ks + KSWZ(r32, cb));
    bf16x8 b1 = *reinterpret_cast<const bf16x8*>((const char*)Ks + KSWZ(32 + r32, cb));
    p0 = __builtin_amdgcn_mfma_f32_32x32x16_bf16(b0, qr[d0], p0, 0, 0, 0);
    p1 = __builtin_amdgcn_mfma_f32_32x32x16_bf16(b1, qr[d0], p1, 0, 0, 0); }
}
__device__ __forceinline__ int v_st(int k, int c) { const int kk = (k & ~0xC) | ((k & 4) << 1) | ((k & 8) >> 1); return ((kk >> 3) * 4 + (c >> 5)) * 512 + ((kk & 7) * 32 + (c & 31)) * 2; }
__device__ __forceinline__ int v_rd_base(int lane) { return ((lane & 3) << 3) | (((lane >> 2) & 3) << 6) | (((lane >> 4) & 1) << 5) | (((lane >> 5) & 1) << 8); }
constexpr int v_rd_off(int d0, int ks, int half) { return d0 * 512 + ks * 4096 + half * 2048; }
template <int OFF> __device__ __forceinline__ s16x4 tr_read(int vb) {
  s16x4 r; asm volatile("ds_read_b64_tr_b16 %0, %1 offset:%2" : "=&v"(r) : "v"(vb), "i"(OFF) : "memory"); return r;
}
template <int D0> __device__ __forceinline__ void pv_one(f32x16& od, int vb, bf16x8 pa0, bf16x8 pa1, bf16x8 pa2, bf16x8 pa3) {
  const s16x4 l0 = tr_read<v_rd_off(D0, 0, 0)>(vb), h0 = tr_read<v_rd_off(D0, 0, 1)>(vb), l1 = tr_read<v_rd_off(D0, 1, 0)>(vb), h1 = tr_read<v_rd_off(D0, 1, 1)>(vb);
  const s16x4 l2 = tr_read<v_rd_off(D0, 2, 0)>(vb), h2 = tr_read<v_rd_off(D0, 2, 1)>(vb), l3 = tr_read<v_rd_off(D0, 3, 0)>(vb), h3 = tr_read<v_rd_off(D0, 3, 1)>(vb);
  asm volatile("s_waitcnt lgkmcnt(0)" ::: "memory"); SBAR();
#define PK(L, H) (bf16x8){L[0], L[1], L[2], L[3], H[0], H[1], H[2], H[3]}
  od = __builtin_amdgcn_mfma_f32_32x32x16_bf16(pa0, PK(l0, h0), od, 0, 0, 0);
  od = __builtin_amdgcn_mfma_f32_32x32x16_bf16(pa1, PK(l1, h1), od, 0, 0, 0);
  od = __builtin_amdgcn_mfma_f32_32x32x16_bf16(pa2, PK(l2, h2), od, 0, 0, 0);
  od = __builtin_amdgcn_mfma_f32_32x32x16_bf16(pa3, PK(l3, h3), od, 0, 0, 0);
#undef PK
}
__device__ __forceinline__ void pv_d0(f32x16* o, int vb, bf16x8 pa0, bf16x8 pa1, bf16x8 pa2, bf16x8 pa3) {
  pv_one<0>(o[0], vb, pa0, pa1, pa2, pa3); pv_one<1>(o[1], vb, pa0, pa1, pa2, pa3); pv_one<2>(o[2], vb, pa0, pa1, pa2, pa3); pv_one<3>(o[3], vb, pa0, pa1, pa2, pa3);
}

template <typename TQ, int LDO>
__device__ __forceinline__ void attn_dense_body(const TQ* __restrict__ Qb, const bf16* __restrict__ Kh, const bf16* __restrict__ Vh,
                                                float* __restrict__ Ob, int seq, char* lds, int wid_s, float* __restrict__ st) {
  using St = Stage<bf16>; using SQ = Stage<TQ>;
  int tid_; asm volatile("v_mbcnt_lo_u32_b32 %0, -1, 0\n\tv_mbcnt_hi_u32_b32 %0, -1, %0" : "=v"(tid_)); tid_ += wid_s * 64; asm volatile("" : "+v"(tid_));
  const int tid = tid_, wid = tid >> 6, lane = tid & 63, r32 = lane & 31, hi = lane >> 5;
  bf16* V_lds = (bf16*)lds; bf16* K_lds = (bf16*)(lds + 2 * SHM_V);
  float* ws = (float*)(lds + 2 * SHM_V + 2 * SHM_K) + wid * 64; float* li_l = ws; float* al_l = ws + 32;
  float m_reg = -1e30f, l_reg = 0; f32x16 o[4] = {}; bf16x8 qr[8];
  const TQ* Qw = Qb + (long)(wid * QBLK + r32) * LDQ + hi * 8;
#pragma unroll
  for (int d0 = 0; d0 < 8; ++d0) qr[d0] = SQ::tobf(SQ::ld8(Qw + d0 * 16));
  const int sr = tid >> 4, sc = (tid & 15) * 8, vst0 = v_st(sr, sc), vst1 = v_st(32 + sr, sc);
  const int vb0 = (int)(uintptr_t)V_lds + v_rd_base(lane);
  struct { typename St::T vs0, vs1, ks0, ks1; } sr_[SDEPTH];
#define SLOAD(i, k0) do { sr_[i].vs0 = St::ld8(&Vh[(long)((k0) + sr) * LDK + sc]); sr_[i].vs1 = St::ld8(&Vh[(long)((k0) + 32 + sr) * LDK + sc]); \
    sr_[i].ks0 = St::ld8(&Kh[(long)((k0) + sr) * LDK + sc]); sr_[i].ks1 = St::ld8(&Kh[(long)((k0) + 32 + sr) * LDK + sc]); } while (0)
#define SWRITE(b, i) do { *(bf16x8*)((char*)V_lds + (b) * SHM_V + vst0) = St::tobf(sr_[i].vs0);          \
    *(bf16x8*)((char*)V_lds + (b) * SHM_V + vst1) = St::tobf(sr_[i].vs1); int kc = sc * 2;               \
    *(bf16x8*)((char*)K_lds + (b) * SHM_K + KSWZ(sr, kc)) = St::tobf(sr_[i].ks0);                       \
    *(bf16x8*)((char*)K_lds + (b) * SHM_K + KSWZ(32 + sr, kc)) = St::tobf(sr_[i].ks1); } while (0)
#define SWAIT() do { if constexpr (SDEPTH == 2) asm volatile("s_waitcnt vmcnt(4)" ::: "memory"); else asm volatile("s_waitcnt vmcnt(0)" ::: "memory"); } while (0)
#define RESC(a) do { if (__any((a) < 1.f)) { if (hi == 0) al_l[r32] = (a); asm volatile("s_waitcnt lgkmcnt(0)" ::: "memory"); \
    for (int d = 0; d < 4; ++d) for (int r = 0; r < 16; ++r) o[d][r] *= al_l[crow(r, hi)]; } } while (0)
  f32x16 pA0, pA1, pB0, pB1; float mnA, mnB, alA, alB; bf16x8 pa0, pa1, pa2, pa3; const int NT = seq / KVBLK;
  constexpr int SE = 0, SO = SDEPTH - 1;
  SLOAD(SE, 0); asm volatile("s_waitcnt vmcnt(0)" ::: "memory"); SWRITE(0, SE); __syncthreads();
  qkt(pA0, pA1, K_lds, qr, r32, hi); partialSM(pA0, pA1, m_reg, mnA, alA);
  SLOAD(SO, KVBLK); if constexpr (SDEPTH == 2) { if (2 < NT) SLOAD(SE, 2 * KVBLK); }
  SWAIT(); SWRITE(1, SO); __syncthreads();
  for (int j = 1; j + 1 < NT; j += 2) {
    SBAR(); qkt(pB0, pB1, (bf16*)((char*)K_lds + SHM_K), qr, r32, hi);
    finishSM(pA0, pA1, alA, l_reg, pa0, pa1, pa2, pa3); SBAR();
    SLOAD(SO, (j + SDEPTH) * KVBLK); SBAR();
    pv_d0(o, vb0, pa0, pa1, pa2, pa3); partialSM(pB0, pB1, m_reg, mnB, alB);
    __syncthreads(); SWAIT(); SWRITE(0, SE);
    RESC(alB); __syncthreads();
    SBAR(); qkt(pA0, pA1, K_lds, qr, r32, hi);
    finishSM(pB0, pB1, alB, l_reg, pa0, pa1, pa2, pa3); SBAR();
    if (SDEPTH == 1 || j + 3 < NT) SLOAD(SE, (j + 1 + SDEPTH) * KVBLK); SBAR();
    pv_d0(o, vb0 + (int)SHM_V, pa0, pa1, pa2, pa3); partialSM(pA0, pA1, m_reg, mnA, alA);
    __syncthreads(); SWAIT(); SWRITE(1, SO);
    RESC(alA); __syncthreads();
  }
  SBAR(); qkt(pB0, pB1, (bf16*)((char*)K_lds + SHM_K), qr, r32, hi);
  finishSM(pA0, pA1, alA, l_reg, pa0, pa1, pa2, pa3); SBAR();
  pv_d0(o, vb0, pa0, pa1, pa2, pa3); partialSM(pB0, pB1, m_reg, mnB, alB);
  __syncthreads(); RESC(alB);
  finishSM(pB0, pB1, alB, l_reg, pa0, pa1, pa2, pa3); SBAR();
  pv_d0(o, vb0 + (int)SHM_V, pa0, pa1, pa2, pa3);
  if (hi == 0) { li_l[r32] = l_reg; *reinterpret_cast<float2*>(st + (size_t)(wid * QBLK + r32) * 8) = make_float2(m_reg, l_reg); } asm volatile("s_waitcnt lgkmcnt(0)" ::: "memory");
  float rli[16];
#pragma unroll
  for (int r = 0; r < 16; ++r) rli[r] = __builtin_amdgcn_rcpf(li_l[crow(r, hi)]);
  float* Ow = Ob + (long)(wid * QBLK) * LDO;
#pragma unroll
  for (int r = 0; r < 16; ++r) { int orow = crow(r, hi);
    for (int d0 = 0; d0 < 4; ++d0) Ow[(long)orow * LDO + d0 * 32 + r32] = o[d0][r] * rli[r]; }
#undef SLOAD
#undef SWRITE
#undef SWAIT
#undef RESC
}

}

#ifndef PG8_SP2
#define PG8_SP2 true
#endif
#ifndef PG8_ALIGN
#define PG8_ALIGN true
#endif

#define GAS __attribute__((address_space(1)))
#define LAS __attribute__((address_space(3)))
constexpr int NWAVES = 8;
constexpr int DM = 2048, SEQ = 4096, NB = 2, CTX = 256;
constexpr int ML = NB * SEQ, MC = NB * CTX, MT = ML + MC;
constexpr int NIN = 5136, NINP = 5376;
constexpr int DFF = 5632, DFE = 7168, NE = 8;
constexpr int LK = CTX + SEQ;
constexpr int MODW = 6 * DM;
constexpr int MSLOT = 18432;
constexpr float EPS = 1e-6f;
constexpr int C_AQ = 0, C_BQ = 512, C_CU = 1024, C_CV = 1536, C_DZ = 2048, C_DC = 2560, C_AK = 2816, C_AV = 3072, C_BK = 3328, C_BV = 3840, C_DX = 4352, C_DB = 4864, C_DT = 5120;

constexpr size_t MiB = 1u << 20;
constexpr size_t WS_CTL = 0, CTL_ZERO_BYTES = 1 * MiB;
constexpr size_t WS_MODP = 1 * MiB;
constexpr size_t WS_MOD = 12 * MiB;
constexpr size_t WS_ROPE = 13 * MiB;
constexpr size_t WS_WIN = 16 * MiB;
constexpr size_t WS_WOUT = 64 * MiB;
constexpr size_t WS_W13 = 80 * MiB;
constexpr size_t WS_W2 = 128 * MiB;
constexpr size_t WS_WM13 = 152 * MiB;
constexpr size_t WS_WM2 = 600 * MiB;
constexpr size_t WS_H = 824 * MiB;
constexpr size_t WS_P = 860 * MiB;
constexpr size_t WS_QA = 952 * MiB;
constexpr size_t WS_KA = 962 * MiB;
constexpr size_t WS_VA = 968 * MiB;
constexpr size_t WS_VN = 974 * MiB;
constexpr size_t WS_XBC = 992 * MiB;
constexpr size_t WS_DT = 1028 * MiB;
constexpr size_t WS_Y = 1030 * MiB;
constexpr size_t WS_OM = 1066 * MiB;
constexpr size_t WS_OB = 1136 * MiB;
constexpr size_t WS_XA = 1172 * MiB;
constexpr size_t WS_XB = 1240 * MiB;
constexpr size_t WS_ACT = 1308 * MiB;
constexpr size_t WS_HS = 1404 * MiB;
constexpr size_t WS_ACTM = 1476 * MiB;
constexpr size_t WS_YM = 1728 * MiB;
constexpr size_t WS_ROUTE = 1872 * MiB;
constexpr size_t WS_VTB = 1874 * MiB;
constexpr size_t WS_BCB = 1884 * MiB;
constexpr size_t WS_XT = 1894 * MiB;
constexpr size_t WS_BT = 1904 * MiB;
constexpr size_t WS_CUM = 1910 * MiB;
constexpr size_t WS_TOT = 1911 * MiB;
constexpr size_t WS_ST = 1912 * MiB;
constexpr size_t WS_HIN = 1950 * MiB;
constexpr size_t WS_SGW = 1970 * MiB;
constexpr size_t WS_VNT = 1971 * MiB;
constexpr size_t WS_VTA = 1981 * MiB;
constexpr size_t WS_OM2 = 1982 * MiB;
constexpr size_t WS_AST = 1998 * MiB;
constexpr size_t WS_PARTW = 2000 * MiB;
constexpr size_t WS_PARTF = 2016 * MiB;
constexpr size_t WS_YMP = 2062 * MiB;
constexpr size_t WS_END = 2640 * MiB;
constexpr int CW_BAR = 4096;
constexpr int CW_CNT = 16384;
constexpr int CW_TAIL = 20480;

constexpr int RING_BYTES = 131072;
constexpr int LDSCTL_OFF = 143360, MISC_OFF = LDSCTL_OFF + 320;
constexpr int LDS_BYTES = 147456;

typedef unsigned short bf16;
typedef unsigned v4u __attribute__((ext_vector_type(4)));
typedef unsigned v2u __attribute__((ext_vector_type(2)));
typedef float f32x4 __attribute__((ext_vector_type(4)));
typedef float f32x2 __attribute__((ext_vector_type(2)));
typedef GAS unsigned gu32;
typedef short bf16x8 __attribute__((ext_vector_type(8)));
#define RLX_AGENT __ATOMIC_RELAXED, __HIP_MEMORY_SCOPE_AGENT
#define LDS_WAIT() asm volatile("s_waitcnt lgkmcnt(0)" ::: "memory")
#define VM_WAIT() asm volatile("s_waitcnt vmcnt(0)" ::: "memory")
__device__ __forceinline__ unsigned f2bf(float f) { unsigned u = __builtin_bit_cast(unsigned, f); return (u + 0x7fffu + ((u >> 16) & 1u)) >> 16; }
__device__ __forceinline__ unsigned pk2(float lo, float hi) { return f2bf(lo) | (f2bf(hi) << 16); }
__device__ __forceinline__ float bf2f(unsigned short b) { return __builtin_bit_cast(float, (unsigned)b << 16); }
__device__ __forceinline__ float bflo(unsigned w) { return __builtin_bit_cast(float, w << 16); }
__device__ __forceinline__ float bfhi(unsigned w) { return __builtin_bit_cast(float, w & 0xffff0000u); }
template <int K> __device__ __forceinline__ float swz(float v) { return __builtin_bit_cast(float, __builtin_amdgcn_ds_swizzle(__builtin_bit_cast(int, v), (K << 10) | 0x1F)); }
__device__ __forceinline__ float wave_sum(float v) {
    v += swz<1>(v); v += swz<2>(v); v += swz<4>(v); v += swz<8>(v); v += swz<16>(v);
    const auto rr = __builtin_amdgcn_permlane32_swap(__float_as_uint(v), __float_as_uint(v), false, false);
    return __uint_as_float(rr[0]) + __uint_as_float(rr[1]);
}
__device__ __forceinline__ float wave_max(float v) {
    v = fmaxf(v, swz<1>(v)); v = fmaxf(v, swz<2>(v)); v = fmaxf(v, swz<4>(v)); v = fmaxf(v, swz<8>(v)); v = fmaxf(v, swz<16>(v));
    const auto rr = __builtin_amdgcn_permlane32_swap(__float_as_uint(v), __float_as_uint(v), false, false);
    return fmaxf(__uint_as_float(rr[0]), __uint_as_float(rr[1]));
}
__device__ __forceinline__ float sum_x32(float v) { const auto rr = __builtin_amdgcn_permlane32_swap(__float_as_uint(v), __float_as_uint(v), false, false); return __uint_as_float(rr[0]) + __uint_as_float(rr[1]); }
__device__ __forceinline__ float max_x32(float v) { const auto rr = __builtin_amdgcn_permlane32_swap(__float_as_uint(v), __float_as_uint(v), false, false); return fmaxf(__uint_as_float(rr[0]), __uint_as_float(rr[1])); }
__device__ __forceinline__ float lane_get(float v, int src) { return __builtin_bit_cast(float, __builtin_amdgcn_ds_bpermute(src << 2, __builtin_bit_cast(int, v))); }
__device__ __forceinline__ float lane_bcast(float v, int src) { return __builtin_bit_cast(float, __builtin_amdgcn_readlane(__builtin_bit_cast(int, v), src)); }
__device__ __forceinline__ float silu1(float v) { return v / (1.0f + expf(-v)); }
__device__ __forceinline__ float gelu_tanh(float v) { const float u = 0.7978845608028654f * (v + 0.044715f * v * v * v); return 0.5f * v * (1.0f + tanhf(u)); }
__device__ __forceinline__ float silu_fast(float v) { return v * __builtin_amdgcn_rcpf(1.0f + __expf(-v)); }
__device__ __forceinline__ float gelu_fast(float v) { const float u = 1.5957691216057308f * (v + 0.044715f * v * v * v); return v * __builtin_amdgcn_rcpf(1.0f + __expf(-u)); }
__device__ __forceinline__ float softplus1(float v) { return v > 20.f ? v : log1pf(expf(v)); }

#define XB_TMO      128
#define XB_XCNT(j)  (256  + 64 * (j))
#define XB_XSUB(j)  (1280 + 64 * (j))
#define XB_XGEN(j)  (2304 + 64 * (j))
#define XB_TOP      3328
#define XB_TOPGEN   3392
#define XCD_BAR_WORDS 3456
#define XB_SPIN_CAP (1u << 18)
__device__ __forceinline__ unsigned xb_ld(unsigned* p)              { return __hip_atomic_load(p, __ATOMIC_RELAXED, __HIP_MEMORY_SCOPE_AGENT); }
__device__ __forceinline__ unsigned xb_add(unsigned* p, unsigned v) { return __hip_atomic_fetch_add(p, v, __ATOMIC_RELAXED, __HIP_MEMORY_SCOPE_AGENT); }
__device__ __forceinline__ unsigned xb_xcc_id() { return (unsigned)__builtin_amdgcn_s_getreg((3 << 11) | 20) & 0xFu; }
#define XB_SPIN(cond, bar) do { unsigned _sp = 0; while (cond) { __builtin_amdgcn_s_sleep(1); \
    if ((++_sp & 255u) == 0u) { if (xb_ld(&(bar)[XB_TMO])) break; if (_sp > XB_SPIN_CAP) { atomicAdd(&(bar)[XB_TMO], 1u); break; } } } } while (0)
__device__ __forceinline__ int lane_id() { int l_; asm volatile("v_mbcnt_lo_u32_b32 %0, -1, 0\n\tv_mbcnt_hi_u32_b32 %0, -1, %0" : "=v"(l_)); return l_; }
struct XcdBarrier { unsigned* bar; unsigned x; volatile LAS unsigned* st; int wave; };
__device__ __forceinline__ XcdBarrier xcd_barrier_post(unsigned* bar, volatile LAS unsigned* st) {
    XcdBarrier b; b.bar = bar; b.x = xb_xcc_id(); b.st = st; b.wave = 0;
    if (threadIdx.x == 0) (void)xb_add(&bar[XB_XCNT(b.x)], 1u);
    return b;
}
__device__ __forceinline__ void xcd_barrier_complete(unsigned* bar, unsigned x, unsigned& nloc, unsigned& nx) {
    const unsigned G = gridDim.x * gridDim.y * gridDim.z;
    unsigned sum, cnt, mine, sp = 0u;
    for (;;) {
        sum = 0u; cnt = 0u; mine = 0u;
#pragma unroll
        for (unsigned j = 0; j < 16; ++j) { const unsigned c = xb_ld(&bar[XB_XCNT(j)]); sum += c; cnt += (c > 0u) ? 1u : 0u; mine = (j == x) ? c : mine; }
        if (sum == G) break;
        __builtin_amdgcn_s_sleep(1);
        if ((++sp & 255u) == 0u) { if (xb_ld(&bar[XB_TMO])) break; if (sp > XB_SPIN_CAP) { atomicAdd(&bar[XB_TMO], 1u); break; } }
    }
    nloc = mine > 0u ? mine : 1u; nx = cnt > 0u ? cnt : 1u;
}
__device__ __forceinline__ void xcd_barrier(const XcdBarrier& b) {
    asm volatile("s_waitcnt vmcnt(0)" ::: "memory");
    __syncthreads();
    if (b.wave == 0 && lane_id() == 0) {
        unsigned* bar = b.bar;
        __builtin_amdgcn_s_waitcnt(0);
        unsigned nloc = b.st[0], nx = b.st[1];
        if (nloc == 0u) { xcd_barrier_complete(bar, b.x, nloc, nx); b.st[0] = nloc; b.st[1] = nx; }
        const unsigned old = xb_add(&bar[XB_XSUB(b.x)], 1u);
        const unsigned gen = old / nloc;
        if (old + 1u == (gen + 1u) * nloc) {
            __builtin_amdgcn_fence(__ATOMIC_RELEASE, "agent");
            asm volatile("s_waitcnt vmcnt(0)" ::: "memory");
            const unsigned og = xb_add(&bar[XB_TOP], 1u);
            const unsigned tg = og / nx;
            if (og + 1u == (tg + 1u) * nx) xb_add(&bar[XB_TOPGEN], 1u);
            else XB_SPIN(xb_ld(&bar[XB_TOPGEN]) == tg, bar);
            __builtin_amdgcn_fence(__ATOMIC_ACQUIRE, "agent");
            xb_add(&bar[XB_XGEN(b.x)], 1u);
            asm volatile("s_waitcnt vmcnt(0)" ::: "memory");
        } else {
            XB_SPIN(xb_ld(&bar[XB_XGEN(b.x)]) == gen, bar);
            __builtin_amdgcn_fence(__ATOMIC_ACQUIRE, "agent");
            asm volatile("s_waitcnt vmcnt(0)" ::: "memory");
        }
    }
    __syncthreads();
}

struct Args { const GAS float* in[28]; GAS float* out; GAS unsigned char* ws; int ph_lo, ph_hi; };
__device__ __forceinline__ const float* ain(const Args& A, int i) { return (const float*)A.in[i]; }
struct Frame {
    LAS unsigned char* lds;
    unsigned char* ldsg;
    volatile LAS unsigned* MISC;
    gu32* ctl;
    int tid, lane, wave;
    int vcu, G;
    float* out;
    unsigned char* ws;
};
enum { I_X = 0, I_C, I_CTX, I_CCTX, I_WMOD, I_BMOD, I_NMIX, I_NFFN, I_WIN, I_QN, I_KN, I_RPB, I_SGUN, I_SGUW, I_SGUB, I_CONVW, I_CONVB, I_ALOG, I_DTB, I_DSKIP, I_ONORM, I_WOUT, I_W13, I_W2, I_ROUTER, I_MW13, I_MW2, I_FNORM };

struct CvtIt { const float* W; bf16* WT; int K, N, drow0, k0, n0; float f8; };
__device__ __forceinline__ void cvt_load(const CvtIt& c, int lane, f32x4 (&v)[8]) {
    const int r8 = lane >> 3, c4 = (lane & 7) * 4;
    const bool ok = (c.n0 + c4) < c.N;
#pragma unroll
    for (int i = 0; i < 8; ++i) { v[i] = ok ? __builtin_nontemporal_load((const GAS f32x4*)(c.W + (size_t)(c.k0 + r8 + 8 * i) * c.N + c.n0 + c4)) : (f32x4){0.f, 0.f, 0.f, 0.f}; }
}
__device__ __forceinline__ void cvt_store(const CvtIt& c, LAS float* scr, int lane, const f32x4 (&v)[8]) {
    const int r8 = lane >> 3, c4 = (lane & 7) * 4;
#pragma unroll
    for (int i = 0; i < 8; ++i) { LAS float* s = scr + (r8 + 8 * i) * 33 + c4; s[0] = v[i][0]; s[1] = v[i][1]; s[2] = v[i][2]; s[3] = v[i][3]; }
    LDS_WAIT(); asm volatile("" ::: "memory");
    const int cc = lane & 7;
#pragma unroll
    for (int j = 0; j < 4; ++j) { const int n = (lane >> 3) + 8 * j; const LAS float* s = scr + (8 * cc) * 33 + n;
        v4u o; o.x = pk2(s[0 * 33], s[1 * 33]); o.y = pk2(s[2 * 33], s[3 * 33]); o.z = pk2(s[4 * 33], s[5 * 33]); o.w = pk2(s[6 * 33], s[7 * 33]);
        *(GAS v4u*)(c.WT + (size_t)(c.drow0 + n) * c.K + c.k0 + 8 * cc) = o; }
    LDS_WAIT(); asm volatile("" ::: "memory");
}
__device__ __forceinline__ int map13(int n0, int dff) { const int h = n0 >= dff ? 1 : 0, j = n0 - h * dff; return (j >> 7) * 256 + h * 128 + (j & 127); }
__device__ __forceinline__ void cvt8_load(const CvtIt& c, int lane, f32x4 (&v)[16]) {
    const int r8 = lane >> 3, c4 = (lane & 7) * 4;
#pragma unroll
    for (int i = 0; i < 16; ++i) v[i] = __builtin_nontemporal_load((const GAS f32x4*)(c.W + (size_t)(c.k0 + r8 + 8 * i) * c.N + c.n0 + c4));
}
__device__ __forceinline__ void cvt8_store(const CvtIt& c, LAS float* scr, int lane, const f32x4 (&v)[16]) {
    const int r8 = lane >> 3, c4 = (lane & 7) * 4;
#pragma unroll
    for (int i = 0; i < 16; ++i) { LAS float* s = scr + (r8 + 8 * i) * 33 + c4; s[0] = v[i][0]; s[1] = v[i][1]; s[2] = v[i][2]; s[3] = v[i][3]; }
    LDS_WAIT(); asm volatile("" ::: "memory");
    const int part = lane & 7; unsigned char* W8 = (unsigned char*)c.WT;
#pragma unroll
    for (int j = 0; j < 4; ++j) { const int n = (lane >> 3) + 8 * j; const LAS float* s = scr + (16 * part) * 33 + n; float x[16];
#pragma unroll
        for (int i = 0; i < 16; ++i) x[i] = s[i * 33] * c.f8;
        v4u o; o.x = pg8::pack_fp8x4(x[0], x[1], x[2], x[3]); o.y = pg8::pack_fp8x4(x[4], x[5], x[6], x[7]); o.z = pg8::pack_fp8x4(x[8], x[9], x[10], x[11]); o.w = pg8::pack_fp8x4(x[12], x[13], x[14], x[15]);
        *(GAS v4u*)(W8 + (size_t)(c.drow0 + n) * c.K + c.k0 + 16 * part) = o; }
    LDS_WAIT(); asm volatile("" ::: "memory");
}
__device__ __forceinline__ void cvt_decode(Frame& F, const Args& A, int it, CvtIt& c) {
    constexpr int I_IN = 32 * 161, I_OUT = 32 * 64;
    int r = it;
    if (r < 2 * I_IN) { const int l = r / I_IN; r -= l * I_IN; const int kb = r / 161, nb = r % 161;
        c = CvtIt{ain(A, I_WIN) + (size_t)l * DM * NIN, (bf16*)(F.ws + WS_WIN) + (size_t)l * NINP * DM, DM, NIN, 32 * nb, 64 * kb, 32 * nb, 0.f}; return; }
    r -= 2 * I_IN;
    if (r < 2 * I_OUT) { const int l = r / I_OUT; r -= l * I_OUT; const int kb = r / 64, nb = r % 64;
        c = CvtIt{ain(A, I_WOUT) + (size_t)l * DM * DM, (bf16*)(F.ws + WS_WOUT) + (size_t)l * DM * DM, DM, DM, 32 * nb, 64 * kb, 32 * nb, 0.f}; return; }
    r -= 2 * I_OUT;
    { const int kb = r / 352, nb = r % 352;
        c = CvtIt{ain(A, I_W13), (bf16*)(F.ws + WS_W13), DM, 2 * DFF, map13(32 * nb, DFF), 64 * kb, 32 * nb, 0.f}; }
}
constexpr int MOE_ITEMS = 8 * 16 * 448 + 8 * 56 * 64;
#ifndef DEF_PER_PHASE
#define DEF_PER_PHASE 31232
#endif
#ifndef G1_SLACK
#define G1_SLACK 4096
#endif
constexpr int G1_STREAM_WGS = 16;
constexpr int MG0_ITEMS = 7680, FF1_ITEMS = 3200, WO0_ITEMS = 3072;
constexpr int OFF_G1 = 2 * DEF_PER_PHASE, OFF_MG0 = OFF_G1 + 2 * G1_SLACK, OFF_FF1 = OFF_MG0 + MG0_ITEMS, OFF_WO0 = OFF_FF1 + FF1_ITEMS;
constexpr int MOE_DEFERRED = OFF_WO0 + WO0_ITEMS;
static_assert(MOE_DEFERRED <= MOE_ITEMS, "deferred MoE items");
__device__ __forceinline__ void cvt8m_decode(Frame& F, const Args& A, int idx, CvtIt& c) {
    constexpr int I_M13 = 16 * 448, I_M2 = 56 * 64;
    int r = idx;
    if (r < 8 * I_M13) { const int e = r / I_M13; r -= e * I_M13; const int kb = r / 448, nb = r % 448;
        c = CvtIt{ain(A, I_MW13) + (size_t)e * DM * 2 * DFE, (bf16*)(F.ws + WS_WM13 + (size_t)e * 2 * DFE * DM), DM, 2 * DFE, map13(32 * nb, DFE), 128 * kb, 32 * nb, 256.f}; return; }
    r -= 8 * I_M13;
    { const int e = r / I_M2; r -= e * I_M2; const int kb = r / 64, nb = r % 64;
        c = CvtIt{ain(A, I_MW2) + (size_t)e * DFE * DM, (bf16*)(F.ws + WS_WM2 + (size_t)e * DM * DFE), DFE, DM, 32 * nb, 128 * kb, 32 * nb, 512.f}; }
}
__device__ __forceinline__ void cvt8_decode(Frame& F, const Args& A, int it, CvtIt& c) {
    constexpr int I_2 = 44 * 64;
    if (it < I_2) { const int kb = it / 64, nb = it % 64;
        c = CvtIt{ain(A, I_W2), (bf16*)(F.ws + WS_W2), DFF, DM, 32 * nb, 128 * kb, 32 * nb, 512.f}; return; }
    cvt8m_decode(F, A, it - I_2 + MOE_DEFERRED, c);
}
__device__ __forceinline__ void cvt8_deferred(Frame& F, const Args& A, int base, int count, int w, int nw) {
    LAS float* scr = (LAS float*)(F.lds + F.wave * 17408);
    const int lane = F.lane, end = base + count;
    CvtIt ca, cb; f32x4 va[16], vb[16];
    int it = base + w;
    if (it < end) { cvt8m_decode(F, A, it, ca); cvt8_load(ca, lane, va); }
    while (it < end) {
        const bool hb = it + nw < end;
        if (hb) { cvt8m_decode(F, A, it + nw, cb); cvt8_load(cb, lane, vb); }
        cvt8_store(ca, scr, lane, va);
        if (!hb) break;
        const bool ha = it + 2 * nw < end;
        if (ha) { cvt8m_decode(F, A, it + 2 * nw, ca); cvt8_load(ca, lane, va); }
        cvt8_store(cb, scr, lane, vb);
        it += 2 * nw;
        if (!ha) break;
    }
}
__device__ __forceinline__ void pro_cvt(Frame& F, const Args& A) {
    LAS float* scr = (LAS float*)(F.lds + F.wave * 17408);
    const int gw = F.vcu * NWAVES + F.wave, NGW = F.G * NWAVES, lane = F.lane;
    { constexpr int NITEMS = 2 * 32 * 161 + 2 * 32 * 64 + 32 * 352;
      CvtIt ca, cb; f32x4 va[8], vb[8];
      int it = gw;
      if (it < NITEMS) { cvt_decode(F, A, it, ca); cvt_load(ca, lane, va); }
      while (it < NITEMS) {
          const bool hb = it + NGW < NITEMS;
          if (hb) { cvt_decode(F, A, it + NGW, cb); cvt_load(cb, lane, vb); }
          cvt_store(ca, scr, lane, va);
          if (!hb) break;
          const bool ha = it + 2 * NGW < NITEMS;
          if (ha) { cvt_decode(F, A, it + 2 * NGW, ca); cvt_load(ca, lane, va); }
          cvt_store(cb, scr, lane, vb);
          it += 2 * NGW;
          if (!ha) break;
      } }
    if (F.G != 256) cvt8_deferred(F, A, OFF_G1, MOE_DEFERRED - OFF_G1, gw, NGW);
    { constexpr int NITEMS = 44 * 64 + MOE_ITEMS - MOE_DEFERRED;
      CvtIt ca, cb; f32x4 va[16], vb[16];
      int it = gw;
      if (it < NITEMS) { cvt8_decode(F, A, it, ca); cvt8_load(ca, lane, va); }
      while (it < NITEMS) {
          const bool hb = it + NGW < NITEMS;
          if (hb) { cvt8_decode(F, A, it + NGW, cb); cvt8_load(cb, lane, vb); }
          cvt8_store(ca, scr, lane, va);
          if (!hb) break;
          const bool ha = it + 2 * NGW < NITEMS;
          if (ha) { cvt8_decode(F, A, it + 2 * NGW, ca); cvt8_load(ca, lane, va); }
          cvt8_store(cb, scr, lane, vb);
          it += 2 * NGW;
          if (!ha) break;
      } }
}
__device__ __forceinline__ void pro_mod(Frame& F, const Args& A) {
    const int gw = F.vcu * NWAVES + F.wave, NGW = F.G * NWAVES, lane = F.lane;
    float* modp = (float*)(F.ws + WS_MODP);
    for (int it = gw; it < 2 * 32 * 48; it += NGW) {
        const int l = it / (32 * 48), r = it % (32 * 48), ks = r / 48, cb = r % 48;
        const float* wm = ain(A, I_WMOD) + (size_t)l * DM * MODW + (size_t)(ks * 64) * MODW + cb * 256 + 4 * lane;
        f32x4 a0 = {0.f, 0.f, 0.f, 0.f}, a1 = a0, a2 = a0;
#pragma unroll 8
        for (int k = 0; k < 64; ++k) {
            const f32x4 w = __builtin_nontemporal_load((const GAS f32x4*)(wm + (size_t)k * MODW));
            const int kk = ks * 64 + k;
            const float s0 = silu1(ain(A, I_C)[kk]), s1 = silu1(ain(A, I_C)[DM + kk]), s2 = silu1(ain(A, I_CCTX)[kk]);
            a0 += w * s0; a1 += w * s1; a2 += w * s2;
        }
        float* o = modp + ((size_t)(l * 32 + ks) * 3) * MODW + cb * 256 + 4 * lane;
        *(GAS f32x4*)(o) = a0; *(GAS f32x4*)(o + MODW) = a1; *(GAS f32x4*)(o + 2 * MODW) = a2;
    }
}
__device__ __forceinline__ void pro_rope(Frame& F, const Args& A) {
    { bf16* sgw = (bf16*)(F.ws + WS_SGW);
      for (int idx = (F.vcu * NWAVES * 64) + F.tid; idx < 2 * 4 * 128 * 128; idx += F.G * NWAVES * 64) sgw[idx] = (bf16)f2bf(ain(A, I_SGUW)[idx]); }
    f32x2* rope = (f32x2*)(F.ws + WS_ROPE);
    for (int idx = (F.vcu * NWAVES * 64) + F.tid; idx < SEQ * 64; idx += F.G * NWAVES * 64) {
        const int t = idx >> 6, i = idx & 63;
        const float pos = (float)(i < 32 ? (t >> 6) : (t & 63));
        const float inv = powf(10000.0f, -(float)(i & 31) / 32.0f);
        const float ang = pos * inv;
        rope[idx] = (f32x2){cosf(ang), sinf(ang)};
    }
}
__device__ __forceinline__ void phase_pro_b(Frame& F, const Args& A) {
    const float* modp = (const float*)(F.ws + WS_MODP); float* mod = (float*)(F.ws + WS_MOD);
    for (int idx = (F.vcu * NWAVES * 64) + F.tid; idx < 2 * 3 * MODW; idx += F.G * NWAVES * 64) {
        const int l = idx / (3 * MODW), r = idx % (3 * MODW), j = r % MODW;
        float s = ain(A, I_BMOD)[l * MODW + j];
        for (int ks = 0; ks < 32; ++ks) s += modp[(size_t)(l * 32 + ks) * 3 * MODW + r];
        mod[idx] = s;
    }
}
template <bool O8 = false>
__device__ __forceinline__ void norm_mod_vals(const f32x4 (&v)[8], const float* __restrict__ gain, const float* __restrict__ sh, const float* __restrict__ sc, bf16* __restrict__ orow, int lane, f32x4 (&y)[8]) {
    float ss = 0.f;
#pragma unroll
    for (int j = 0; j < 8; ++j) ss += (v[j].x * v[j].x + v[j].y * v[j].y) + (v[j].z * v[j].z + v[j].w * v[j].w);
    const float r = 1.0f / sqrtf(wave_sum(ss) * (1.0f / DM) + EPS);
#pragma unroll
    for (int j = 0; j < 8; ++j) { const int c = 4 * lane + 256 * j;
        const f32x4 g = *(const GAS f32x4*)(gain + c), s1 = *(const GAS f32x4*)(sc + c), s0 = *(const GAS f32x4*)(sh + c);
        y[j] = (v[j] * r) * g * (s1 + 1.0f) + s0;
        if (O8) *(GAS unsigned*)((unsigned char*)orow + c) = pg8::pack_fp8x4(y[j].x * 4.f, y[j].y * 4.f, y[j].z * 4.f, y[j].w * 4.f);
        else { v2u o; o.x = pk2(y[j].x, y[j].y); o.y = pk2(y[j].z, y[j].w); *(GAS v2u*)(orow + c) = o; } }
}
template <bool O8 = false>
__device__ __forceinline__ void norm_mod_row(const float* __restrict__ xrow, const float* __restrict__ gain, const float* __restrict__ sh, const float* __restrict__ sc, bf16* __restrict__ orow, int lane, f32x4 (&y)[8]) {
    f32x4 v[8];
#pragma unroll
    for (int j = 0; j < 8; ++j) v[j] = *(const GAS f32x4*)(xrow + 4 * lane + 256 * j);
    norm_mod_vals<O8>(v, gain, sh, sc, orow, lane, y);
}
template <int NS>
__device__ __forceinline__ void ctx_row_from_parts(const float* base, const float* gate, const float* parts, int r, int lane, f32x4 (&v)[8]) {
#pragma unroll
    for (int j = 0; j < 8; ++j) { const int c = 4 * lane + 256 * j;
        f32x4 s = *(const GAS f32x4*)(parts + (size_t)r * DM + c);
#pragma unroll
        for (int k = 1; k < NS; ++k) s += *(const GAS f32x4*)(parts + ((size_t)k * MC + r) * DM + c);
        v[j] = *(const GAS f32x4*)(base + c) + *(const GAS f32x4*)(gate + c) * s; }
}
__device__ __forceinline__ const float* xrow_ptr(Frame& F, const Args& A, int l, int row) {
    if (l == 0) return row < ML ? ain(A, I_X) + (size_t)row * DM : ain(A, I_CTX) + (size_t)(row - ML) * DM;
    return (const float*)(F.ws + WS_XB) + (size_t)row * DM;
}
__device__ __forceinline__ int row_vec(int row) { return row < SEQ ? 0 : (row < ML ? 1 : 2); }
__device__ __forceinline__ void phase_n1(Frame& F, const Args& A, int l) {
    const int gw = F.vcu * NWAVES + F.wave, NGW = F.G * NWAVES;
    const float* mod = (const float*)(F.ws + WS_MOD) + (size_t)l * 3 * MODW;
    bf16* H = (bf16*)(F.ws + WS_H);
    for (int row = gw; row < MT; row += NGW) {
        const float* m = mod + row_vec(row) * MODW; f32x4 y[8];
        if (l == 1 && row >= ML) {
            f32x4 v[8];
            ctx_row_from_parts<11>((const float*)(F.ws + WS_XA) + (size_t)row * DM, (const float*)(F.ws + WS_MOD) + 2 * MODW + 5 * DM, (const float*)(F.ws + WS_PARTF), row - ML, F.lane, v);
            norm_mod_vals(v, ain(A, I_NMIX) + l * DM, m, m + DM, H + (size_t)row * DM, F.lane, y);
        } else norm_mod_row(xrow_ptr(F, A, l, row), ain(A, I_NMIX) + l * DM, m, m + DM, H + (size_t)row * DM, F.lane, y);
    }
}
template <bool TILE>
__device__ __forceinline__ void prep_one_row_impl(const bf16* __restrict__ P, bf16* __restrict__ QA, bf16* __restrict__ KA, bf16* __restrict__ VA, bf16* __restrict__ VNT, float* __restrict__ XBC, float* __restrict__ DT,
        bf16* __restrict__ VTB, bf16* __restrict__ VTA, bf16* __restrict__ BCB, bf16* __restrict__ XT, bf16* __restrict__ BT, const f32x2* __restrict__ rope, const float* __restrict__ qn, const float* __restrict__ kn,
        const float (&cwv)[16][5], const float (&cbv)[16], const float* __restrict__ sgun, const float* __restrict__ dtb, int row, int lane, LAS bf16* tile, int tok) {
    const bool lat = TILE ? true : row < ML;
    const int b = lat ? row / SEQ : (row - ML) / CTX, tpos = lat ? row % SEQ : (row - ML) % CTX, slen = lat ? SEQ : CTX;
    const int pos = lat ? CTX + tpos : tpos;
    const bf16* pr = P + (size_t)row * NINP;
    f32x2 cs = {1.f, 0.f}; if (lat) cs = rope[tpos * 64 + lane];
#pragma unroll
    for (int hh = 0; hh < 6; ++hh) {
        const int src = hh < 4 ? C_AQ + hh * 128 : C_AK + (hh - 4) * 128;
        const unsigned w = *(const GAS unsigned*)(pr + src + 2 * lane);
        const float v0 = bflo(w), v1 = bfhi(w);
        const float r = 1.0f / sqrtf(wave_sum(v0 * v0 + v1 * v1) * (1.0f / 128.f) + EPS);
        const float* gn = hh < 4 ? qn : kn;
        const float y0 = v0 * r * gn[2 * lane], y1 = v1 * r * gn[2 * lane + 1];
        const float o0 = y0 * cs.x - y1 * cs.y, o1 = y0 * cs.y + y1 * cs.x;
        bf16* dst = hh < 4 ? QA + (size_t)row * 512 + hh * 128 : KA + ((size_t)b * LK + pos) * 256 + (hh - 4) * 128;
        *(GAS unsigned*)(dst + 2 * lane) = pk2(o0, o1);
    }
    { const v2u w = *(const GAS v2u*)(pr + C_AV + 4 * lane);
      *(GAS v2u*)(VA + ((size_t)b * LK + pos) * 256 + 4 * lane) = w; }
#pragma unroll
    for (int i = 0; i < 8; ++i) { const int v = lane + 64 * i;
        if (TILE) tile[v * 34 + tok] = pr[C_BV + v];
        else VTB[((size_t)(b * 4 + (v >> 7)) * 128 + (v & 127)) * LK + pos] = pr[C_BV + v]; }
    if (!lat) {
#pragma unroll
        for (int i = 0; i < 4; ++i) { const int v = lane + 64 * i;
            VTA[((size_t)(b * 2 + (v >> 7)) * 128 + (v & 127)) * 256 + tpos] = pr[C_AV + v]; } }
    { const v4u w = *(const GAS v4u*)(pr + C_CV + 8 * lane);
      float g[8]; g[0] = gelu_fast(bflo(w.x)); g[1] = gelu_fast(bfhi(w.x)); g[2] = gelu_fast(bflo(w.y)); g[3] = gelu_fast(bfhi(w.y));
      g[4] = gelu_fast(bflo(w.z)); g[5] = gelu_fast(bfhi(w.z)); g[6] = gelu_fast(bflo(w.w)); g[7] = gelu_fast(bfhi(w.w));
      float ss = 0.f;
#pragma unroll
      for (int i = 0; i < 8; ++i) ss += g[i] * g[i];
      const float r = 1.0f / sqrtf(wave_sum(ss) * (1.0f / 512.f) + EPS);
      const float* sn = sgun + 8 * lane;
      bf16* vt = VNT + ((size_t)(row >> 7) * 512 + 8 * lane) * 128 + (row & 127);
#pragma unroll
      for (int i = 0; i < 8; ++i) { const bf16 o = (bf16)f2bf(g[i] * r * sn[i]);
          if (TILE) tile[(512 + 8 * lane + i) * 34 + tok] = o; else vt[i * 128] = o; } }
    int roff[5]; float mk[5];
#pragma unroll
    for (int k = 0; k < 5; ++k) { const int tt = tpos + k - 2; const bool ok = tt >= 0 && tt < slen; roff[k] = ok ? (k - 2) * NINP : 0; mk[k] = ok ? 1.f : 0.f; }
#pragma unroll
    for (int i0 = 0; i0 < 16; i0 += 8) {
        unsigned short tp[8][5];
#pragma unroll
        for (int ii = 0; ii < 8; ++ii) { const int ch = lane + 64 * (i0 + ii);
            const int col = i0 + ii < 8 ? C_DX + ch : (i0 + ii < 12 ? C_DB + (ch - 512) : C_DC + (ch - 768));
#pragma unroll
            for (int k = 0; k < 5; ++k) tp[ii][k] = pr[roff[k] + col]; }
#pragma unroll
        for (int ii = 0; ii < 8; ++ii) { const int ch = lane + 64 * (i0 + ii);
            float acc = cbv[i0 + ii];
#pragma unroll
            for (int k = 0; k < 5; ++k) acc += (cwv[i0 + ii][k] * mk[k]) * bf2f(tp[ii][k]);
            const float sv = silu_fast(acc);
            XBC[(size_t)row * 1024 + ch] = sv; const bf16 sb = (bf16)f2bf(sv);
            if (i0 + ii < 8) { if (TILE) tile[(1024 + ch) * 34 + tok] = sb; else XT[((size_t)b * 512 + ch) * LK + pos] = sb; }
            else { BCB[(size_t)row * 512 + (ch - 512)] = sb;
                if (i0 + ii < 12) { if (TILE) tile[(1536 + ch - 512) * 34 + tok] = sb; else BT[((size_t)b * 256 + (ch - 512)) * LK + pos] = sb; } }
        }
    }
    if (lane < 16) DT[(size_t)row * 16 + lane] = softplus1(bf2f(pr[C_DT + lane]) + dtb[lane]);
}
__device__ __forceinline__ void prep_two_rows(const bf16* __restrict__ P, bf16* __restrict__ QA, bf16* __restrict__ KA, bf16* __restrict__ VA, float* __restrict__ XBC, float* __restrict__ DT, bf16* __restrict__ BCB,
        const f32x2* __restrict__ rope, const float* __restrict__ qn, const float* __restrict__ kn, const float* __restrict__ cw, const float* __restrict__ cb, const float* __restrict__ sgun, const float* __restrict__ dtb,
        int row0, int row1, int lane, LAS bf16* tile, int tok0, int tok1) {
    const int row[2] = {row0, row1}, tok[2] = {tok0, tok1};
    int b[2], tpos[2], pos[2]; const bf16* pr[2];
#pragma unroll
    for (int q = 0; q < 2; ++q) { b[q] = row[q] / SEQ; tpos[q] = row[q] % SEQ; pos[q] = CTX + tpos[q]; pr[q] = P + (size_t)row[q] * NINP; }
    f32x2 cs[2]; unsigned qk[2][6]; v2u av[2]; unsigned short bvv[2][8]; v4u cvw[2]; unsigned short dtv[2];
#pragma unroll
    for (int q = 0; q < 2; ++q) {
        cs[q] = rope[tpos[q] * 64 + lane];
#pragma unroll
        for (int hh = 0; hh < 6; ++hh) qk[q][hh] = *(const GAS unsigned*)(pr[q] + (hh < 4 ? C_AQ + hh * 128 : C_AK + (hh - 4) * 128) + 2 * lane);
        av[q] = *(const GAS v2u*)(pr[q] + C_AV + 4 * lane);
#pragma unroll
        for (int i = 0; i < 8; ++i) bvv[q][i] = pr[q][C_BV + lane + 64 * i];
        cvw[q] = *(const GAS v4u*)(pr[q] + C_CV + 8 * lane);
        dtv[q] = pr[q][C_DT + (lane & 15)];
    }
    float gq_[6][2];
#pragma unroll
    for (int hh = 0; hh < 6; ++hh) { const float* gn = hh < 4 ? qn : kn; gq_[hh][0] = gn[2 * lane]; gq_[hh][1] = gn[2 * lane + 1]; }
    float sn[8];
#pragma unroll
    for (int i = 0; i < 8; ++i) sn[i] = sgun[8 * lane + i];
#pragma unroll
    for (int hh = 0; hh < 6; ++hh) {
        float v0[2], v1[2], ss[2];
#pragma unroll
        for (int q = 0; q < 2; ++q) { v0[q] = bflo(qk[q][hh]); v1[q] = bfhi(qk[q][hh]); ss[q] = v0[q] * v0[q] + v1[q] * v1[q]; }
        ss[0] = wave_sum(ss[0]); ss[1] = wave_sum(ss[1]);
#pragma unroll
        for (int q = 0; q < 2; ++q) { const float r = 1.0f / sqrtf(ss[q] * (1.0f / 128.f) + EPS);
            const float y0 = v0[q] * r * gq_[hh][0], y1 = v1[q] * r * gq_[hh][1];
            const float o0 = y0 * cs[q].x - y1 * cs[q].y, o1 = y0 * cs[q].y + y1 * cs[q].x;
            bf16* dst = hh < 4 ? QA + (size_t)row[q] * 512 + hh * 128 : KA + ((size_t)b[q] * LK + pos[q]) * 256 + (hh - 4) * 128;
            *(GAS unsigned*)(dst + 2 * lane) = pk2(o0, o1); }
    }
#pragma unroll
    for (int q = 0; q < 2; ++q) { *(GAS v2u*)(VA + ((size_t)b[q] * LK + pos[q]) * 256 + 4 * lane) = av[q];
#pragma unroll
        for (int i = 0; i < 8; ++i) tile[(lane + 64 * i) * 34 + tok[q]] = bvv[q][i]; }
    { float g[2][8], ss[2];
#pragma unroll
      for (int q = 0; q < 2; ++q) { const v4u w = cvw[q];
          g[q][0] = gelu_fast(bflo(w.x)); g[q][1] = gelu_fast(bfhi(w.x)); g[q][2] = gelu_fast(bflo(w.y)); g[q][3] = gelu_fast(bfhi(w.y));
          g[q][4] = gelu_fast(bflo(w.z)); g[q][5] = gelu_fast(bfhi(w.z)); g[q][6] = gelu_fast(bflo(w.w)); g[q][7] = gelu_fast(bfhi(w.w));
          ss[q] = 0.f;
#pragma unroll
          for (int i = 0; i < 8; ++i) ss[q] += g[q][i] * g[q][i]; }
      ss[0] = wave_sum(ss[0]); ss[1] = wave_sum(ss[1]);
#pragma unroll
      for (int q = 0; q < 2; ++q) { const float r = 1.0f / sqrtf(ss[q] * (1.0f / 512.f) + EPS);
#pragma unroll
          for (int i = 0; i < 8; ++i) tile[(512 + 8 * lane + i) * 34 + tok[q]] = (bf16)f2bf(g[q][i] * r * sn[i]); } }
#pragma unroll
    for (int q = 0; q < 2; ++q) if (lane < 16) DT[(size_t)row[q] * 16 + lane] = softplus1(bf2f(dtv[q]) + dtb[lane]);
    int roff[2][5]; float mk[2][5];
#pragma unroll
    for (int q = 0; q < 2; ++q)
#pragma unroll
        for (int k = 0; k < 5; ++k) { const int tt = tpos[q] + k - 2; const bool ok = tt >= 0 && tt < SEQ; roff[q][k] = ok ? (k - 2) * NINP : 0; mk[q][k] = ok ? 1.f : 0.f; }
#pragma unroll 1
    for (int i0 = 0; i0 < 16; i0 += 4) {
        unsigned short tp[2][4][5]; float wv[4][5], bv[4];
#pragma unroll
        for (int ii = 0; ii < 4; ++ii) { const int ch = lane + 64 * (i0 + ii); bv[ii] = cb[ch];
#pragma unroll
            for (int k = 0; k < 5; ++k) wv[ii][k] = cw[k * 1024 + ch]; }
#pragma unroll
        for (int q = 0; q < 2; ++q)
#pragma unroll
            for (int ii = 0; ii < 4; ++ii) { const int ch = lane + 64 * (i0 + ii);
                const int col = i0 + ii < 8 ? C_DX + ch : (i0 + ii < 12 ? C_DB + (ch - 512) : C_DC + (ch - 768));
#pragma unroll
                for (int k = 0; k < 5; ++k) tp[q][ii][k] = pr[q][roff[q][k] + col]; }
#pragma unroll
        for (int q = 0; q < 2; ++q)
#pragma unroll
            for (int ii = 0; ii < 4; ++ii) { const int ch = lane + 64 * (i0 + ii);
                float acc = bv[ii];
#pragma unroll
                for (int k = 0; k < 5; ++k) acc += (wv[ii][k] * mk[q][k]) * bf2f(tp[q][ii][k]);
                const float sv = silu_fast(acc);
                XBC[(size_t)row[q] * 1024 + ch] = sv; const bf16 sb = (bf16)f2bf(sv);
                if (i0 + ii < 8) tile[(1024 + ch) * 34 + tok[q]] = sb;
                else { BCB[(size_t)row[q] * 512 + (ch - 512)] = sb; if (i0 + ii < 12) tile[(1536 + ch - 512) * 34 + tok[q]] = sb; } }
    }
}
__device__ __forceinline__ void load_conv_w(const Args& A, int l, int lane, float (&cwv)[16][5], float (&cbv)[16]) {
    const float* cw = ain(A, I_CONVW) + (size_t)l * 5 * 1024; const float* cb = ain(A, I_CONVB) + l * 1024;
#pragma unroll
    for (int i = 0; i < 16; ++i) { cbv[i] = cb[lane + 64 * i];
#pragma unroll
        for (int k = 0; k < 5; ++k) cwv[i][k] = cw[k * 1024 + lane + 64 * i]; }
}
template <bool TILE>
__device__ __forceinline__ void prep_one_row(Frame& F, const Args& A, int l, int row, int lane, LAS bf16* tile, int tok, const float (&cwv)[16][5], const float (&cbv)[16]) {
    prep_one_row_impl<TILE>((const bf16*)(F.ws + WS_P), (bf16*)(F.ws + WS_QA), (bf16*)(F.ws + WS_KA), (bf16*)(F.ws + WS_VA), (bf16*)(F.ws + WS_VNT), (float*)(F.ws + WS_XBC), (float*)(F.ws + WS_DT),
        (bf16*)(F.ws + WS_VTB), (bf16*)(F.ws + WS_VTA), (bf16*)(F.ws + WS_BCB), (bf16*)(F.ws + WS_XT), (bf16*)(F.ws + WS_BT), (const f32x2*)(F.ws + WS_ROPE), ain(A, I_QN) + l * 128, ain(A, I_KN) + l * 128,
        cwv, cbv, ain(A, I_SGUN) + l * 512, ain(A, I_DTB) + l * 16, row, lane, tile, tok);
}
__device__ __forceinline__ void prep_rows(Frame& F, const Args& A, int l) {
    LAS bf16* tile = (LAS bf16*)F.lds;
    for (int t = F.vcu; t < ML / 32; t += F.G) {
        const int r0 = 32 * t;
#pragma unroll 1
        for (int i = 0; i < 4; i += 2)
            prep_two_rows((const bf16*)(F.ws + WS_P), (bf16*)(F.ws + WS_QA), (bf16*)(F.ws + WS_KA), (bf16*)(F.ws + WS_VA), (float*)(F.ws + WS_XBC), (float*)(F.ws + WS_DT), (bf16*)(F.ws + WS_BCB),
                          (const f32x2*)(F.ws + WS_ROPE), ain(A, I_QN) + l * 128, ain(A, I_KN) + l * 128, ain(A, I_CONVW) + (size_t)l * 5 * 1024, ain(A, I_CONVB) + l * 1024, ain(A, I_SGUN) + l * 512, ain(A, I_DTB) + l * 16,
                          r0 + F.wave + 8 * i, r0 + F.wave + 8 * i + 8, F.lane, tile, F.wave + 8 * i, F.wave + 8 * i + 8);
        LDS_WAIT(); __syncthreads();
        const int b = r0 / SEQ, pos0 = CTX + (r0 % SEQ);
        bf16* VTB = (bf16*)(F.ws + WS_VTB); bf16* VNT = (bf16*)(F.ws + WS_VNT); bf16* XT = (bf16*)(F.ws + WS_XT); bf16* BT = (bf16*)(F.ws + WS_BT);
#pragma unroll 2
        for (int k = 0; k < 14; ++k) { const int idx = F.tid + 512 * k, tc = idx >> 2, part = idx & 3;
            const LAS unsigned* sp = (const LAS unsigned*)(tile + tc * 34) + 4 * part;
            v4u o; o.x = sp[0]; o.y = sp[1]; o.z = sp[2]; o.w = sp[3];
            bf16* dst;
            if (tc < 512) dst = VTB + ((size_t)(b * 4 + (tc >> 7)) * 128 + (tc & 127)) * LK + pos0;
            else if (tc < 1024) dst = VNT + ((size_t)(r0 >> 7) * 512 + (tc - 512)) * 128 + (r0 & 127);
            else if (tc < 1536) dst = XT + ((size_t)b * 512 + (tc - 1024)) * LK + pos0;
            else dst = BT + ((size_t)b * 256 + (tc - 1536)) * LK + pos0;
            *(GAS v4u*)(dst + 8 * part) = o; }
        __syncthreads();
    }
    { const int gw = F.vcu * NWAVES + F.wave, NGW = F.G * NWAVES;
      float cwv[16][5], cbv[16]; load_conv_w(A, l, F.lane, cwv, cbv);
      for (int row = ML + gw; row < MT; row += NGW) prep_one_row<false>(F, A, l, row, F.lane, tile, 0, cwv, cbv); }
}
__device__ __forceinline__ void prep_cum(Frame& F, const Args& A, int l) {
    const int gw = F.vcu * NWAVES + F.wave, NGW = F.G * NWAVES, lane = F.lane;
    const bf16* P = (const bf16*)(F.ws + WS_P); float* CUM = (float*)(F.ws + WS_CUM); float* TOT = (float*)(F.ws + WS_TOT);
    for (int it = gw; it < 68 * 16; it += NGW) {
        const int rc = it >> 4, j = it & 15, d = j >> 3, rowbase = rc * 128;
        const float a = -expf(ain(A, I_ALOG)[l * 16 + j]), bias = ain(A, I_DTB)[l * 16 + j];
        const float v0 = softplus1(bf2f(P[(size_t)(rowbase + lane) * NINP + C_DT + j]) + bias) * a, v1 = softplus1(bf2f(P[(size_t)(rowbase + 64 + lane) * NINP + C_DT + j]) + bias) * a;
        float s0 = v0, s1 = v1;
#pragma unroll
        for (int o = 1; o < 64; o <<= 1) { const float t0 = lane_get(s0, (lane - o) & 63), t1 = lane_get(s1, (lane - o) & 63); if (lane >= o) { s0 += t0; s1 += t1; } }
        const float tot0 = lane_bcast(s0, 63), total = tot0 + lane_bcast(s1, 63);
        s1 += tot0;
        CUM[(size_t)(rowbase + lane) * 16 + j] = d ? total - (s0 - v0) : s0;
        CUM[(size_t)(rowbase + 64 + lane) * 16 + j] = d ? total - (s1 - v1) : s1;
        if (lane == 0) TOT[rc * 16 + j] = total;
    }
}
template <bool WIN, bool CL>
__device__ __forceinline__ void na_unit(const bf16* __restrict__ qp, const bf16* __restrict__ kb, const bf16* __restrict__ kc, int kcs, const bf16* __restrict__ VT, int vts, const float* __restrict__ rpb_h, int r, int n, float* __restrict__ outp, int lane, const LAS bf16* lk, const LAS bf16* lv) {
    const int lr = lane & 15, g = lane >> 4;
    constexpr int NTB = WIN ? 16 : 0, NT = NTB + 16;
    bf16x8 qf[4];
#pragma unroll
    for (int ks = 0; ks < 4; ++ks) qf[ks] = *(const GAS bf16x8*)(qp + 8 * g + 32 * ks);
    const int r0 = min(max(r - 4, 0), 56), bc0 = n == 0 ? 0 : (n == 1 ? 8 : (n == 2 ? 24 : 32));
    const int kperm = 8 * (lr >> 2) + (lr & 3);
    f32x4 acc[NT];
#pragma unroll
    for (int t0 = 0; t0 < NT; t0 += 4) {
        bf16x8 kf[4][4];
#pragma unroll
        for (int tt = 0; tt < 4; ++tt) { const int t = t0 + tt;
            if (CL && t >= NTB) { const LAS bf16* kp = lk + (32 * ((t - NTB) >> 1) + kperm + 4 * (t & 1)) * 136 + 8 * g;
#pragma unroll
                for (int ks = 0; ks < 4; ++ks) kf[tt][ks] = *(const LAS bf16x8*)(kp + 32 * ks); }
            else { const bf16* kp = ((t < NTB) ? kb + (size_t)((r0 + (t >> 1)) * 64 + bc0 + kperm + 4 * (t & 1)) * NINP : kc + (size_t)(32 * ((t - NTB) >> 1) + kperm + 4 * (t & 1)) * kcs) + 8 * g;
#pragma unroll
                for (int ks = 0; ks < 4; ++ks) kf[tt][ks] = *(const GAS bf16x8*)(kp + 32 * ks); } }
#pragma unroll
        for (int tt = 0; tt < 4; ++tt) { f32x4 a = {0.f, 0.f, 0.f, 0.f};
#pragma unroll
            for (int ks = 0; ks < 4; ++ks) a = __builtin_amdgcn_mfma_f32_16x16x32_bf16(kf[tt][ks], qf[ks], a, 0, 0, 0);
            acc[t0 + tt] = a; }
        __builtin_amdgcn_sched_barrier(0);
    }
    const int c = 16 * n + lr, c0 = min(max(c - 8, 0), 48);
    float m = -1e30f;
#pragma unroll
    for (int t = 0; t < NT; ++t)
#pragma unroll
        for (int rr = 0; rr < 4; ++rr) {
            float s = acc[t][rr] * 0.088388347648318440f;
            if (t < NTB) { const int kcol = bc0 + 8 * g + 4 * (t & 1) + rr, krow = r0 + (t >> 1); const bool valid = kcol >= c0 && kcol < c0 + 16;
                const int bi = valid ? (krow - r + 7) * 31 + (kcol - c + 15) : 0; const float bv = rpb_h[bi]; s = valid ? s + bv : -1e30f; }
            acc[t][rr] = s; m = fmaxf(m, s);
        }
    m = fmaxf(m, swz<16>(m)); m = max_x32(m);
    float lsum = 0.f;
    bf16x8 af[NT / 2];
#pragma unroll
    for (int kst = 0; kst < NT / 2; ++kst) {
        float pv[8];
#pragma unroll
        for (int rr = 0; rr < 4; ++rr) { pv[rr] = __expf(acc[2 * kst][rr] - m); pv[4 + rr] = __expf(acc[2 * kst + 1][rr] - m); }
#pragma unroll
        for (int i = 0; i < 8; ++i) lsum += pv[i];
        v4u aw; aw.x = pk2(pv[0], pv[1]); aw.y = pk2(pv[2], pv[3]); aw.z = pk2(pv[4], pv[5]); aw.w = pk2(pv[6], pv[7]);
        af[kst] = __builtin_bit_cast(bf16x8, aw);
    }
    lsum += swz<16>(lsum); lsum = sum_x32(lsum);
    f32x4 o[8];
#pragma unroll
    for (int dt = 0; dt < 8; ++dt) o[dt] = (f32x4){0.f, 0.f, 0.f, 0.f};
#pragma unroll
    for (int k0 = 0; k0 < NT / 2; k0 += 2) {
        v4u vv[2][8];
#pragma unroll
        for (int kk = 0; kk < 2; ++kk) { const int kst = k0 + kk;
            const int posbase = (2 * kst < NTB) ? CTX + (r0 + kst) * 64 + bc0 : 32 * (kst - NTB / 2);
#pragma unroll
            for (int dt = 0; dt < 8; ++dt) {
                if (CL && 2 * kst >= NTB) vv[kk][dt] = *(const LAS v4u*)(lv + (16 * dt + lr) * 264 + posbase + 8 * g);
                else vv[kk][dt] = *(const GAS v4u*)(VT + (size_t)(16 * dt + lr) * vts + posbase + 8 * g); } }
#pragma unroll
        for (int kk = 0; kk < 2; ++kk)
#pragma unroll
            for (int dt = 0; dt < 8; ++dt) o[dt] = __builtin_amdgcn_mfma_f32_16x16x32_bf16(af[k0 + kk], __builtin_bit_cast(bf16x8, vv[kk][dt]), o[dt], 0, 0, 0);
        __builtin_amdgcn_sched_barrier(0);
    }
    float linv[4];
#pragma unroll
    for (int rr = 0; rr < 4; ++rr) linv[rr] = 1.0f / lane_get(lsum, 4 * g + rr);
#pragma unroll
    for (int dt = 0; dt < 8; ++dt)
#pragma unroll
        for (int rr = 0; rr < 4; ++rr) outp[(size_t)(4 * g + rr) * DM + 16 * dt + lr] = o[dt][rr] * linv[rr];
}
__device__ __forceinline__ void rc_geom(int rc, int& b, int& pos0) { if (rc < 64) { b = rc >> 5; pos0 = CTX + (rc & 31) * 128; } else { b = (rc - 64) >> 1; pos0 = ((rc - 64) & 1) * 128; } }
__device__ __forceinline__ bf16x8 scale_frag(bf16x8 x, const LAS float* w) {
    const v4u u = __builtin_bit_cast(v4u, x); const f32x4 w0 = *(const LAS f32x4*)w, w1 = *(const LAS f32x4*)(w + 4);
    v4u o; o.x = pk2(bflo(u.x) * w0.x, bfhi(u.x) * w0.y); o.y = pk2(bflo(u.y) * w0.z, bfhi(u.y) * w0.w); o.z = pk2(bflo(u.z) * w1.x, bfhi(u.z) * w1.y); o.w = pk2(bflo(u.w) * w1.z, bfhi(u.w) * w1.w);
    return __builtin_bit_cast(bf16x8, o);
}
__device__ __forceinline__ void ssd_states_unit(Frame& F, int rc, int j16, LAS float* wt, int lane) {
    const int d = j16 >> 3, hh = j16 & 7, g = hh >> 2, lr = lane & 15, gq = lane >> 4, rowbase = rc * 128;
    int b, pos0; rc_geom(rc, b, pos0);
    const float* CUM = (const float*)(F.ws + WS_CUM); const float* DT = (const float*)(F.ws + WS_DT); const float tot = ((const float*)(F.ws + WS_TOT))[rc * 16 + j16];
    wt[lane] = expf(tot - CUM[(size_t)(rowbase + lane) * 16 + j16]) * DT[(size_t)(rowbase + lane) * 16 + j16];
    wt[lane + 64] = expf(tot - CUM[(size_t)(rowbase + 64 + lane) * 16 + j16]) * DT[(size_t)(rowbase + 64 + lane) * 16 + j16];
    LDS_WAIT(); asm volatile("" ::: "memory");
    const bf16* XTp = (const bf16*)(F.ws + WS_XT) + ((size_t)b * 512 + hh * 64 + lr) * LK + pos0 + 8 * gq;
    const bf16* BTp = (const bf16*)(F.ws + WS_BT) + ((size_t)b * 256 + g * 128 + lr) * LK + pos0 + 8 * gq;
    float* ST = (float*)(F.ws + WS_ST) + (size_t)(rc * 16 + j16) * 8192 + (4 * gq) * 128 + lr;
#pragma unroll 1
    for (int nh = 0; nh < 2; ++nh) {
        f32x4 acc[4][4];
#pragma unroll
        for (int pt = 0; pt < 4; ++pt)
#pragma unroll
            for (int nt = 0; nt < 4; ++nt) acc[pt][nt] = (f32x4){0.f, 0.f, 0.f, 0.f};
#pragma unroll
        for (int ks = 0; ks < 4; ++ks) {
            bf16x8 af[4];
#pragma unroll
            for (int pt = 0; pt < 4; ++pt) af[pt] = scale_frag(*(const GAS bf16x8*)(XTp + (size_t)(16 * pt) * LK + 32 * ks), wt + 32 * ks + 8 * gq);
#pragma unroll
            for (int nt = 0; nt < 4; ++nt) { const bf16x8 bfr = *(const GAS bf16x8*)(BTp + (size_t)(64 * nh + 16 * nt) * LK + 32 * ks);
#pragma unroll
                for (int pt = 0; pt < 4; ++pt) acc[pt][nt] = __builtin_amdgcn_mfma_f32_16x16x32_bf16(af[pt], bfr, acc[pt][nt], 0, 0, 0); }
            if (ks & 1) __builtin_amdgcn_sched_barrier(0);
        }
        float* sp = ST + 64 * nh;
#pragma unroll
        for (int pt = 0; pt < 4; ++pt)
#pragma unroll
            for (int r = 0; r < 4; ++r)
#pragma unroll
                for (int nt = 0; nt < 4; ++nt) sp[(16 * pt + r) * 128 + 16 * nt] = acc[pt][nt][r];
    }
    asm volatile("" ::: "memory");
}
__device__ __forceinline__ void ssd_scan(Frame& F) {
    const float* ST = (const float*)(F.ws + WS_ST); const float* TOT = (const float*)(F.ws + WS_TOT); bf16* HIN = (bf16*)(F.ws + WS_HIN);
    const bool split = DEF_PER_PHASE > 0; if (split && (F.vcu & 1)) return;
    for (int idx = ((split ? F.vcu >> 1 : F.vcu) * NWAVES * 64) + F.tid; idx < 65536; idx += (split ? F.G >> 1 : F.G) * NWAVES * 64) {
        const int n4 = idx & 31, p = (idx >> 5) & 63, hh = (idx >> 11) & 7, d = (idx >> 14) & 1, b = idx >> 15;
        f32x4 run = {0.f, 0.f, 0.f, 0.f};
#pragma unroll 1
        for (int s0 = 0; s0 < 34; s0 += 17) {
            f32x4 sv[17]; float dec[17];
#pragma unroll
            for (int u = 0; u < 17; ++u) { const int step = s0 + u;
                const int rc = d == 0 ? (step < 2 ? 64 + 2 * b + step : 32 * b + step - 2) : (step < 2 ? 64 + 2 * b + 1 - step : 32 * b + 33 - step);
                sv[u] = *(const GAS f32x4*)(ST + (size_t)(rc * 16 + d * 8 + hh) * 8192 + p * 128 + 4 * n4); dec[u] = expf(TOT[rc * 16 + d * 8 + hh]); }
#pragma unroll
            for (int u = 0; u < 17; ++u) { const int step = s0 + u;
                const int rc = d == 0 ? (step < 2 ? 64 + 2 * b + step : 32 * b + step - 2) : (step < 2 ? 64 + 2 * b + 1 - step : 32 * b + 33 - step);
                v2u o; o.x = pk2(run.x, run.y); o.y = pk2(run.z, run.w);
                *(GAS v2u*)(HIN + (size_t)(rc * 16 + d * 8 + hh) * 8192 + p * 128 + 4 * n4) = o;
                run = run * dec[u] + sv[u]; }
        }
    }
}
__device__ __forceinline__ void ssd_out_unit(Frame& F, const Args& A, int l, int rc, int q, LAS float* tab, LAS float* ssq, int hh, int lane) {
    const int g = hh >> 2, lr = lane & 15, gq = lane >> 4, rowbase = rc * 128;
    int b, pos0; rc_geom(rc, b, pos0);
    const float* __restrict__ CUM = (const float*)(F.ws + WS_CUM); const float* __restrict__ DT = (const float*)(F.ws + WS_DT);
    const bf16* __restrict__ BCB = (const bf16*)(F.ws + WS_BCB);
    float tv[8];
#pragma unroll
    for (int k = 0; k < 2; ++k) { const size_t ro = (size_t)(rowbase + lane + 64 * k) * 16; tv[4 * k] = CUM[ro + hh]; tv[4 * k + 1] = CUM[ro + 8 + hh]; tv[4 * k + 2] = DT[ro + hh]; tv[4 * k + 3] = DT[ro + 8 + hh]; }
    bf16x8 cf[2][4];
#pragma unroll
    for (int it = 0; it < 2; ++it)
#pragma unroll
        for (int ks = 0; ks < 4; ++ks) cf[it][ks] = *(const GAS bf16x8*)(BCB + (size_t)(rowbase + 32 * q + 16 * it + lr) * 512 + 256 + g * 128 + 32 * ks + 8 * gq);
    const int jperm = 8 * (lr >> 2) + (lr & 3);
    f32x4 S[8][2];
#pragma unroll
    for (int jh = 0; jh < 2; ++jh) {
        bf16x8 bfr[4][4];
#pragma unroll
        for (int jj = 0; jj < 4; ++jj)
#pragma unroll
            for (int ks = 0; ks < 4; ++ks) bfr[jj][ks] = *(const GAS bf16x8*)(BCB + (size_t)(rowbase + 32 * ((4 * jh + jj) >> 1) + jperm + 4 * (jj & 1)) * 512 + g * 128 + 32 * ks + 8 * gq);
        if (jh == 0) {
#pragma unroll
            for (int k = 0; k < 2; ++k) { const int t = lane + 64 * k; tab[t] = tv[4 * k]; tab[128 + t] = tv[4 * k + 1]; tab[256 + t] = tv[4 * k + 2]; tab[384 + t] = tv[4 * k + 3]; }
        }
#pragma unroll
        for (int jj = 0; jj < 4; ++jj) { f32x4 a0 = {0.f, 0.f, 0.f, 0.f}, a1 = a0;
#pragma unroll
            for (int ks = 0; ks < 4; ++ks) { a0 = __builtin_amdgcn_mfma_f32_16x16x32_bf16(bfr[jj][ks], cf[0][ks], a0, 0, 0, 0); a1 = __builtin_amdgcn_mfma_f32_16x16x32_bf16(bfr[jj][ks], cf[1][ks], a1, 0, 0, 0); }
            S[4 * jh + jj][0] = a0; S[4 * jh + jj][1] = a1; }
        __builtin_amdgcn_sched_barrier(0);
    }
    LDS_WAIT(); asm volatile("" ::: "memory");
    bf16x8 af[4][2];
#pragma unroll
    for (int it = 0; it < 2; ++it) {
        const int i = 32 * q + 16 * it + lr; const float c0i = tab[i], c1i = tab[128 + i];
#pragma unroll
        for (int kst = 0; kst < 4; ++kst) { float mv[8];
#pragma unroll
            for (int h2 = 0; h2 < 2; ++h2)
#pragma unroll
                for (int r = 0; r < 4; ++r) { const int jt = 2 * kst + h2, j = 32 * kst + 8 * gq + 4 * h2 + r;
                    const bool le = j <= i; const float arg = le ? c0i - tab[j] : c1i - tab[128 + j]; const float dts = le ? tab[256 + j] : tab[384 + j];
                    float fct = __expf(arg) * dts; if (j == i) fct += tab[384 + j];
                    mv[4 * h2 + r] = S[jt][it][r] * fct; }
            v4u aw; aw.x = pk2(mv[0], mv[1]); aw.y = pk2(mv[2], mv[3]); aw.z = pk2(mv[4], mv[5]); aw.w = pk2(mv[6], mv[7]); af[kst][it] = __builtin_bit_cast(bf16x8, aw); }
    }
    const bf16* __restrict__ XTp = (const bf16*)(F.ws + WS_XT) + ((size_t)b * 512 + hh * 64 + lr) * LK + pos0 + 8 * gq;
    v4u xfr[4][4];
#pragma unroll
    for (int kst = 0; kst < 4; ++kst)
#pragma unroll
        for (int pt = 0; pt < 4; ++pt) xfr[kst][pt] = *(const GAS v4u*)(XTp + (size_t)(16 * pt) * LK + 32 * kst);
    f32x4 y[2][4];
#pragma unroll
    for (int it = 0; it < 2; ++it)
#pragma unroll
        for (int pt = 0; pt < 4; ++pt) y[it][pt] = (f32x4){0.f, 0.f, 0.f, 0.f};
#pragma unroll
    for (int kst = 0; kst < 4; ++kst)
#pragma unroll
        for (int pt = 0; pt < 4; ++pt) { const bf16x8 bfr = __builtin_bit_cast(bf16x8, xfr[kst][pt]);
            y[0][pt] = __builtin_amdgcn_mfma_f32_16x16x32_bf16(af[kst][0], bfr, y[0][pt], 0, 0, 0); y[1][pt] = __builtin_amdgcn_mfma_f32_16x16x32_bf16(af[kst][1], bfr, y[1][pt], 0, 0, 0); }
    __builtin_amdgcn_sched_barrier(0);
#pragma unroll
    for (int d = 0; d < 2; ++d) {
        const bf16* __restrict__ HP = (const bf16*)(F.ws + WS_HIN) + (size_t)(rc * 16 + d * 8 + hh) * 8192 + (size_t)lr * 128 + 8 * gq;
        bf16x8 hf[4][4];
#pragma unroll
        for (int ks = 0; ks < 4; ++ks)
#pragma unroll
            for (int pt = 0; pt < 4; ++pt) hf[ks][pt] = *(const GAS bf16x8*)(HP + (size_t)(16 * pt) * 128 + 32 * ks);
        f32x4 t[2][4];
#pragma unroll
        for (int it = 0; it < 2; ++it)
#pragma unroll
            for (int pt = 0; pt < 4; ++pt) t[it][pt] = (f32x4){0.f, 0.f, 0.f, 0.f};
#pragma unroll
        for (int ks = 0; ks < 4; ++ks)
#pragma unroll
            for (int pt = 0; pt < 4; ++pt) { t[0][pt] = __builtin_amdgcn_mfma_f32_16x16x32_bf16(cf[0][ks], hf[ks][pt], t[0][pt], 0, 0, 0); t[1][pt] = __builtin_amdgcn_mfma_f32_16x16x32_bf16(cf[1][ks], hf[ks][pt], t[1][pt], 0, 0, 0); }
#pragma unroll
        for (int it = 0; it < 2; ++it)
#pragma unroll
            for (int r = 0; r < 4; ++r) { const float e = __expf(tab[128 * d + 32 * q + 16 * it + 4 * gq + r]);
#pragma unroll
                for (int pt = 0; pt < 4; ++pt) y[it][pt][r] += e * t[it][pt][r]; }
        __builtin_amdgcn_sched_barrier(0);
    }
    const float skip = ain(A, I_DSKIP)[l * 16 + hh] + ain(A, I_DSKIP)[l * 16 + 8 + hh];
    const float* __restrict__ XBC = (const float*)(F.ws + WS_XBC); const bf16* __restrict__ P = (const bf16*)(F.ws + WS_P);
    float xv[2][4][4]; unsigned short zv[2][4][4];
#pragma unroll
    for (int it = 0; it < 2; ++it)
#pragma unroll
        for (int r = 0; r < 4; ++r) { const size_t row = (size_t)(rowbase + 32 * q + 16 * it + 4 * gq + r);
#pragma unroll
            for (int pt = 0; pt < 4; ++pt) { const int ch = hh * 64 + 16 * pt + lr; xv[it][r][pt] = XBC[row * 1024 + ch]; zv[it][r][pt] = P[row * NINP + C_DZ + ch]; } }
#pragma unroll
    for (int it = 0; it < 2; ++it)
#pragma unroll
        for (int r = 0; r < 4; ++r) { float s = 0.f;
#pragma unroll
            for (int pt = 0; pt < 4; ++pt) { const float v = (y[it][pt][r] + skip * xv[it][r][pt]) * silu_fast(bf2f(zv[it][r][pt])); y[it][pt][r] = v; s += v * v; }
            s += swz<1>(s); s += swz<2>(s); s += swz<4>(s); s += swz<8>(s);
            if (lr == 0) ssq[hh * 32 + 16 * it + 4 * gq + r] = s; }
    LDS_WAIT(); __syncthreads();
    const float* __restrict__ on = ain(A, I_ONORM) + l * DM + 1536; bf16* __restrict__ OB = (bf16*)(F.ws + WS_OB);
    float gn[4];
#pragma unroll
    for (int pt = 0; pt < 4; ++pt) gn[pt] = on[hh * 64 + 16 * pt + lr];
#pragma unroll
    for (int it = 0; it < 2; ++it)
#pragma unroll
        for (int r = 0; r < 4; ++r) { const int ti = 16 * it + 4 * gq + r; float s = 0.f;
#pragma unroll
            for (int w = 0; w < 8; ++w) s += ssq[w * 32 + ti];
            const float rn = 1.0f / sqrtf(s * (1.0f / 512.f) + EPS); const size_t row = (size_t)(rowbase + 32 * q + ti);
#pragma unroll
            for (int pt = 0; pt < 4; ++pt) { const int ch = hh * 64 + 16 * pt + lr; OB[row * DM + 1536 + ch] = (bf16)f2bf(y[it][pt][r] * rn * gn[pt]); } }
    __syncthreads();
}
__device__ __forceinline__ void mixa_d1(Frame& F) {
    const int gw = F.vcu * NWAVES + F.wave, NGW = F.G * NWAVES, lane = F.lane;
    LAS float* wt = (LAS float*)(F.lds + F.wave * 512);
    for (int it = gw; it < 68 * 16; it += NGW) { int ln = lane; asm volatile("" : "+v"(ln)); ssd_states_unit(F, it >> 4, it & 15, wt, ln); }
}
__device__ __forceinline__ void mixa_ctx(Frame& F) {
    const bf16* P = (const bf16*)(F.ws + WS_P); const bf16* QA = (const bf16*)(F.ws + WS_QA); const bf16* KA = (const bf16*)(F.ws + WS_KA);
    float* OM = (float*)(F.ws + WS_OM);
    LAS bf16* lk = (LAS bf16*)F.lds; LAS bf16* lv = (LAS bf16*)(F.lds + 69632);
    for (int gi = F.G - 1 - F.vcu; gi < 32; gi += F.G) {
        const int mixer = gi >> 4, b = (gi >> 3) & 1, h = (gi >> 1) & 3, qt = (gi & 1) * 8 + F.wave;
        const bf16* kc = mixer == 0 ? KA + (size_t)b * LK * 256 + (h >> 1) * 128 : P + (size_t)(ML + b * CTX) * NINP + C_BK + h * 128; const int kcs = mixer == 0 ? 256 : NINP;
        const bf16* vt = mixer == 0 ? (const bf16*)(F.ws + WS_VTA) + (size_t)(b * 2 + (h >> 1)) * 128 * 256 : (const bf16*)(F.ws + WS_VTB) + (size_t)(b * 4 + h) * 128 * LK; const int vts = mixer == 0 ? 256 : LK;
        __syncthreads();
#pragma unroll
        for (int k = 0; k < 8; ++k) { const int idx = F.tid + 512 * k, row = idx >> 4, part = idx & 15;
            *(LAS v4u*)(lk + row * 136 + 8 * part) = *(const GAS v4u*)(kc + (size_t)row * kcs + 8 * part); }
#pragma unroll
        for (int k = 0; k < 8; ++k) { const int idx = F.tid + 512 * k, row = idx >> 5, part = idx & 31;
            *(LAS v4u*)(lv + row * 264 + 8 * part) = *(const GAS v4u*)(vt + (size_t)row * vts + 8 * part); }
        LDS_WAIT(); __syncthreads();
        int ln = F.lane; asm volatile("" : "+v"(ln));
        const int row0 = ML + b * CTX + 16 * qt, lr = ln & 15;
        const bf16* qp = mixer == 0 ? QA + (size_t)(row0 + lr) * 512 + h * 128 : P + (size_t)(row0 + lr) * NINP + C_BQ + h * 128;
        na_unit<false, true>(qp, nullptr, nullptr, 0, nullptr, 0, nullptr, 0, 0, OM + (size_t)row0 * DM + (mixer ? 512 : 0) + h * 128, ln, lk, lv);
        __syncthreads();
    }
}
__device__ __forceinline__ void mixa_na(Frame& F, const Args& A, int l) {
    const bf16* P = (const bf16*)(F.ws + WS_P); float* OM = (float*)(F.ws + WS_OM);
    LAS bf16* lk = (LAS bf16*)F.lds; LAS bf16* lv = (LAS bf16*)(F.lds + 69632);
    for (int grp = F.vcu; grp < 256; grp += F.G) {
        const int b = grp >> 7, h = (grp >> 5) & 3;
        __syncthreads();
        { const bf16* kc = P + (size_t)(ML + b * CTX) * NINP + C_BK + h * 128; const bf16* vt = (const bf16*)(F.ws + WS_VTB) + (size_t)(b * 4 + h) * 128 * LK;
#pragma unroll
          for (int k = 0; k < 8; ++k) { const int idx = F.tid + 512 * k, row = idx >> 4, part = idx & 15;
              *(LAS v4u*)(lk + row * 136 + 8 * part) = *(const GAS v4u*)(kc + (size_t)row * NINP + 8 * part); }
#pragma unroll
          for (int k = 0; k < 8; ++k) { const int idx = F.tid + 512 * k, row = idx >> 5, part = idx & 31;
              *(LAS v4u*)(lv + row * 264 + 8 * part) = *(const GAS v4u*)(vt + (size_t)row * LK + 8 * part); } }
        LDS_WAIT(); __syncthreads();
        const int u = grp * 8 + F.wave, r = (u >> 2) & 63, n = u & 3; int ln = F.lane; asm volatile("" : "+v"(ln));
        const int row0 = b * SEQ + r * 64 + 16 * n;
        na_unit<true, true>(P + (size_t)(row0 + (ln & 15)) * NINP + C_BQ + h * 128, P + (size_t)(b * SEQ) * NINP + C_BK + h * 128, nullptr, 0,
                            (const bf16*)(F.ws + WS_VTB) + (size_t)(b * 4 + h) * 128 * LK, LK, ain(A, I_RPB) + (size_t)(l * 4 + h) * 15 * 31, r, n, OM + (size_t)row0 * DM + 512 + h * 128, ln, lk, lv);
        __syncthreads();
    }
}
__device__ __forceinline__ void mixa_sgu(Frame& F, const Args& A, int l) {
    const bf16* P = (const bf16*)(F.ws + WS_P); float* OM = (float*)(F.ws + WS_OM);
    const int nunit = (l == 0 ? 68 : 64) * 4;
    for (int u = F.vcu; u < nunit; u += F.G) {
        int ln = F.lane; asm volatile("" : "+v"(ln));
        const int rc = u >> 2, g = u & 3, lr = ln & 15, gq = ln >> 4, w = F.wave;
        const bf16* Wp = (const bf16*)(F.ws + WS_SGW) + ((size_t)(l * 4 + g) * 128 + 16 * w + lr) * 128 + 8 * gq;
        bf16x8 af[4];
#pragma unroll
        for (int ks = 0; ks < 4; ++ks) af[ks] = *(const GAS bf16x8*)(Wp + 32 * ks);
        const bf16* VT = (const bf16*)(F.ws + WS_VNT) + ((size_t)rc * 512 + g * 128 + lr) * 128 + 8 * gq;
        const float* sb = ain(A, I_SGUB) + (l * 4 + g) * 128 + 16 * w + 4 * gq;
        const float sb0 = sb[0], sb1 = sb[1], sb2 = sb[2], sb3 = sb[3];
        unsigned short uv[8][4];
#pragma unroll
        for (int ct = 0; ct < 8; ++ct)
#pragma unroll
            for (int r = 0; r < 4; ++r) uv[ct][r] = P[(size_t)(rc * 128 + 16 * w + 4 * gq + r) * NINP + C_CU + g * 128 + 16 * ct + lr];
#pragma unroll
        for (int ch = 0; ch < 2; ++ch) {
            bf16x8 bfr[4][4];
#pragma unroll
            for (int cc = 0; cc < 4; ++cc)
#pragma unroll
                for (int ks = 0; ks < 4; ++ks) bfr[cc][ks] = *(const GAS bf16x8*)(VT + (size_t)(16 * (4 * ch + cc)) * 128 + 32 * ks);
#pragma unroll
            for (int cc = 0; cc < 4; ++cc) { const int ct = 4 * ch + cc;
                f32x4 acc = {0.f, 0.f, 0.f, 0.f};
#pragma unroll
                for (int ks = 0; ks < 4; ++ks) acc = __builtin_amdgcn_mfma_f32_16x16x32_bf16(af[ks], bfr[cc][ks], acc, 0, 0, 0);
                const float bs[4] = {sb0, sb1, sb2, sb3};
#pragma unroll
                for (int r = 0; r < 4; ++r) { const size_t row = (size_t)(rc * 128 + 16 * w + 4 * gq + r); const int chn = g * 128 + 16 * ct + lr;
                    OM[row * DM + 1024 + chn] = gelu_fast(bf2f(uv[ct][r])) * (acc[r] + bs[r]); } }
            __builtin_amdgcn_sched_barrier(0);
        }
    }
}
__device__ __forceinline__ void mixb_attn(Frame& F, const Args& A, int l) {
    const bf16* QA = (const bf16*)(F.ws + WS_QA); const bf16* KA = (const bf16*)(F.ws + WS_KA); const bf16* VA = (const bf16*)(F.ws + WS_VA);
    float* OM = (float*)(F.ws + WS_OM); float* AST = (float*)(F.ws + WS_AST);
    if (DEF_PER_PHASE > 0) {
        const int role = F.vcu & 1, idx = F.vcu >> 1, nhalf = F.G >> 1;
        if (role == 0) {
            for (int u = idx; u < 128; u += nhalf) {
                const int b = u >> 6, h = (u >> 4) & 3, qb = u & 15;
                const size_t row0 = (size_t)b * SEQ + qb * 256;
                att::attn_dense_body<att::bf16, 2048>((const att::bf16*)QA + row0 * 512 + h * 128, (const att::bf16*)KA + (size_t)b * LK * 256 + (h >> 1) * 128, (const att::bf16*)VA + (size_t)b * LK * 256 + (h >> 1) * 128,
                                                      OM + row0 * DM + h * 128, LK, (char*)F.ldsg, F.wave, AST + row0 * 8 + h * 2);
                __syncthreads();
            }
        } else cvt8_deferred(F, A, l * DEF_PER_PHASE, DEF_PER_PHASE, idx * NWAVES + F.wave, nhalf * NWAVES);
    } else {
        float* OM2 = (float*)(F.ws + WS_OM2);
        for (int u = F.vcu; u < 256; u += F.G) {
            const int b = u >> 7, h = (u >> 5) & 3, half = (u >> 4) & 1, qb = u & 15;
            const size_t row0 = (size_t)b * SEQ + qb * 256, k0 = (size_t)b * LK + half * (LK / 2);
            float* Ob = half ? OM2 + row0 * 512 + h * 128 : OM + row0 * DM + h * 128;
            if (half) att::attn_dense_body<att::bf16, 512>((const att::bf16*)QA + row0 * 512 + h * 128, (const att::bf16*)KA + k0 * 256 + (h >> 1) * 128, (const att::bf16*)VA + k0 * 256 + (h >> 1) * 128,
                                                       Ob, LK / 2, (char*)F.ldsg, F.wave, AST + ((size_t)ML + row0) * 8 + h * 2);
            else att::attn_dense_body<att::bf16, 2048>((const att::bf16*)QA + row0 * 512 + h * 128, (const att::bf16*)KA + k0 * 256 + (h >> 1) * 128, (const att::bf16*)VA + k0 * 256 + (h >> 1) * 128,
                                                       Ob, LK / 2, (char*)F.ldsg, F.wave, AST + row0 * 8 + h * 2);
            __syncthreads();
        }
    }
}
__device__ __forceinline__ void merge_d3(Frame& F, const Args& A, int l) {
    LAS float* tab = (LAS float*)(F.lds + F.wave * 2048); LAS float* ssq = (LAS float*)(F.lds + 16384);
    const int nunit = (l == 0 ? 68 : 64) * 4;
    for (int u = F.vcu; u < nunit; u += F.G) { int ln = F.lane; asm volatile("" : "+v"(ln)); ssd_out_unit(F, A, l, u >> 2, u & 3, tab, ssq, F.wave, ln); }
}
__device__ __forceinline__ void merge_stream(Frame& F, const Args& A) {
    if (F.G == 256 && F.vcu >= 16) cvt8_deferred(F, A, OFF_MG0, MG0_ITEMS, (F.vcu - 16) * NWAVES + F.wave, 240 * NWAVES);
}
__device__ __forceinline__ void merge_abc(Frame& F, const Args& A, int l) {
    const int gw = F.vcu * NWAVES + F.wave, NGW = F.G * NWAVES, lane = F.lane;
    const float* OM = (const float*)(F.ws + WS_OM);
    bf16* OB = (bf16*)(F.ws + WS_OB);
    const float* on = ain(A, I_ONORM) + l * DM;
    const int nrow = l == 0 ? MT : ML;
    f32x4 gn[3][2];
#pragma unroll
    for (int g = 0; g < 3; ++g) { gn[g][0] = *(const GAS f32x4*)(on + g * 512 + 8 * lane); gn[g][1] = *(const GAS f32x4*)(on + g * 512 + 8 * lane + 4); }
    for (int row = gw; row < nrow; row += NGW) {
        f32x4 va[3], vc[3];
#pragma unroll
        for (int g = 0; g < 3; ++g) { va[g] = *(const GAS f32x4*)(OM + (size_t)row * DM + g * 512 + 8 * lane); vc[g] = *(const GAS f32x4*)(OM + (size_t)row * DM + g * 512 + 8 * lane + 4); }
        if (DEF_PER_PHASE == 0 && row < ML) {
            const float* AST = (const float*)(F.ws + WS_AST); const float* OM2 = (const float*)(F.ws + WS_OM2);
            const f32x2 s1 = *(const GAS f32x2*)(AST + (size_t)row * 8 + (lane >> 4) * 2), s2 = *(const GAS f32x2*)(AST + ((size_t)ML + row) * 8 + (lane >> 4) * 2);
            const float mm = fmaxf(s1.x, s2.x); constexpr float CC = 0.088388347648318440f * 1.4426950408889634f;
            const float w1 = s1.y * exp2f((s1.x - mm) * CC), w2 = s2.y * exp2f((s2.x - mm) * CC), inv = 1.0f / (w1 + w2);
            const f32x4 a2 = *(const GAS f32x4*)(OM2 + (size_t)row * 512 + 8 * lane), c2 = *(const GAS f32x4*)(OM2 + (size_t)row * 512 + 8 * lane + 4);
            va[0] = (va[0] * w1 + a2 * w2) * inv; vc[0] = (vc[0] * w1 + c2 * w2) * inv;
        }
        float ss[3];
#pragma unroll
        for (int g = 0; g < 3; ++g) ss[g] = (va[g].x * va[g].x + va[g].y * va[g].y) + (va[g].z * va[g].z + va[g].w * va[g].w) + (vc[g].x * vc[g].x + vc[g].y * vc[g].y) + (vc[g].z * vc[g].z + vc[g].w * vc[g].w);
#pragma unroll
        for (int g = 0; g < 3; ++g) ss[g] = wave_sum(ss[g]);
#pragma unroll
        for (int g = 0; g < 3; ++g) { const float r = 1.0f / sqrtf(ss[g] * (1.0f / 512.f) + EPS);
            const f32x4 x = va[g] * r * gn[g][0], y = vc[g] * r * gn[g][1];
            v4u o; o.x = pk2(x.x, x.y); o.y = pk2(x.z, x.w); o.z = pk2(y.x, y.y); o.w = pk2(y.z, y.w);
            *(GAS v4u*)(OB + (size_t)row * DM + g * 512 + 8 * lane) = o; }
    }
}
__device__ __forceinline__ void phase_n2(Frame& F, const Args& A, int l) {
    const int gw = F.vcu * NWAVES + F.wave, NGW = F.G * NWAVES, lane = F.lane;
    const float* mod = (const float*)(F.ws + WS_MOD) + (size_t)l * 3 * MODW;
    const float* XA = (const float*)(F.ws + WS_XA);
    bf16* H = (bf16*)(F.ws + WS_H);
    const int nrow = l == 0 ? MT : ML;
    for (int row = gw; row < nrow; row += NGW) {
        const float* m = mod + row_vec(row) * MODW; f32x4 y[8];
        if (row >= ML) {
            f32x4 v[8];
            ctx_row_from_parts<4>(ain(A, I_CTX) + (size_t)(row - ML) * DM, m + 2 * DM, (const float*)(F.ws + WS_PARTW), row - ML, lane, v);
            float* xo = (float*)(F.ws + WS_XA) + (size_t)row * DM;
#pragma unroll
            for (int j = 0; j < 8; ++j) *(GAS f32x4*)(xo + 4 * lane + 256 * j) = v[j];
            norm_mod_vals(v, ain(A, I_NFFN) + l * DM, m + 3 * DM, m + 4 * DM, H + (size_t)row * DM, lane, y);
        } else norm_mod_row(XA + (size_t)row * DM, ain(A, I_NFFN) + l * DM, m + 3 * DM, m + 4 * DM, H + (size_t)row * DM, lane, y);
    }
}
__device__ __forceinline__ void phase_n2_route(Frame& F, const Args& A) {
    const int gw = F.vcu * NWAVES + F.wave, NGW = F.G * NWAVES, lane = F.lane;
    const float* mod = (const float*)(F.ws + WS_MOD) + (size_t)3 * MODW;
    const float* XA = (const float*)(F.ws + WS_XA);
    bf16* H = (bf16*)(F.ws + WS_H);
    int* route = (int*)(F.ws + WS_ROUTE);
    LAS f32x4* rl = (LAS f32x4*)F.lds;
    for (int i = F.tid; i < 4096; i += NWAVES * 64) rl[i] = *(const GAS f32x4*)(ain(A, I_ROUTER) + 4 * i);
    LAS int* sel = (LAS int*)(F.lds + 65536);
    __syncthreads();
#pragma unroll 1
    for (int k = 0; k < 4; ++k) {
        const int row = gw + k * NGW; int ln = lane; asm volatile("" : "+v"(ln));
        const float* m = mod + row_vec(row) * MODW; f32x4 y[8];
        norm_mod_row(XA + (size_t)row * DM, ain(A, I_NFFN) + DM, m + 3 * DM, m + 4 * DM, H + (size_t)row * DM, ln, y);
        float lg[8];
#pragma unroll
        for (int e = 0; e < 8; ++e) lg[e] = 0.f;
#pragma unroll
        for (int j = 0; j < 8; ++j) {
#pragma unroll
            for (int i = 0; i < 4; ++i) { const int kk = 4 * ln + 256 * j + i;
                const f32x4 r0 = rl[2 * kk], r1 = rl[2 * kk + 1];
                const float yy = y[j][i];
                lg[0] += yy * r0.x; lg[1] += yy * r0.y; lg[2] += yy * r0.z; lg[3] += yy * r0.w; lg[4] += yy * r1.x; lg[5] += yy * r1.y; lg[6] += yy * r1.z; lg[7] += yy * r1.w; }
            __builtin_amdgcn_sched_barrier(0);
        }
#pragma unroll
        for (int e = 0; e < 8; ++e) lg[e] = wave_sum(lg[e]);
        int e0 = 0; float v0 = lg[0];
#pragma unroll
        for (int e = 1; e < 8; ++e) if (lg[e] > v0) { v0 = lg[e]; e0 = e; }
        int e1 = -1; float v1 = -3.4e38f;
#pragma unroll
        for (int e = 0; e < 8; ++e) if (e != e0 && lg[e] > v1) { v1 = lg[e]; e1 = e; }
        const float ex = expf(v1 - v0), w0 = 1.0f / (1.0f + ex), w1 = ex / (1.0f + ex);
        if (ln == 0) { LAS int* s = sel + (F.wave * 4 + k) * 4; s[0] = e0; s[1] = e1; s[2] = __builtin_bit_cast(int, w0); s[3] = __builtin_bit_cast(int, w1); }
    }
    LDS_WAIT(); __syncthreads();
    if (F.wave == 0) {
        const bool valid = lane < 32;
        const int e0 = valid ? sel[lane * 4] : -1, e1 = valid ? sel[lane * 4 + 1] : -1;
        const unsigned long long lt = (1ull << lane) - 1ull;
        int cnt_mine = 0, r0 = 0, r1 = 0;
#pragma unroll
        for (int e = 0; e < 8; ++e) { const unsigned long long b0 = __ballot(e0 == e), b1 = __ballot(e1 == e);
            const int c0 = __popcll(b0), c = c0 + __popcll(b1);
            if (lane == e) cnt_mine = c;
            if (e0 == e) r0 = __popcll(b0 & lt);
            if (e1 == e) r1 = c0 + __popcll(b1 & lt); }
        int base = 0;
        if (lane < 8) base = (int)__hip_atomic_fetch_add((unsigned*)(F.ctl + CW_CNT + 64 * lane), (unsigned)cnt_mine, RLX_AGENT);
        int b0v = 0, b1v = 0;
#pragma unroll
        for (int e = 0; e < 8; ++e) { const int be = __builtin_amdgcn_readlane(base, e); if (e0 == e) b0v = be; if (e1 == e) b1v = be; }
        if (valid) { const int row = (F.vcu * NWAVES + (lane >> 2)) + (lane & 3) * NGW;
            int* rr = route + (size_t)row * 8;
            rr[0] = e0; rr[1] = e1; rr[2] = b0v + r0; rr[3] = b1v + r1; rr[4] = sel[lane * 4 + 2]; rr[5] = sel[lane * 4 + 3]; }
    }
}
__device__ __forceinline__ void moe_tiles(Frame& F) {
    __syncthreads();
    if (F.tid == 0) { unsigned acc = 0;
        for (int e = 0; e < 8; ++e) { F.MISC[16 + e] = acc; const unsigned c = __hip_atomic_load((unsigned*)(F.ctl + CW_CNT + 64 * e), RLX_AGENT); acc += (c + 255u) >> 8; }
        F.MISC[24] = acc; }
    __syncthreads();
}
__device__ __forceinline__ void phase_gather(Frame& F) {
    const int gw = F.vcu * NWAVES + F.wave, NGW = F.G * NWAVES, lane = F.lane;
    moe_tiles(F);
    const bf16* H = (const bf16*)(F.ws + WS_H); bf16* HS = (bf16*)(F.ws + WS_HS);
    int* route = (int*)(F.ws + WS_ROUTE);
    for (int it = gw; it < ML * 2; it += NGW) {
        const int tok = it >> 1, k = it & 1;
        const int e = route[(size_t)tok * 8 + k], pos = route[(size_t)tok * 8 + 2 + k];
        const int slot = (int)F.MISC[16 + e] * 256 + pos;
        const v4u* src = (const v4u*)(H + (size_t)tok * DM) + 4 * lane;
        v4u o[2];
#pragma unroll
        for (int j = 0; j < 2; ++j) { const v4u a = src[2 * j], b2 = src[2 * j + 1];
            o[j].x = pg8::pack_fp8x4(bflo(a.x) * 4.f, bfhi(a.x) * 4.f, bflo(a.y) * 4.f, bfhi(a.y) * 4.f); o[j].y = pg8::pack_fp8x4(bflo(a.z) * 4.f, bfhi(a.z) * 4.f, bflo(a.w) * 4.f, bfhi(a.w) * 4.f);
            o[j].z = pg8::pack_fp8x4(bflo(b2.x) * 4.f, bfhi(b2.x) * 4.f, bflo(b2.y) * 4.f, bfhi(b2.y) * 4.f); o[j].w = pg8::pack_fp8x4(bflo(b2.z) * 4.f, bfhi(b2.z) * 4.f, bflo(b2.w) * 4.f, bfhi(b2.w) * 4.f); }
        v4u* dst = (v4u*)((unsigned char*)HS + (size_t)slot * DM) + 2 * lane;
        dst[0] = o[0]; dst[1] = o[1];
        if (lane == 0) route[(size_t)tok * 8 + 6 + k] = slot;
    }
}
__device__ __forceinline__ void phase_final(Frame& F, const Args& A) {
    const int gw = F.vcu * NWAVES + F.wave, NGW = F.G * NWAVES, lane = F.lane;
    const float* mod = (const float*)(F.ws + WS_MOD) + (size_t)1 * 3 * MODW;
    const float* XA = (const float*)(F.ws + WS_XA); const bf16* YM = (const bf16*)(F.ws + WS_YM);
    const int* route = (const int*)(F.ws + WS_ROUTE);
    const unsigned* tfb = (const unsigned*)(F.ctl + CW_TAIL);
    const float* YMP = (const float*)(F.ws + WS_YMP);
    f32x4 gn[8];
#pragma unroll
    for (int j = 0; j < 8; ++j) gn[j] = *(const GAS f32x4*)(ain(A, I_FNORM) + 4 * lane + 256 * j);
    for (int row = gw; row < ML; row += NGW) {
        const v4u rq = *(const GAS v4u*)(route + (size_t)row * 8 + 4);
        float w0 = __builtin_bit_cast(float, rq.x), w1 = __builtin_bit_cast(float, rq.y);
        asm volatile("v_mov_b32 %0, %1" : "=v"(w1) : "v"(rq.y));
        const int sl0 = __builtin_amdgcn_readfirstlane((int)rq.z), sl1 = __builtin_amdgcn_readfirstlane((int)rq.w);
        const unsigned fl = *(const GAS unsigned*)(tfb + (((lane & 8) ? sl1 : sl0) >> 8) * 8 + (lane & 7));
        const bf16* y0 = YM + (size_t)sl0 * DM; const bf16* y1 = YM + (size_t)sl1 * DM;
        const float* g2 = mod + row_vec(row) * MODW + 5 * DM;
        f32x4 v[8], g[8]; v2u ta[8], tb[8];
#pragma unroll
        for (int j = 0; j < 8; ++j) { const int c = 4 * lane + 256 * j;
            v[j] = *(const GAS f32x4*)(XA + (size_t)row * DM + c); g[j] = *(const GAS f32x4*)(g2 + c);
            ta[j] = *(const GAS v2u*)(y0 + c); tb[j] = *(const GAS v2u*)(y1 + c); }
        float ss = 0.f;
#pragma unroll
        for (int j = 0; j < 8; ++j) { const int c = 4 * lane + 256 * j;
            f32x4 a = f32x4{bflo(ta[j].x), bfhi(ta[j].x), bflo(ta[j].y), bfhi(ta[j].y)}, bb = f32x4{bflo(tb[j].x), bfhi(tb[j].x), bflo(tb[j].y), bfhi(tb[j].y)};
            {
                const int s0 = __builtin_amdgcn_readlane((int)fl, j), s1 = __builtin_amdgcn_readlane((int)fl, 8 + j);
                if (s0) { a = *(const GAS f32x4*)(YMP + (size_t)sl0 * DM + c); for (int k = 1; k < s0; ++k) a += *(const GAS f32x4*)(YMP + ((size_t)k * MSLOT + sl0) * DM + c); }
                if (s1) { bb = *(const GAS f32x4*)(YMP + (size_t)sl1 * DM + c); for (int k = 1; k < s1; ++k) bb += *(const GAS f32x4*)(YMP + ((size_t)k * MSLOT + sl1) * DM + c); } }
            v[j] = v[j] + g[j] * (a * w0 + bb * w1);
            ss += (v[j].x * v[j].x + v[j].y * v[j].y) + (v[j].z * v[j].z + v[j].w * v[j].w); }
        const float r = 1.0f / sqrtf(wave_sum(ss) * (1.0f / DM) + EPS);
#pragma unroll
        for (int j = 0; j < 8; ++j) { const int c = 4 * lane + 256 * j;
            *(GAS f32x4*)(F.out + (size_t)row * DM + c) = v[j] * r * gn[j]; }
    }
}

#ifndef MK_N_LAUNCHES
#define MK_N_LAUNCHES 1
#endif
constexpr int NPH = 24;
__global__ void __launch_bounds__(NWAVES * 64, 2) hymba_fwd(Args args) {
    extern __shared__ __attribute__((aligned(16))) unsigned char lds[];
#define MKFRAME() Frame F; { int t_ = wave_s * 64 + lane_id(); asm volatile("" : "+v"(t_)); size_t wo_ = 0; asm volatile("" : "+s"(wo_)); unsigned char* w_ = (unsigned char*)(args.ws + wo_);     unsigned lb_ = 0; asm volatile("" : "+s"(lb_)); \
    F.lds = (LAS unsigned char*)lds + lb_; F.ldsg = lds + lb_; F.MISC = (volatile LAS unsigned*)(F.lds + MISC_OFF); \
    F.tid = t_; F.lane = t_ & 63; F.wave = __builtin_amdgcn_readfirstlane(t_ >> 6); \
    F.G = gridDim.x; { const int bx = blockIdx.x; F.vcu = (F.G % 8 == 0) ? (bx % 8) * (F.G / 8) + bx / 8 : bx; } \
    F.ws = w_; F.out = (float*)args.out; F.ctl = (gu32*)(w_ + WS_CTL); }
    const int wave_s = __builtin_amdgcn_readfirstlane((int)threadIdx.x >> 6);
    for (int u = threadIdx.x; u < (LDS_BYTES - LDSCTL_OFF) / 4; u += NWAVES * 64) ((LAS unsigned*)((LAS unsigned char*)lds + LDSCTL_OFF))[u] = 0u;
    __syncthreads();
    const int lo = args.ph_lo, hi = args.ph_hi;
    const bool multi = (hi - lo) > 1;
    XcdBarrier bar; bar.bar = (unsigned*)(unsigned char*)(args.ws + WS_CTL) + CW_BAR; bar.x = 0; bar.st = nullptr;
    bar.wave = wave_s;
    if (multi) { bar = xcd_barrier_post((unsigned*)(unsigned char*)(args.ws + WS_CTL) + CW_BAR, (volatile LAS unsigned*)((LAS unsigned char*)lds + MISC_OFF) + 8); bar.wave = wave_s; }
#define IN(k) (lo <= (k) && (k) < hi)
#ifndef PROBE_MASK
#define PROBE_MASK 0ull
#endif
#define REP(k) ((int)((PROBE_MASK >> (k)) & 1ull) + 1)
#ifndef TIME_WG
#define TIME_WG 0
#endif
#ifndef TIME_PH
#define TIME_PH (-1)
#endif
#ifndef TIME_MULT
#define TIME_MULT 10
#endif
#define TSTAMP(k, slot) do { if (TIME_PH == (k) && blockIdx.x == TIME_WG && wave_s == 0) { const unsigned long long c_ = wall_clock64(); volatile LAS unsigned* m_ = (volatile LAS unsigned*)((LAS unsigned char*)lds + MISC_OFF); \
    m_[40 + 2 * (slot)] = (unsigned)c_; m_[41 + 2 * (slot)] = (unsigned)(c_ >> 32); } } while (0)
#define SEAM(k) do { if (rep_ == REP(k) - 1 && IN((k) + 1)) xcd_barrier(bar); if (rep_ == REP(k) - 1) TSTAMP(k, 1); } while (0)

    if (IN(0)) for (int rep_ = 0; rep_ < REP(0); ++rep_) { TSTAMP(0, 0); { MKFRAME(); pro_cvt(F, args); } { MKFRAME(); pro_mod(F, args); } { MKFRAME(); pro_rope(F, args); } SEAM(0); }
    if (IN(1)) for (int rep_ = 0; rep_ < REP(1); ++rep_) { TSTAMP(1, 0); MKFRAME(); phase_pro_b(F, args); SEAM(1); }
#define LAYER_BODY(l) do { \
        const int pb = l ? 12 : 2; \
        if (IN(pb + 0)) for (int rep_ = 0; rep_ < REP(pb + 0); ++rep_) { TSTAMP(pb + 0, 0); MKFRAME(); phase_n1(F, args, l); SEAM(pb + 0); } \
        if (IN(pb + 1)) for (int rep_ = 0; rep_ < REP(pb + 1); ++rep_) { TSTAMP(pb + 1, 0); \
            MKFRAME(); \
            pg8::Gemm g{(const pg8::bf16_t*)(F.ws + WS_H), (const pg8::bf16_t*)(F.ws + WS_WIN) + (size_t)l * NINP * DM, MT, NINP, DM, wave_s, DM / 64, 127, 127}; \
            const bool g1s = (G1_SLACK > 0 && F.G == 256); const int gG = g1s ? 256 - G1_STREAM_WGS : F.G; \
            if ((int)blockIdx.x < gG) { \
                pg8::StaticOrder S; S.init(MT, NINP, gG, (int)blockIdx.x); \
                pg8::EpiBf16Plain E{(pg8::bf16_t*)(F.ws + WS_P), NINP}; \
                pg8::gemm_phase<pg8::EpiBf16Plain, pg8::StaticOrder, PG8_ALIGN, PG8_SP2>(F.lds, g, S, E); \
            } else cvt8_deferred(F, args, 2 * DEF_PER_PHASE + l * G1_SLACK, G1_SLACK, ((int)blockIdx.x - gG) * NWAVES + F.wave, G1_STREAM_WGS * NWAVES); \
            SEAM(pb + 1); \
        } \
        if (IN(pb + 2)) for (int rep_ = 0; rep_ < REP(pb + 2); ++rep_) { TSTAMP(pb + 2, 0); TSTAMP(121 + 100 * l, 0); { MKFRAME(); prep_rows(F, args, l); } TSTAMP(121 + 100 * l, 1); TSTAMP(122 + 100 * l, 0); { MKFRAME(); prep_cum(F, args, l); } TSTAMP(122 + 100 * l, 1); SEAM(pb + 2); } \
        if (IN(pb + 3)) for (int rep_ = 0; rep_ < REP(pb + 3); ++rep_) { TSTAMP(pb + 3, 0); TSTAMP(101 + 100 * l, 0); { MKFRAME(); mixa_d1(F); } TSTAMP(101 + 100 * l, 1); TSTAMP(102 + 100 * l, 0); if (l == 0) { MKFRAME(); mixa_ctx(F); } TSTAMP(102 + 100 * l, 1); TSTAMP(103 + 100 * l, 0); { MKFRAME(); mixa_na(F, args, l); } TSTAMP(103 + 100 * l, 1); TSTAMP(104 + 100 * l, 0); { MKFRAME(); mixa_sgu(F, args, l); } TSTAMP(104 + 100 * l, 1); SEAM(pb + 3); } \
        if (IN(pb + 4)) for (int rep_ = 0; rep_ < REP(pb + 4); ++rep_) { TSTAMP(pb + 4, 0); TSTAMP(131 + 100 * l, 0); { MKFRAME(); ssd_scan(F); } TSTAMP(131 + 100 * l, 1); TSTAMP(132 + 100 * l, 0); { MKFRAME(); mixb_attn(F, args, l); } TSTAMP(132 + 100 * l, 1); SEAM(pb + 4); } \
        if (IN(pb + 5)) for (int rep_ = 0; rep_ < REP(pb + 5); ++rep_) { TSTAMP(pb + 5, 0); TSTAMP(111 + 100 * l, 0); { MKFRAME(); merge_d3(F, args, l); } TSTAMP(111 + 100 * l, 1); TSTAMP(112 + 100 * l, 0); { MKFRAME(); merge_abc(F, args, l); } TSTAMP(112 + 100 * l, 1); if (l == 0) { MKFRAME(); merge_stream(F, args); } SEAM(pb + 5); } \
        if (IN(pb + 6)) for (int rep_ = 0; rep_ < REP(pb + 6); ++rep_) { TSTAMP(pb + 6, 0); \
            MKFRAME(); \
            pg8::Gemm g{(const pg8::bf16_t*)(F.ws + WS_OB), (const pg8::bf16_t*)(F.ws + WS_WOUT) + (size_t)l * DM * DM, ML, DM, DM, wave_s, DM / 64, 127, 127}; \
            pg8::StaticOrder S; S.init(ML, DM, F.G, (int)blockIdx.x); \
            const float* bL = l == 0 ? (const float*)args.in[I_X] : (const float*)(F.ws + WS_XB); \
            const float* bC = l == 0 ? (const float*)args.in[I_CTX] : (const float*)(F.ws + WS_XB) + (size_t)ML * DM; \
            pg8::EpiResGate E{bL, bC, (float*)(F.ws + WS_XA), (const float*)(F.ws + WS_MOD) + (size_t)l * 3 * MODW + 2 * DM}; \
            pg8::gemm_phase<pg8::EpiResGate, pg8::StaticOrder, PG8_ALIGN, PG8_SP2>(F.lds, g, S, E); \
            if (l == 0) { \
                pg8::Gemm g2{(const pg8::bf16_t*)(F.ws + WS_OB) + (size_t)ML * DM, (const pg8::bf16_t*)(F.ws + WS_WOUT), MC, DM, DM, wave_s, 8, 127, 127}; \
                pg8::SplitOrder S2; S2.init(2, 8, 4, 1024, F.G, (int)blockIdx.x); \
                pg8::EpiPart E2{(float*)(F.ws + WS_PARTW), MC}; \
                pg8::gemm_phase<pg8::EpiPart, pg8::SplitOrder, PG8_ALIGN, PG8_SP2>(F.lds, g2, S2, E2); \
                if (F.G == 256 && (int)blockIdx.x >= 64) cvt8_deferred(F, args, OFF_WO0, WO0_ITEMS, ((int)blockIdx.x - 64) * NWAVES + F.wave, 192 * NWAVES); \
            } \
            SEAM(pb + 6); \
        } \
        if (IN(pb + 7)) for (int rep_ = 0; rep_ < REP(pb + 7); ++rep_) { TSTAMP(pb + 7, 0); MKFRAME(); if (l == 0) phase_n2(F, args, 0); else phase_n2_route(F, args); SEAM(pb + 7); } \
        if (l == 0) { \
        if (IN(10)) for (int rep_ = 0; rep_ < REP(10); ++rep_) { TSTAMP(10, 0); \
            MKFRAME(); \
            pg8::Gemm g{(const pg8::bf16_t*)(F.ws + WS_H), (const pg8::bf16_t*)(F.ws + WS_W13), MT, 2 * DFF, DM, wave_s, DM / 64, 127, 127}; \
            pg8::StaticOrder S; S.init(MT, 2 * DFF, F.G, (int)blockIdx.x); \
            pg8::EpiSwiglu8 E{(unsigned char*)(F.ws + WS_ACT), DFF, 8.0f}; \
            pg8::gemm_phase<pg8::EpiSwiglu8, pg8::StaticOrder, PG8_ALIGN, PG8_SP2>(F.lds, g, S, E); \
            if (F.G == 256 && (int)blockIdx.x >= 216) cvt8_deferred(F, args, OFF_FF1, FF1_ITEMS, ((int)blockIdx.x - 216) * NWAVES + F.wave, 40 * NWAVES); \
            SEAM(10); \
        } \
        if (IN(11)) for (int rep_ = 0; rep_ < REP(11); ++rep_) { TSTAMP(11, 0); \
            MKFRAME(); \
            pg8::Gemm g{(const pg8::bf16_t*)(F.ws + WS_ACT), (const pg8::bf16_t*)(F.ws + WS_W2), ML, DM, DFF / 2, wave_s, DFF / 128, 121, 121}; \
            pg8::StaticOrder S; S.init(ML, DM, F.G, (int)blockIdx.x); \
            pg8::EpiResGate E{(const float*)(F.ws + WS_XA), (const float*)(F.ws + WS_XA) + (size_t)ML * DM, (float*)(F.ws + WS_XB), (const float*)(F.ws + WS_MOD) + 5 * DM}; \
            {     \
                pg8::Gemm g2{(const pg8::bf16_t*)(F.ws + WS_ACT + (size_t)ML * DFF), (const pg8::bf16_t*)(F.ws + WS_W2), MC, DM, DFF / 2, wave_s, 4, 121, 121}; \
                pg8::SplitOrder S2; S2.init(2, 8, 11, 512, F.G, (int)blockIdx.x); \
                pg8::EpiPart E2{(float*)(F.ws + WS_PARTF), MC}; \
                pg8::gemm_phase<pg8::EpiPart, pg8::SplitOrder, PG8_ALIGN, PG8_SP2, true>(F.lds, g2, S2, E2); \
            } \
            pg8::gemm_phase<pg8::EpiResGate, pg8::StaticOrder, PG8_ALIGN, PG8_SP2, true>(F.lds, g, S, E); \
            SEAM(11); \
        } \
        } \
     \
    } while (0)
    LAYER_BODY(0);
    LAYER_BODY(1);
#undef LAYER_BODY
    if (IN(20)) for (int rep_ = 0; rep_ < REP(20); ++rep_) { TSTAMP(20, 0); MKFRAME(); phase_gather(F); SEAM(20); }
    if (IN(21)) for (int rep_ = 0; rep_ < REP(21); ++rep_) { TSTAMP(21, 0);
        MKFRAME();
        moe_tiles(F);
        pg8::Gemm g{(const pg8::bf16_t*)(F.ws + WS_HS), (const pg8::bf16_t*)(F.ws + WS_WM13), MSLOT, 2 * DFE, DM / 2, wave_s, DM / 128, 122, 122};
        pg8::MoeOrder S; S.init(F.MISC + 16, (2 * DFE) / 256, F.G, (int)blockIdx.x);
        pg8::EpiSwiglu8 E{(unsigned char*)(F.ws + WS_ACTM), DFE, 8.0f};
        pg8::gemm_phase<pg8::EpiSwiglu8, pg8::MoeOrder, PG8_ALIGN, PG8_SP2, true>(F.lds, g, S, E);
        SEAM(21);
    }
    if (IN(22)) for (int rep_ = 0; rep_ < REP(22); ++rep_) { TSTAMP(22, 0);
        MKFRAME();
        moe_tiles(F);
        pg8::Gemm g{(const pg8::bf16_t*)(F.ws + WS_ACTM), (const pg8::bf16_t*)(F.ws + WS_WM2), MSLOT, DM, DFE / 2, wave_s, DFE / 128, 121, 121};
        pg8::MoeOrder S; S.init(F.MISC + 16, DM / 256, F.G, (int)blockIdx.x);
        const int whole = (S.nwg / F.G) * F.G, tail = S.nwg - whole; S.hi = whole;
        pg8::EpiBf16Plain E{(pg8::bf16_t*)(F.ws + WS_YM), DM};
        pg8::gemm_phase<pg8::EpiBf16Plain, pg8::MoeOrder, PG8_ALIGN, PG8_SP2, true>(F.lds, g, S, E);
        if (tail > 0) {
            const int sp = tail * 4 <= F.G ? 4 : (tail * 2 <= F.G ? 2 : 1);
            pg8::Gemm g2{(const pg8::bf16_t*)(F.ws + WS_ACTM), (const pg8::bf16_t*)(F.ws + WS_WM2), MSLOT, DM, DFE / 2, wave_s, (DFE / 128) / sp, 121, 121};
            pg8::MoeTailOrder S2; S2.M = S; S2.M.hi = S.nwg; S2.lo = whole; S2.S = sp; S2.kbytes = DFE / sp;
            pg8::EpiPartFlag E2{(float*)(F.ws + WS_YMP), (size_t)MSLOT * DM, (unsigned*)(F.ctl + CW_TAIL), (unsigned)sp};
            pg8::gemm_phase<pg8::EpiPartFlag, pg8::MoeTailOrder, PG8_ALIGN, PG8_SP2, true>(F.lds, g2, S2, E2);
        }
        SEAM(22);
    }
    if (IN(23)) for (int rep_ = 0; rep_ < REP(23); ++rep_) { TSTAMP(23, 0); { MKFRAME(); phase_final(F, args); } TSTAMP(23, 1); }
    if (TIME_PH >= 0 && blockIdx.x == TIME_WG && wave_s == 0) { volatile LAS unsigned* m_ = (volatile LAS unsigned*)((LAS unsigned char*)lds + MISC_OFF);
        const unsigned long long t0_ = ((unsigned long long)m_[41] << 32) | m_[40], t1_ = ((unsigned long long)m_[43] << 32) | m_[42];
        const unsigned long long span_ = (t1_ > t0_ ? t1_ - t0_ : 0ull) * TIME_MULT, s_ = wall_clock64();
        while (wall_clock64() - s_ < span_ && span_ < 400000000ull) __builtin_amdgcn_s_sleep(8); }
#undef IN
#undef MKFRAME
#undef SEAM
}

extern "C" void kernel_launch(void* const* d_in, const int* in_sizes, int n_in, void* d_out, int out_size, void* d_ws, size_t ws_size, hipStream_t stream) {
    static int grid = 0;
    if (grid == 0) {
        if (n_in != 28 || out_size != ML * DM || ws_size < WS_END) { fprintf(stderr, "kernel_launch: unexpected shapes: n_in %d out %d ws %zu (need %zu)\n", n_in, out_size, ws_size, (size_t)WS_END); grid = -1; return; }
        int dev = 0, cus = 0, per_cu = 0;
        if (hipGetDevice(&dev) != hipSuccess || hipDeviceGetAttribute(&cus, hipDeviceAttributeMultiprocessorCount, dev) != hipSuccess) { grid = -1; return; }
        if (hipFuncSetAttribute((const void*)hymba_fwd, hipFuncAttributeMaxDynamicSharedMemorySize, LDS_BYTES) != hipSuccess) { fprintf(stderr, "kernel_launch: hipFuncSetAttribute failed\n"); grid = -1; return; }
        if (hipOccupancyMaxActiveBlocksPerMultiprocessor(&per_cu, (const void*)hymba_fwd, NWAVES * 64, LDS_BYTES) != hipSuccess || per_cu < 1)
            fprintf(stderr, "kernel_launch: note: occupancy query reports %d workgroups per CU\n", per_cu);
        (void)hipGetLastError();
        grid = cus;
    }
    if (grid < 0) return;
    if (hipMemsetAsync((char*)d_ws + WS_CTL, 0, CTL_ZERO_BYTES, stream) != hipSuccess) { fprintf(stderr, "kernel_launch: memset failed\n"); return; }
    Args a{};
    for (int i = 0; i < 28; ++i) a.in[i] = (const GAS float*)d_in[i];
    a.out = (GAS float*)d_out; a.ws = (GAS unsigned char*)d_ws;
#if MK_N_LAUNCHES == 1
    a.ph_lo = 0; a.ph_hi = NPH;
    hipLaunchKernelGGL(hymba_fwd, dim3(grid), dim3(NWAVES * 64), LDS_BYTES, stream, a);
#else
    for (int ph = 0; ph < NPH; ++ph) {
        a.ph_lo = ph; a.ph_hi = ph + 1;
        hipLaunchKernelGGL(hymba_fwd, dim3(grid), dim3(NWAVES * 64), LDS_BYTES, stream, a);
    }
#endif
    const hipError_t le = hipPeekAtLastError();
    if (le != hipSuccess) fprintf(stderr, "kernel_launch: launch failed: %s\n", hipGetErrorName(le));
}
```

```cpp
#include <hip/hip_runtime.h>
#include <hip/hip_bf16.h>
#include <cstdio>
#include <cstdint>
#include <cmath>

namespace pg8 {
#define PG8_LAS __attribute__((address_space(3)))
typedef unsigned short bf16_t;
typedef short bf16x8 __attribute__((ext_vector_type(8)));
typedef float f32x4 __attribute__((ext_vector_type(4)));
typedef unsigned u32x4 __attribute__((ext_vector_type(4)));
typedef int i32x8 __attribute__((ext_vector_type(8)));
constexpr int BM = 256, BK = 64, HALF = 128, HTB = HALF * BK * 2  , STAGE_BYTES = 8 * HTB, NXCD = 8, WGM = 8;

__host__ __device__ __forceinline__ int lds_byte(int r, int c) { const int st = (r >> 4) * 2 + (c >> 5), rr = r & 15, cc = c & 31, ob = rr * 64 + cc * 2; return st * 1024 + (ob ^ (((ob >> 9) & 1) << 5)); }
__host__ __device__ __forceinline__ void stage_rc(int b, int& R, int& C) { const int st = b / 1024, sb = b % 1024, swz = sb ^ (((sb >> 9) & 1) << 5); R = (st >> 1) * 16 + swz / 64; C = (st & 1) * 32 + (swz % 64) / 2; }
__host__ __device__ __forceinline__ int perm32(int rho) { const int n = rho >> 4, i = rho & 15; return 8 * (i >> 2) + 4 * n + (i & 3); }

struct Unit { int pm, pn, pb, koff, ks; };
struct Gemm { const bf16_t* A; const bf16_t* Bt; int M, N, K, wid, nt, sw, sa; };

struct StaticOrder {
    int nM, nN, nwg, G, c;
    __host__ __device__ void init(int M, int N, int G_, int c_) { nM = M / BM; nN = N / BM; nwg = nM * nN; G = G_; c = c_; }
    __device__ bool next(int i, Unit& u) const {
        const long L = (long)i * G + c; if (L >= nwg) return false;
        int wgid = (int)L; { const int q = nwg / NXCD, r = nwg % NXCD, xcd = wgid % NXCD, off = wgid / NXCD; wgid = (xcd < r ? xcd * (q + 1) : r * (q + 1) + (xcd - r) * q) + off; }
        const int nig = WGM * nN, gid = wgid / nig, fm = gid * WGM, gsz = (nM - fm) < WGM ? (nM - fm) : WGM;
        u.pm = fm + ((wgid % nig) % gsz); u.pn = (wgid % nig) / gsz; u.pm = __builtin_amdgcn_readfirstlane(u.pm); u.pn = __builtin_amdgcn_readfirstlane(u.pn); u.pb = u.pn; u.koff = 0; u.ks = 0; return true;
    }
    __device__ __forceinline__ void a_ready(const Unit&) const {}
    __device__ __forceinline__ void done(const Unit&) const {}
};

__device__ __forceinline__ unsigned cvt_pk_bf16(float lo, float hi) { unsigned r; asm volatile("v_cvt_pk_bf16_f32 %0, %1, %2" : "=v"(r) : "v"(lo), "v"(hi)); return r; }

struct EpiBf16Plain {
    static constexpr bool PERM = true, AFTER_DRAIN = false;
    bf16_t* O; int ldc;
    __device__ __forceinline__ void operator()(const f32x4 (&acc)[2][2][4][2], const Unit& u, int wr, int wc, int fr, int fq) const {
        const int row0 = u.pm * BM + wr * 64 + fr, col0 = u.pn * BM + wc * 32 + 8 * fq;
#pragma unroll
        for (int ai = 0; ai < 2; ++ai)
#pragma unroll
            for (int m = 0; m < 4; ++m) { bf16_t* rowp = O + (size_t)(row0 + ai * HALF + m * 16) * ldc + col0;
#pragma unroll
                for (int bj = 0; bj < 2; ++bj) { const f32x4 v0 = acc[ai][bj][m][0], v1 = acc[ai][bj][m][1];
                    u32x4 w; w.x = cvt_pk_bf16(v0[0], v0[1]); w.y = cvt_pk_bf16(v0[2], v0[3]); w.z = cvt_pk_bf16(v1[0], v1[1]); w.w = cvt_pk_bf16(v1[2], v1[3]);
                    *(u32x4*)(rowp + bj * HALF) = w; } }
    }
};
struct EpiResGate {
    static constexpr bool PERM = false, AFTER_DRAIN = false;
    const float* baseL; const float* baseC; float* out; const float* gate;
    __device__ __forceinline__ void operator()(const f32x4 (&acc)[2][2][4][2], const Unit& u, int wr, int wc, int fr, int fq) const {
        const int row0 = u.pm * BM + wr * 64 + fr, col0 = u.pn * BM + wc * 32 + 4 * fq;
        const int v = u.pm < 16 ? 0 : (u.pm < 32 ? 1 : 2);
        const float* gp = gate + v * 12288 + col0;
        f32x4 gv[2][2];
#pragma unroll
        for (int bj = 0; bj < 2; ++bj)
#pragma unroll
            for (int n = 0; n < 2; ++n) gv[bj][n] = *(const f32x4*)(gp + bj * HALF + n * 16);
#pragma unroll
        for (int ai = 0; ai < 2; ++ai)
#pragma unroll
            for (int m = 0; m < 4; ++m) { const int row = row0 + ai * HALF + m * 16;
                const float* bp = (row < 8192 ? baseL + (size_t)row * 2048 : baseC + (size_t)(row - 8192) * 2048) + col0; float* op = out + (size_t)row * 2048 + col0;
#pragma unroll
                for (int bj = 0; bj < 2; ++bj)
#pragma unroll
                    for (int n = 0; n < 2; ++n) { const f32x4 b = *(const f32x4*)(bp + bj * HALF + n * 16); *(f32x4*)(op + bj * HALF + n * 16) = b + gv[bj][n] * acc[ai][bj][m][n]; } }
    }
};
__device__ __forceinline__ float silu_f(float v) { return v * __builtin_amdgcn_rcpf(1.0f + __expf(-v)); }
struct EpiSwiglu {
    static constexpr bool PERM = true, AFTER_DRAIN = false;
    bf16_t* O; int ldc;
    __device__ __forceinline__ void operator()(const f32x4 (&acc)[2][2][4][2], const Unit& u, int wr, int wc, int fr, int fq) const {
        const int row0 = u.pm * BM + wr * 64 + fr, col0 = u.pn * HALF + wc * 32 + 8 * fq;
#pragma unroll
        for (int ai = 0; ai < 2; ++ai)
#pragma unroll
            for (int m = 0; m < 4; ++m) { bf16_t* rowp = O + (size_t)(row0 + ai * HALF + m * 16) * ldc + col0;
                f32x4 a0, a1;
#pragma unroll
                for (int j = 0; j < 4; ++j) { a0[j] = silu_f(acc[ai][0][m][0][j]) * acc[ai][1][m][0][j]; a1[j] = silu_f(acc[ai][0][m][1][j]) * acc[ai][1][m][1][j]; }
                u32x4 w; w.x = cvt_pk_bf16(a0[0], a0[1]); w.y = cvt_pk_bf16(a0[2], a0[3]); w.z = cvt_pk_bf16(a1[0], a1[1]); w.w = cvt_pk_bf16(a1[2], a1[3]);
                *(u32x4*)rowp = w; }
    }
};
__device__ __forceinline__ float sat_fp8(float v) { return __builtin_amdgcn_fmed3f(v, -448.0f, 448.0f); }
__device__ __forceinline__ unsigned pack_fp8x4(float a, float b, float c, float d) { int r = __builtin_amdgcn_cvt_pk_fp8_f32(sat_fp8(a), sat_fp8(b), 0, false); r = __builtin_amdgcn_cvt_pk_fp8_f32(sat_fp8(c), sat_fp8(d), r, true); return (unsigned)r; }
struct EpiSwiglu8 {
    static constexpr bool PERM = true, AFTER_DRAIN = false;
    unsigned char* O; int ldc; float oscale;
    __device__ __forceinline__ void operator()(const f32x4 (&acc)[2][2][4][2], const Unit& u, int wr, int wc, int fr, int fq) const {
        const int row0 = u.pm * BM + wr * 64 + fr, col0 = u.pn * HALF + wc * 32 + 8 * fq;
#pragma unroll
        for (int ai = 0; ai < 2; ++ai)
#pragma unroll
            for (int m = 0; m < 4; ++m) { unsigned char* rowp = O + (size_t)(row0 + ai * HALF + m * 16) * ldc + col0;
                f32x4 a0, a1;
#pragma unroll
                for (int j = 0; j < 4; ++j) { a0[j] = silu_f(acc[ai][0][m][0][j]) * acc[ai][1][m][0][j] * oscale; a1[j] = silu_f(acc[ai][0][m][1][j]) * acc[ai][1][m][1][j] * oscale; }
                typedef unsigned u32x2 __attribute__((ext_vector_type(2)));
                u32x2 w; w.x = pack_fp8x4(a0[0], a0[1], a0[2], a0[3]); w.y = pack_fp8x4(a1[0], a1[1], a1[2], a1[3]);
                *(u32x2*)rowp = w; }
    }
};
struct EpiF32Plain {
    static constexpr bool PERM = false, AFTER_DRAIN = false;
    float* C; int ldc;
    __device__ __forceinline__ void operator()(const f32x4 (&acc)[2][2][4][2], const Unit& u, int wr, int wc, int fr, int fq) const {
        const int row0 = u.pm * BM + wr * 64 + fr, col0 = u.pn * BM + wc * 32 + 4 * fq;
#pragma unroll
        for (int ai = 0; ai < 2; ++ai)
#pragma unroll
            for (int m = 0; m < 4; ++m) { float* rowp = C + (size_t)(row0 + ai * HALF + m * 16) * ldc + col0;
#pragma unroll
                for (int bj = 0; bj < 2; ++bj)
#pragma unroll
                    for (int n = 0; n < 2; ++n) *(f32x4*)(rowp + bj * HALF + n * 16) = acc[ai][bj][m][n]; }
    }
};
struct MoeOrder {
    int nM, nN, nwg, G, c; int t1, t2, t3, t4, t5, t6, t7; int hi;
    __device__ __forceinline__ void init(const volatile PG8_LAS unsigned* ts, int nN_, int G_, int c_) {
        t1 = __builtin_amdgcn_readfirstlane((int)ts[1]); t2 = __builtin_amdgcn_readfirstlane((int)ts[2]); t3 = __builtin_amdgcn_readfirstlane((int)ts[3]); t4 = __builtin_amdgcn_readfirstlane((int)ts[4]);
        t5 = __builtin_amdgcn_readfirstlane((int)ts[5]); t6 = __builtin_amdgcn_readfirstlane((int)ts[6]); t7 = __builtin_amdgcn_readfirstlane((int)ts[7]);
        nM = __builtin_amdgcn_readfirstlane((int)ts[8]); nN = nN_; nwg = nM * nN; G = G_; c = c_; hi = nwg; }
    __device__ __forceinline__ void decode(int L, Unit& u) const {
        int wgid = L; { const int q = nwg / NXCD, r = nwg % NXCD, xcd = wgid % NXCD, off = wgid / NXCD; wgid = (xcd < r ? xcd * (q + 1) : r * (q + 1) + (xcd - r) * q) + off; }
        const int nig = WGM * nN, gid = wgid / nig, fm = gid * WGM, gsz = (nM - fm) < WGM ? (nM - fm) : WGM;
        u.pm = fm + ((wgid % nig) % gsz); u.pn = (wgid % nig) / gsz;
        const int e = (u.pm >= t1) + (u.pm >= t2) + (u.pm >= t3) + (u.pm >= t4) + (u.pm >= t5) + (u.pm >= t6) + (u.pm >= t7);
        u.pb = e * nN + u.pn; u.koff = 0; u.ks = 0;
        u.pm = __builtin_amdgcn_readfirstlane(u.pm); u.pn = __builtin_amdgcn_readfirstlane(u.pn); u.pb = __builtin_amdgcn_readfirstlane(u.pb);
    }
    __device__ __forceinline__ bool next(int i, Unit& u) const {
        const int L = i * G + c; if (L >= hi) return false;
        decode(L, u); return true;
    }
    __device__ __forceinline__ void a_ready(const Unit&) const {}
    __device__ __forceinline__ void done(const Unit&) const {}
};
struct MoeTailOrder {
    MoeOrder M; int lo, S, kbytes;
    __device__ __forceinline__ bool next(int i, Unit& u) const {
        const int Lp = i * M.G + M.c; if (Lp >= (M.nwg - lo) * S) return false;
        M.decode(lo + Lp / S, u); u.ks = __builtin_amdgcn_readfirstlane(Lp % S); u.koff = __builtin_amdgcn_readfirstlane(u.ks * kbytes); return true;
    }
    __device__ __forceinline__ void a_ready(const Unit&) const {}
    __device__ __forceinline__ void done(const Unit&) const {}
};
struct EpiPartFlag {
    static constexpr bool PERM = false, AFTER_DRAIN = false;
    float* C; size_t slab; unsigned* flags; unsigned S;
    __device__ __forceinline__ void operator()(const f32x4 (&acc)[2][2][4][2], const Unit& u, int wr, int wc, int fr, int fq) const {
        const int row0 = u.pm * BM + wr * 64 + fr, col0 = u.pn * BM + wc * 32 + 4 * fq;
        float* base = C + (size_t)u.ks * slab;
        if (u.ks == 0 && wr == 0 && wc == 0 && fr == 0 && fq == 0) flags[u.pm * 8 + u.pn] = S;
#pragma unroll
        for (int ai = 0; ai < 2; ++ai)
#pragma unroll
            for (int m = 0; m < 4; ++m) { float* rowp = base + (size_t)(row0 + ai * HALF + m * 16) * 2048 + col0;
#pragma unroll
                for (int bj = 0; bj < 2; ++bj)
#pragma unroll
                    for (int n = 0; n < 2; ++n) *(f32x4*)(rowp + bj * HALF + n * 16) = acc[ai][bj][m][n]; }
    }
};
struct SplitOrder {
    int nN, S, nwg, G, c, kbytes;
    __device__ __forceinline__ void init(int nM, int nN_, int S_, int kbytes_, int G_, int c_) { nN = nN_; S = S_; nwg = nM * nN_ * S_; G = G_; c = c_; kbytes = kbytes_; }
    __device__ __forceinline__ bool next(int i, Unit& u) const {
        const int L = i * G + c; if (L >= nwg) return false;
        u.ks = __builtin_amdgcn_readfirstlane(L % S); const int t = L / S; u.pn = __builtin_amdgcn_readfirstlane(t % nN); u.pm = __builtin_amdgcn_readfirstlane(t / nN); u.pb = u.pn; u.koff = u.ks * kbytes; return true;
    }
    __device__ __forceinline__ void a_ready(const Unit&) const {}
    __device__ __forceinline__ void done(const Unit&) const {}
};
struct EpiPart {
    static constexpr bool PERM = false, AFTER_DRAIN = false;
    float* C; int rows;
    __device__ __forceinline__ void operator()(const f32x4 (&acc)[2][2][4][2], const Unit& u, int wr, int wc, int fr, int fq) const {
        const int row0 = u.pm * BM + wr * 64 + fr, col0 = u.pn * BM + wc * 32 + 4 * fq;
        float* base = C + (size_t)u.ks * rows * 2048;
#pragma unroll
        for (int ai = 0; ai < 2; ++ai)
#pragma unroll
            for (int m = 0; m < 4; ++m) { float* rowp = base + (size_t)(row0 + ai * HALF + m * 16) * 2048 + col0;
#pragma unroll
                for (int bj = 0; bj < 2; ++bj)
#pragma unroll
                    for (int n = 0; n < 2; ++n) *(f32x4*)(rowp + bj * HALF + n * 16) = acc[ai][bj][m][n]; }
    }
};


template <class Epi, class Sched, bool ALIGN_EPI = false, bool SP2 = false, bool F8 = false>
__device__ __forceinline__ void gemm_phase(PG8_LAS unsigned char* lds, const Gemm g, const Sched& S, const Epi& E) {
    int tid_; asm volatile("v_mbcnt_lo_u32_b32 %0, -1, 0\n\tv_mbcnt_hi_u32_b32 %0, -1, %0" : "=v"(tid_)); tid_ += g.wid * 64; asm volatile("" : "+v"(tid_));
    const int tid = tid_, wid = __builtin_amdgcn_readfirstlane(tid >> 6), lane = tid & 63, wr = wid >> 2, wc = wid & 3, fr = lane & 15, fq = lane >> 4;
    const int K = g.K, nt = g.nt;
    unsigned voffA[2], voffB[2];
#pragma unroll
    for (int i = 0; i < 2; ++i) { int R, C; stage_rc(tid * 16 + i * 8192, R, C); const int Rb = Epi::PERM ? ((R & ~31) + perm32(R & 31)) : R;
        voffA[i] = (unsigned)(R * K + C) * 2u; voffB[i] = (unsigned)(Rb * K + C) * 2u; }
    const size_t q64 = (size_t)64 * K * 2;
    const size_t kstep = (size_t)(BK * 2);
    const size_t hstep = (size_t)HALF * K * 2;
    const size_t tstep = 2 * hstep;
    const unsigned ldsw = (unsigned)wid * 1024u;
    const int aoff = lds_byte(wr * 64 + fr, fq * 8), boff = lds_byte(wc * 32 + fr, fq * 8);
    PG8_LAS unsigned char* ldsa = lds + aoff; PG8_LAS unsigned char* ldsb = lds + 4 * HTB + boff;
    asm volatile("" : "+v"(ldsa), "+v"(ldsb));
#define PG8_SA(b, h) (((b) * 2 + (h)) * HTB)
#define PG8_SB(b, h) ((4 + (b) * 2 + (h)) * HTB)
#define PG8_STAGE(bufoff, gbase, voff) do { _Pragma("unroll") for (int _i = 0; _i < 2; ++_i) \
        __builtin_amdgcn_global_load_lds((const unsigned*)((const char*)(gbase) + (size_t)_i * q64 + (voff)[0]), (PG8_LAS unsigned*)(lds + (bufoff) + ldsw + _i * 8192), 16, 0, 0); } while (0)
#define PG8_LD8(base, off) __builtin_shufflevector(*(const PG8_LAS u32x4*)((base) + (off)), *(const PG8_LAS u32x4*)((base) + (off) + 1024), 0, 1, 2, 3, 4, 5, 6, 7)
#define PG8_LDA(dst, b, h) do { if constexpr (F8) { _Pragma("unroll") for (int m = 0; m < 4; ++m) dst##8[m] = PG8_LD8(ldsa, PG8_SA(b, h) + m * 2048); } \
        else { _Pragma("unroll") for (int m = 0; m < 4; ++m) _Pragma("unroll") for (int k = 0; k < 2; ++k) dst[m][k] = *(const PG8_LAS bf16x8*)(ldsa + PG8_SA(b, h) + m * 2048 + k * 1024); } } while (0)
#define PG8_LDB(dst, b, h) do { if constexpr (F8) { _Pragma("unroll") for (int n = 0; n < 2; ++n) dst##8[n] = PG8_LD8(ldsb, PG8_SB(b, h) - 4 * HTB + n * 2048); } \
        else { _Pragma("unroll") for (int n = 0; n < 2; ++n) _Pragma("unroll") for (int k = 0; k < 2; ++k) dst[n][k] = *(const PG8_LAS bf16x8*)(ldsb + PG8_SB(b, h) - 4 * HTB + n * 2048 + k * 1024); } } while (0)
#define PG8_MMA(ai, bj, At, Bt) do { __builtin_amdgcn_s_setprio(1); \
        if constexpr (F8) { _Pragma("unroll") for (int m = 0; m < 4; ++m) _Pragma("unroll") for (int n = 0; n < 2; ++n) \
            acc[ai][bj][m][n] = __builtin_amdgcn_mfma_scale_f32_16x16x128_f8f6f4(__builtin_bit_cast(i32x8, Bt##8[n]), __builtin_bit_cast(i32x8, At##8[m]), acc[ai][bj][m][n], 0, 0, 0, g.sw, 0, g.sw); } \
        else { _Pragma("unroll") for (int m = 0; m < 4; ++m) _Pragma("unroll") for (int n = 0; n < 2; ++n) _Pragma("unroll") for (int k = 0; k < 2; ++k) \
            acc[ai][bj][m][n] = __builtin_amdgcn_mfma_f32_16x16x32_bf16(Bt[n][k], At[m][k], acc[ai][bj][m][n], 0, 0, 0); } \
        __builtin_amdgcn_s_setprio(0); } while (0)
#define PG8_WAIT_V(n) asm volatile("s_waitcnt vmcnt(" #n ")" ::: "memory")
#define PG8_WAIT_L(n) asm volatile("s_waitcnt lgkmcnt(" #n ")" ::: "memory")
#define PG8_BAR __builtin_amdgcn_s_barrier()
#define PG8_SCHED __builtin_amdgcn_sched_barrier(0)
    Unit cur, nxt; int ui = 0;
    if (!S.next(0, cur)) return;
    f32x4 acc[2][2][4][2];
#pragma unroll
    for (int a = 0; a < 2; ++a)
#pragma unroll
        for (int b = 0; b < 2; ++b)
#pragma unroll
            for (int m = 0; m < 4; ++m)
#pragma unroll
                for (int n = 0; n < 2; ++n) acc[a][b][m][n] = (f32x4){0.f, 0.f, 0.f, 0.f};
    bf16x8 At[4][2], B0[2][2], B1[2][2];
    typedef unsigned u32x8 __attribute__((ext_vector_type(8)));
    u32x8 At8[4], B08[2], B18[2];
    const char* cA = (const char*)g.A + (size_t)cur.pm * tstep + cur.koff; const char* cB = (const char*)g.Bt + (size_t)cur.pb * tstep + cur.koff;
    S.a_ready(cur);
    if constexpr (SP2) {
        PG8_STAGE(PG8_SB(0, 0), cB, voffB); PG8_STAGE(PG8_SB(0, 1), cB + hstep, voffB); PG8_STAGE(PG8_SA(0, 0), cA, voffA); PG8_STAGE(PG8_SA(0, 1), cA + hstep, voffA);
        if (wr == 1) PG8_BAR;
        PG8_WAIT_V(2); PG8_BAR;
        PG8_STAGE(PG8_SB(1, 0), cB + kstep, voffB); PG8_STAGE(PG8_SA(1, 0), cA + kstep, voffA); PG8_STAGE(PG8_SB(1, 1), cB + hstep + kstep, voffB);
        PG8_WAIT_V(6); PG8_BAR;
    } else {
        PG8_STAGE(PG8_SB(0, 0), cB, voffB); PG8_STAGE(PG8_SA(0, 0), cA, voffA); PG8_STAGE(PG8_SB(0, 1), cB + hstep, voffB); PG8_STAGE(PG8_SA(0, 1), cA + hstep, voffA);
        if (wr == 1) PG8_BAR;
        PG8_WAIT_V(4); PG8_BAR;
        PG8_STAGE(PG8_SB(1, 0), cB + kstep, voffB); PG8_STAGE(PG8_SA(1, 0), cA + kstep, voffA); PG8_STAGE(PG8_SB(1, 1), cB + hstep + kstep, voffB);
        PG8_WAIT_V(6); PG8_BAR;
    }
    for (;;) {
        const bool has_next = S.next(ui + 1, nxt);
        const char* nA = has_next ? (const char*)g.A + (size_t)nxt.pm * tstep + nxt.koff : cA; const char* nB = has_next ? (const char*)g.Bt + (size_t)nxt.pb * tstep + nxt.koff : cB;
#pragma unroll 1
        for (int t = 0; t < nt; t += 2) {
            const bool last = (t == nt - 2);
            const char* a1 = cA + (size_t)(t + 1) * kstep;
            const char* a2 = last ? nA : cA + (size_t)(t + 2) * kstep; const char* b2 = last ? nB : cB + (size_t)(t + 2) * kstep;
            const char* a3 = a2 + kstep; const char* b3 = b2 + kstep;
            if (last && has_next) S.a_ready(nxt);
            if constexpr (SP2) {
            PG8_LDB(B0, 0, 0); PG8_LDB(B1, 0, 1); PG8_SCHED; PG8_LDA(At, 0, 0); PG8_STAGE(PG8_SA(1, 1), a1 + hstep, voffA);
            PG8_WAIT_V(8); PG8_WAIT_L(0); PG8_BAR; PG8_MMA(0, 0, At, B0); PG8_MMA(0, 1, At, B1); PG8_BAR; PG8_SCHED;
            PG8_LDA(At, 0, 1); PG8_STAGE(PG8_SB(0, 0), b2, voffB); PG8_STAGE(PG8_SB(0, 1), b2 + hstep, voffB); PG8_STAGE(PG8_SA(0, 0), a2, voffA);
            PG8_WAIT_V(8); PG8_WAIT_L(0); PG8_BAR; PG8_MMA(1, 0, At, B0); PG8_MMA(1, 1, At, B1); PG8_BAR; PG8_SCHED;
            PG8_LDB(B0, 1, 0); PG8_LDB(B1, 1, 1); PG8_SCHED; PG8_LDA(At, 1, 0); PG8_STAGE(PG8_SA(0, 1), a2 + hstep, voffA);
            PG8_WAIT_V(8); PG8_WAIT_L(0); PG8_BAR; PG8_MMA(0, 0, At, B0); PG8_MMA(0, 1, At, B1); PG8_BAR; PG8_SCHED;
            PG8_LDA(At, 1, 1); PG8_STAGE(PG8_SB(1, 0), b3, voffB); PG8_STAGE(PG8_SB(1, 1), b3 + hstep, voffB); PG8_STAGE(PG8_SA(1, 0), a3, voffA);
            PG8_WAIT_V(8); PG8_WAIT_L(0); PG8_BAR; PG8_MMA(1, 0, At, B0); PG8_MMA(1, 1, At, B1); PG8_BAR; PG8_SCHED;
            } else {
            PG8_LDB(B0, 0, 0); PG8_SCHED; PG8_LDA(At, 0, 0); PG8_STAGE(PG8_SA(1, 1), a1 + hstep, voffA);
            PG8_WAIT_L(8); PG8_BAR; PG8_WAIT_L(0); PG8_MMA(0, 0, At, B0); PG8_BAR; PG8_SCHED;
            PG8_LDB(B1, 0, 1); PG8_STAGE(PG8_SB(0, 0), b2, voffB);
            PG8_BAR; PG8_WAIT_L(0); PG8_MMA(0, 1, At, B1); PG8_BAR;
            PG8_LDA(At, 0, 1); PG8_STAGE(PG8_SA(0, 0), a2, voffA);
            PG8_BAR; PG8_WAIT_L(0); PG8_MMA(1, 0, At, B0); PG8_BAR; PG8_SCHED;
            PG8_STAGE(PG8_SB(0, 1), b2 + hstep, voffB);
            PG8_WAIT_V(6); PG8_BAR; PG8_MMA(1, 1, At, B1); PG8_BAR;
            PG8_LDB(B0, 1, 0); PG8_SCHED; PG8_LDA(At, 1, 0); PG8_STAGE(PG8_SA(0, 1), a2 + hstep, voffA);
            PG8_WAIT_L(8); PG8_BAR; PG8_WAIT_L(0); PG8_MMA(0, 0, At, B0); PG8_BAR; PG8_SCHED;
            PG8_LDB(B1, 1, 1); PG8_STAGE(PG8_SB(1, 0), b3, voffB);
            PG8_BAR; PG8_WAIT_L(0); PG8_MMA(0, 1, At, B1); PG8_BAR;
            PG8_LDA(At, 1, 1); PG8_STAGE(PG8_SA(1, 0), a3, voffA);
            PG8_BAR; PG8_WAIT_L(0); PG8_MMA(1, 0, At, B0); PG8_BAR; PG8_SCHED;
            PG8_STAGE(PG8_SB(1, 1), b3 + hstep, voffB);
            PG8_WAIT_V(6); PG8_BAR; PG8_MMA(1, 1, At, B1); PG8_BAR;
            }
        }
        if constexpr (ALIGN_EPI) { if (wr == 0) PG8_BAR; }
        if constexpr (!Epi::AFTER_DRAIN) { int l2_; asm volatile("v_mbcnt_lo_u32_b32 %0, -1, 0\n\tv_mbcnt_hi_u32_b32 %0, -1, %0" : "=v"(l2_));
            E(acc, cur, wr, wc, l2_ & 15, l2_ >> 4); S.done(cur); }
        if (!has_next) break;
#pragma unroll
        for (int a = 0; a < 2; ++a)
#pragma unroll
            for (int b = 0; b < 2; ++b)
#pragma unroll
                for (int m = 0; m < 4; ++m)
#pragma unroll
                    for (int n = 0; n < 2; ++n) acc[a][b][m][n] = (f32x4){0.f, 0.f, 0.f, 0.f};
        cur = nxt; cA = nA; cB = nB; ++ui;
        if constexpr (ALIGN_EPI) { if (wr == 1) PG8_BAR; }
    }
    PG8_WAIT_V(0);
    if constexpr (!ALIGN_EPI) { if (wr == 0) PG8_BAR; }
    PG8_BAR;
    if constexpr (Epi::AFTER_DRAIN) { E.fused(acc, cur, wr, wc, fr, fq, lds, wid, lane); S.done(cur); }
#undef PG8_SA
#undef PG8_SB
#undef PG8_STAGE
#undef PG8_LDA
#undef PG8_LDB
#undef PG8_MMA
#undef PG8_LD8
#undef PG8_WAIT_V
#undef PG8_WAIT_L
#undef PG8_BAR
#undef PG8_SCHED
}
}

namespace att {
using bf16 = __hip_bfloat16;
constexpr int   D = 128, NW = 8, QBLK = 32, KVBLK = 64;
constexpr float SCALE = 0.088388347648318440f;
constexpr float THR = 8.f;
constexpr int SDEPTH = 1;
constexpr int LDQ = 512, LDK = 256;
constexpr size_t SHM_V = KVBLK * D * 2, SHM_K = KVBLK * D * 2, SHM_ATTN = 2 * SHM_V + 2 * SHM_K + NW * 64 * 4;
using bf16x8 = __attribute__((ext_vector_type(8))) short;
using s16x4  = __attribute__((ext_vector_type(4))) short;
using f32x16 = __attribute__((ext_vector_type(16))) float;
using f32x8  = __attribute__((ext_vector_type(8))) float;
using u32x4  = __attribute__((ext_vector_type(4))) unsigned;
#define KSWZ(row, colB) ((row) * 256 + ((colB) ^ (((row) & 7) << 4)))
#define SBAR() __builtin_amdgcn_sched_barrier(0)
__device__ __forceinline__ int crow(int r, int hi) { return (r & 3) + 8 * (r >> 2) + 4 * hi; }
__device__ __forceinline__ unsigned cvtpk(float lo, float hi) {
  unsigned r; asm volatile("v_cvt_pk_bf16_f32 %0, %1, %2" : "=v"(r) : "v"(lo), "v"(hi)); return r;
}
template <typename TIn> struct Stage;
template <> struct Stage<bf16>  { using T = bf16x8;
  __device__ static __forceinline__ T ld8(const bf16* p) { return *reinterpret_cast<const bf16x8*>(p); }
  __device__ static __forceinline__ bf16x8 tobf(T x) { return x; } };
template <> struct Stage<float> { using T = f32x8;
  __device__ static __forceinline__ T ld8(const float* p) { return *reinterpret_cast<const f32x8*>(p); }
  __device__ static __forceinline__ bf16x8 tobf(T x) {
    u32x4 w = {cvtpk(x[0], x[1]), cvtpk(x[2], x[3]), cvtpk(x[4], x[5]), cvtpk(x[6], x[7])}; return *reinterpret_cast<bf16x8*>(&w); } };

__device__ __forceinline__ void partialSM(f32x16& p0, f32x16& p1, float& m_reg, float& mn, float& alpha) {
  constexpr float C = SCALE * 1.4426950408889634f;
  float pmax = p0[0]; for (int r = 1; r < 16; ++r) pmax = fmaxf(pmax, p0[r]); for (int r = 0; r < 16; ++r) pmax = fmaxf(pmax, p1[r]);
  { auto rr = __builtin_amdgcn_permlane32_swap(__float_as_uint(pmax), __float_as_uint(pmax), false, false);
    pmax = fmaxf(__uint_as_float(rr[0]), __uint_as_float(rr[1])); }
  if (__builtin_expect(__all(pmax - m_reg <= THR / SCALE), 1)) { mn = m_reg; alpha = 1.f; }
  else { mn = fmaxf(m_reg, pmax); alpha = __builtin_amdgcn_exp2f((m_reg - mn) * C); m_reg = mn; }
  float mnC = -mn * C;
  for (int r = 0; r < 16; ++r) p0[r] = fmaf(p0[r], C, mnC); for (int r = 0; r < 16; ++r) p1[r] = fmaf(p1[r], C, mnC);
  for (int r = 0; r < 16; ++r) p0[r] = __builtin_amdgcn_exp2f(p0[r]);
}
__device__ __forceinline__ void finishSM(f32x16& p0, f32x16& p1, float alpha, float& l_reg, bf16x8& pa0, bf16x8& pa1, bf16x8& pa2, bf16x8& pa3) {
  for (int r = 0; r < 16; ++r) p1[r] = __builtin_amdgcn_exp2f(p1[r]);
  float ps = 0; for (int r = 0; r < 16; ++r) ps += p0[r]; for (int r = 0; r < 16; ++r) ps += p1[r];
  { auto rr = __builtin_amdgcn_permlane32_swap(__float_as_uint(ps), __float_as_uint(ps), false, false);
    ps = __uint_as_float(rr[0]) + __uint_as_float(rr[1]); }
  l_reg = l_reg * alpha + ps;
#define PK4(P, BASE, OUT) do { unsigned a0 = cvtpk(P[BASE + 0], P[BASE + 1]), a1 = cvtpk(P[BASE + 2], P[BASE + 3]);   \
    unsigned b0 = cvtpk(P[BASE + 4], P[BASE + 5]), b1 = cvtpk(P[BASE + 6], P[BASE + 7]);                              \
    auto r0 = __builtin_amdgcn_permlane32_swap(a0, b0, false, false); auto r1 = __builtin_amdgcn_permlane32_swap(a1, b1, false, false); \
    u32x4 w = {r0[0], r1[0], r0[1], r1[1]}; OUT = *reinterpret_cast<bf16x8*>(&w); } while (0)
  PK4(p0, 0, pa0); PK4(p0, 8, pa1); PK4(p1, 0, pa2); PK4(p1, 8, pa3);
#undef PK4
}
__device__ __forceinline__ void qkt(f32x16& p0, f32x16& p1, const bf16* Ks, const bf16x8* qr, int r32, int hi) {
  p0 = f32x16{}; p1 = f32x16{};
  for (int d0 = 0; d0 < 8; ++d0) { int cb = (d0 * 16 + hi * 8) * 2;
    bf16x8 b0 = *reinterpret_cast<const bf16x8*>((const char*)Ks + KSWZ(r32, cb));
    bf16x8 b1 = *reinterpret_cast<const bf16x8*>((const char*)Ks + KSWZ(32 + r32, cb));
    p0 = __builtin_amdgcn_mfma_f32_32x32x16_bf16(b0, qr[d0], p0, 0, 0, 0);
    p1 = __builtin_amdgcn_mfma_f32_32x32x16_bf16(b1, qr[d0], p1, 0, 0, 0); }
}
__device__ __forceinline__ int v_st(int k, int c) { const int kk = (k & ~0xC) | ((k & 4) << 1) | ((k & 8) >> 1); return ((kk >> 3) * 4 + (c >> 5)) * 512 + ((kk & 7) * 32 + (c & 31)) * 2; }
__device__ __forceinline__ int v_rd_base(int lane) { return ((lane & 3) << 3) | (((lane >> 2) & 3) << 6) | (((lane >> 4) & 1) << 5) | (((lane >> 5) & 1) << 8); }
constexpr int v_rd_off(int d0, int ks, int half) { return d0 * 512 + ks * 4096 + half * 2048; }
template <int OFF> __device__ __forceinline__ s16x4 tr_read(int vb) {
  s16x4 r; asm volatile("ds_read_b64_tr_b16 %0, %1 offset:%2" : "=&v"(r) : "v"(vb), "i"(OFF) : "memory"); return r;
}
template <int D0> __device__ __forceinline__ void pv_one(f32x16& od, int vb, bf16x8 pa0, bf16x8 pa1, bf16x8 pa2, bf16x8 pa3) {
  const s16x4 l0 = tr_read<v_rd_off(D0, 0, 0)>(vb), h0 = tr_read<v_rd_off(D0, 0, 1)>(vb), l1 = tr_read<v_rd_off(D0, 1, 0)>(vb), h1 = tr_read<v_rd_off(D0, 1, 1)>(vb);
  const s16x4 l2 = tr_read<v_rd_off(D0, 2, 0)>(vb), h2 = tr_read<v_rd_off(D0, 2, 1)>(vb), l3 = tr_read<v_rd_off(D0, 3, 0)>(vb), h3 = tr_read<v_rd_off(D0, 3, 1)>(vb);
  asm volatile("s_waitcnt lgkmcnt(0)" ::: "memory"); SBAR();
#define PK(L, H) (bf16x8){L[0], L[1], L[2], L[3], H[0], H[1], H[2], H[3]}
  od = __builtin_amdgcn_mfma_f32_32x32x16_bf16(pa0, PK(l0, h0), od, 0, 0, 0);
  od = __builtin_amdgcn_mfma_f32_32x32x16_bf16(pa1, PK(l1, h1), od, 0, 0, 0);
  od = __builtin_amdgcn_mfma_f32_32x32x16_bf16(pa2, PK(l2, h2), od, 0, 0, 0);
  od = __builtin_amdgcn_mfma_f32_32x32x16_bf16(pa3, PK(l3, h3), od, 0, 0, 0);
#undef PK
}
__device__ __forceinline__ void pv_d0(f32x16* o, int vb, bf16x8 pa0, bf16x8 pa1, bf16x8 pa2, bf16x8 pa3) {
  pv_one<0>(o[0], vb, pa0, pa1, pa2, pa3); pv_one<1>(o[1], vb, pa0, pa1, pa2, pa3); pv_one<2>(o[2], vb, pa0, pa1, pa2, pa3); pv_one<3>(o[3], vb, pa0, pa1, pa2, pa3);
}

template <typename TQ, int LDO>
__device__ __forceinline__ void attn_dense_body(const TQ* __restrict__ Qb, const bf16* __restrict__ Kh, const bf16* __restrict__ Vh,
                                                float* __restrict__ Ob, int seq, char* lds, int wid_s, float* __restrict__ st) {
  using St = Stage<bf16>; using SQ = Stage<TQ>;
  int tid_; asm volatile("v_mbcnt_lo_u32_b32 %0, -1, 0\n\tv_mbcnt_hi_u32_b32 %0, -1, %0" : "=v"(tid_)); tid_ += wid_s * 64; asm volatile("" : "+v"(tid_));
  const int tid = tid_, wid = tid >> 6, lane = tid & 63, r32 = lane & 31, hi = lane >> 5;
  bf16* V_lds = (bf16*)lds; bf16* K_lds = (bf16*)(lds + 2 * SHM_V);
  float* ws = (float*)(lds + 2 * SHM_V + 2 * SHM_K) + wid * 64; float* li_l = ws; float* al_l = ws + 32;
  float m_reg = -1e30f, l_reg = 0; f32x16 o[4] = {}; bf16x8 qr[8];
  const TQ* Qw = Qb + (long)(wid * QBLK + r32) * LDQ + hi * 8;
#pragma unroll
  for (int d0 = 0; d0 < 8; ++d0) qr[d0] = SQ::tobf(SQ::ld8(Qw + d0 * 16));
  const int sr = tid >> 4, sc = (tid & 15) * 8, vst0 = v_st(sr, sc), vst1 = v_st(32 + sr, sc);
  const int vb0 = (int)(uintptr_t)V_lds + v_rd_base(lane);
  struct { typename St::T vs0, vs1, ks0, ks1; } sr_[SDEPTH];
#define SLOAD(i, k0) do { sr_[i].vs0 = St::ld8(&Vh[(long)((k0) + sr) * LDK + sc]); sr_[i].vs1 = St::ld8(&Vh[(long)((k0) + 32 + sr) * LDK + sc]); \
    sr_[i].ks0 = St::ld8(&Kh[(long)((k0) + sr) * LDK + sc]); sr_[i].ks1 = St::ld8(&Kh[(long)((k0) + 32 + sr) * LDK + sc]); } while (0)
#define SWRITE(b, i) do { *(bf16x8*)((char*)V_lds + (b) * SHM_V + vst0) = St::tobf(sr_[i].vs0);          \
    *(bf16x8*)((char*)V_lds + (b) * SHM_V + vst1) = St::tobf(sr_[i].vs1); int kc = sc * 2;               \
    *(bf16x8*)((char*)K_lds + (b) * SHM_K + KSWZ(sr, kc)) = St::tobf(sr_[i].ks0);                       \
    *(bf16x8*)((char*)K_lds + (b) * SHM_K + KSWZ(32 + sr, kc)) = St::tobf(sr_[i].ks1); } while (0)
#define SWAIT() do { if constexpr (SDEPTH == 2) asm volatile("s_waitcnt vmcnt(4)" ::: "memory"); else asm volatile("s_waitcnt vmcnt(0)" ::: "memory"); } while (0)
#define RESC(a) do { if (__any((a) < 1.f)) { if (hi == 0) al_l[r32] = (a); asm volatile("s_waitcnt lgkmcnt(0)" ::: "memory"); \
    for (int d = 0; d < 4; ++d) for (int r = 0; r < 16; ++r) o[d][r] *= al_l[crow(r, hi)]; } } while (0)
  f32x16 pA0, pA1, pB0, pB1; float mnA, mnB, alA, alB; bf16x8 pa0, pa1, pa2, pa3; const int NT = seq / KVBLK;
  constexpr int SE = 0, SO = SDEPTH - 1;
  SLOAD(SE, 0); asm volatile("s_waitcnt vmcnt(0)" ::: "memory"); SWRITE(0, SE); __syncthreads();
  qkt(pA0, pA1, K_lds, qr, r32, hi); partialSM(pA0, pA1, m_reg, mnA, alA);
  SLOAD(SO, KVBLK); if constexpr (SDEPTH == 2) { if (2 < NT) SLOAD(SE, 2 * KVBLK); }
  SWAIT(); SWRITE(1, SO); __syncthreads();
  for (int j = 1; j + 1 < NT; j += 2) {
    SBAR(); qkt(pB0, pB1, (bf16*)((char*)K_lds + SHM_K), qr, r32, hi);
    finishSM(pA0, pA1, alA, l_reg, pa0, pa1, pa2, pa3); SBAR();
    SLOAD(SO, (j + SDEPTH) * KVBLK); SBAR();
    pv_d0(o, vb0, pa0, pa1, pa2, pa3); partialSM(pB0, pB1, m_reg, mnB, alB);
    __syncthreads(); SWAIT(); SWRITE(0, SE);
    RESC(alB); __syncthreads();
    SBAR(); qkt(pA0, pA1, K_lds, qr, r32, hi);
    finishSM(pB0, pB1, alB, l_reg, pa0, pa1, pa2, pa3); SBAR();
    if (SDEPTH == 1 || j + 3 < NT) SLOAD(SE, (j + 1 + SDEPTH) * KVBLK); SBAR();
    pv_d0(o, vb0 + (int)SHM_V, pa0, pa1, pa2, pa3); partialSM(pA0, pA1, m_reg, mnA, alA);
    __syncthreads(); SWAIT(); SWRITE(1, SO);
    RESC(alA); __syncthreads();
  }
  SBAR(); qkt(pB0, pB1, (bf16*)((char*)K_lds + SHM_K), qr, r32, hi);
  finishSM(pA0, pA1, alA, l_reg, pa0, pa1, pa2, pa3); SBAR();
  pv_d0(o, vb0, pa0, pa1, pa2, pa3); partialSM(pB0, pB1, m_reg, mnB, alB);
  __syncthreads(); RESC(alB);
  finishSM(pB0, pB1, alB, l_reg, pa0, pa1, pa2, pa3); SBAR();
  pv_d0(o, vb0 + (int)SHM_V, pa0, pa1, pa2, pa3);
  if (hi == 0) { li_l[r32] = l_reg; *reinterpret_cast<float2*>(st + (size_t)(wid * QBLK + r32) * 8) = make_float2(m_reg, l_reg); } asm volatile("s_waitcnt lgkmcnt(0)" ::: "memory");
  float rli[16];
#pragma unroll
  for (int r = 0; r < 16; ++r) rli[r] = __builtin_amdgcn_rcpf(li_l[crow(r, hi)]);
  float* Ow = Ob + (long)(wid * QBLK) * LDO;
#pragma unroll
  for (int r = 0; r < 16; ++r) { int orow = crow(r, hi);
    for (int d0 = 0; d0 < 4; ++d0) Ow[(long)orow * LDO + d0 * 32 + r32] = o[d0][r] * rli[r]; }
#undef SLOAD
#undef SWRITE
#undef SWAIT
#undef RESC
}

}

#ifndef PG8_SP2
#define PG8_SP2 true
#endif
#ifndef PG8_ALIGN
#define PG8_ALIGN true
#endif

#define GAS __attribute__((address_space(1)))
#define LAS __attribute__((address_space(3)))
constexpr int NWAVES = 8;
constexpr int DM = 2048, SEQ = 4096, NB = 2, CTX = 256;
constexpr int ML = NB * SEQ, MC = NB * CTX, MT = ML + MC;
constexpr int NIN = 5136, NINP = 5376;
constexpr int DFF = 5632, DFE = 7168, NE = 8;
constexpr int LK = CTX + SEQ;
constexpr int MODW = 6 * DM;
constexpr int MSLOT = 18432;
constexpr float EPS = 1e-6f;
constexpr int C_AQ = 0, C_BQ = 512, C_CU = 1024, C_CV = 1536, C_DZ = 2048, C_DC = 2560, C_AK = 2816, C_AV = 3072, C_BK = 3328, C_BV = 3840, C_DX = 4352, C_DB = 4864, C_DT = 5120;

constexpr size_t MiB = 1u << 20;
constexpr size_t WS_CTL = 0, CTL_ZERO_BYTES = 1 * MiB;
constexpr size_t WS_MODP = 1 * MiB;
constexpr size_t WS_MOD = 12 * MiB;
constexpr size_t WS_ROPE = 13 * MiB;
constexpr size_t WS_WIN = 16 * MiB;
constexpr size_t WS_WOUT = 64 * MiB;
constexpr size_t WS_W13 = 80 * MiB;
constexpr size_t WS_W2 = 128 * MiB;
constexpr size_t WS_WM13 = 152 * MiB;
constexpr size_t WS_WM2 = 600 * MiB;
constexpr size_t WS_H = 824 * MiB;
constexpr size_t WS_P = 860 * MiB;
constexpr size_t WS_QA = 952 * MiB;
constexpr size_t WS_KA = 962 * MiB;
constexpr size_t WS_VA = 968 * MiB;
constexpr size_t WS_VN = 974 * MiB;
constexpr size_t WS_XBC = 992 * MiB;
constexpr size_t WS_DT = 1028 * MiB;
constexpr size_t WS_Y = 1030 * MiB;
constexpr size_t WS_OM = 1066 * MiB;
constexpr size_t WS_OB = 1136 * MiB;
constexpr size_t WS_XA = 1172 * MiB;
constexpr size_t WS_XB = 1240 * MiB;
constexpr size_t WS_ACT = 1308 * MiB;
constexpr size_t WS_HS = 1404 * MiB;
constexpr size_t WS_ACTM = 1476 * MiB;
constexpr size_t WS_YM = 1728 * MiB;
constexpr size_t WS_ROUTE = 1872 * MiB;
constexpr size_t WS_VTB = 1874 * MiB;
constexpr size_t WS_BCB = 1884 * MiB;
constexpr size_t WS_XT = 1894 * MiB;
constexpr size_t WS_BT = 1904 * MiB;
constexpr size_t WS_CUM = 1910 * MiB;
constexpr size_t WS_TOT = 1911 * MiB;
constexpr size_t WS_ST = 1912 * MiB;
constexpr size_t WS_HIN = 1950 * MiB;
constexpr size_t WS_SGW = 1970 * MiB;
constexpr size_t WS_VNT = 1971 * MiB;
constexpr size_t WS_VTA = 1981 * MiB;
constexpr size_t WS_OM2 = 1982 * MiB;
constexpr size_t WS_AST = 1998 * MiB;
constexpr size_t WS_PARTW = 2000 * MiB;
constexpr size_t WS_PARTF = 2016 * MiB;
constexpr size_t WS_YMP = 2062 * MiB;
constexpr size_t WS_END = 2640 * MiB;
constexpr int CW_BAR = 4096;
constexpr int CW_CNT = 16384;
constexpr int CW_TAIL = 20480;

constexpr int RING_BYTES = 131072;
constexpr int LDSCTL_OFF = 143360, MISC_OFF = LDSCTL_OFF + 320;
constexpr int LDS_BYTES = 147456;

typedef unsigned short bf16;
typedef unsigned v4u __attribute__((ext_vector_type(4)));
typedef unsigned v2u __attribute__((ext_vector_type(2)));
typedef float f32x4 __attribute__((ext_vector_type(4)));
typedef float f32x2 __attribute__((ext_vector_type(2)));
typedef GAS unsigned gu32;
typedef short bf16x8 __attribute__((ext_vector_type(8)));
#define RLX_AGENT __ATOMIC_RELAXED, __HIP_MEMORY_SCOPE_AGENT
#define LDS_WAIT() asm volatile("s_waitcnt lgkmcnt(0)" ::: "memory")
#define VM_WAIT() asm volatile("s_waitcnt vmcnt(0)" ::: "memory")
__device__ __forceinline__ unsigned f2bf(float f) { unsigned u = __builtin_bit_cast(unsigned, f); return (u + 0x7fffu + ((u >> 16) & 1u)) >> 16; }
__device__ __forceinline__ unsigned pk2(float lo, float hi) { return f2bf(lo) | (f2bf(hi) << 16); }
__device__ __forceinline__ float bf2f(unsigned short b) { return __builtin_bit_cast(float, (unsigned)b << 16); }
__device__ __forceinline__ float bflo(unsigned w) { return __builtin_bit_cast(float, w << 16); }
__device__ __forceinline__ float bfhi(unsigned w) { return __builtin_bit_cast(float, w & 0xffff0000u); }
template <int K> __device__ __forceinline__ float swz(float v) { return __builtin_bit_cast(float, __builtin_amdgcn_ds_swizzle(__builtin_bit_cast(int, v), (K << 10) | 0x1F)); }
__device__ __forceinline__ float wave_sum(float v) {
    v += swz<1>(v); v += swz<2>(v); v += swz<4>(v); v += swz<8>(v); v += swz<16>(v);
    const auto rr = __builtin_amdgcn_permlane32_swap(__float_as_uint(v), __float_as_uint(v), false, false);
    return __uint_as_float(rr[0]) + __uint_as_float(rr[1]);
}
__device__ __forceinline__ float wave_max(float v) {
    v = fmaxf(v, swz<1>(v)); v = fmaxf(v, swz<2>(v)); v = fmaxf(v, swz<4>(v)); v = fmaxf(v, swz<8>(v)); v = fmaxf(v, swz<16>(v));
    const auto rr = __builtin_amdgcn_permlane32_swap(__float_as_uint(v), __float_as_uint(v), false, false);
    return fmaxf(__uint_as_float(rr[0]), __uint_as_float(rr[1]));
}
__device__ __forceinline__ float sum_x32(float v) { const auto rr = __builtin_amdgcn_permlane32_swap(__float_as_uint(v), __float_as_uint(v), false, false); return __uint_as_float(rr[0]) + __uint_as_float(rr[1]); }
__device__ __forceinline__ float max_x32(float v) { const auto rr = __builtin_amdgcn_permlane32_swap(__float_as_uint(v), __float_as_uint(v), false, false); return fmaxf(__uint_as_float(rr[0]), __uint_as_float(rr[1])); }
__device__ __forceinline__ float lane_get(float v, int src) { return __builtin_bit_cast(float, __builtin_amdgcn_ds_bpermute(src << 2, __builtin_bit_cast(int, v))); }
__device__ __forceinline__ float lane_bcast(float v, int src) { return __builtin_bit_cast(float, __builtin_amdgcn_readlane(__builtin_bit_cast(int, v), src)); }
__device__ __forceinline__ float silu1(float v) { return v / (1.0f + expf(-v)); }
__device__ __forceinline__ float gelu_tanh(float v) { const float u = 0.7978845608028654f * (v + 0.044715f * v * v * v); return 0.5f * v * (1.0f + tanhf(u)); }
__device__ __forceinline__ float silu_fast(float v) { return v * __builtin_amdgcn_rcpf(1.0f + __expf(-v)); }
__device__ __forceinline__ float gelu_fast(float v) { const float u = 1.5957691216057308f * (v + 0.044715f * v * v * v); return v * __builtin_amdgcn_rcpf(1.0f + __expf(-u)); }
__device__ __forceinline__ float softplus1(float v) { return v > 20.f ? v : log1pf(expf(v)); }

#define XB_TMO      128
#define XB_XCNT(j)  (256  + 64 * (j))
#define XB_XSUB(j)  (1280 + 64 * (j))
#define XB_XGEN(j)  (2304 + 64 * (j))
#define XB_TOP      3328
#define XB_TOPGEN   3392
#define XCD_BAR_WORDS 3456
#define XB_SPIN_CAP (1u << 18)
__device__ __forceinline__ unsigned xb_ld(unsigned* p)              { return __hip_atomic_load(p, __ATOMIC_RELAXED, __HIP_MEMORY_SCOPE_AGENT); }
__device__ __forceinline__ unsigned xb_add(unsigned* p, unsigned v) { return __hip_atomic_fetch_add(p, v, __ATOMIC_RELAXED, __HIP_MEMORY_SCOPE_AGENT); }
__device__ __forceinline__ unsigned xb_xcc_id() { return (unsigned)__builtin_amdgcn_s_getreg((3 << 11) | 20) & 0xFu; }
#define XB_SPIN(cond, bar) do { unsigned _sp = 0; while (cond) { __builtin_amdgcn_s_sleep(1); \
    if ((++_sp & 255u) == 0u) { if (xb_ld(&(bar)[XB_TMO])) break; if (_sp > XB_SPIN_CAP) { atomicAdd(&(bar)[XB_TMO], 1u); break; } } } } while (0)
__device__ __forceinline__ int lane_id() { int l_; asm volatile("v_mbcnt_lo_u32_b32 %0, -1, 0\n\tv_mbcnt_hi_u32_b32 %0, -1, %0" : "=v"(l_)); return l_; }
struct XcdBarrier { unsigned* bar; unsigned x; volatile LAS unsigned* st; int wave; };
__device__ __forceinline__ XcdBarrier xcd_barrier_post(unsigned* bar, volatile LAS unsigned* st) {
    XcdBarrier b; b.bar = bar; b.x = xb_xcc_id(); b.st = st; b.wave = 0;
    if (threadIdx.x == 0) (void)xb_add(&bar[XB_XCNT(b.x)], 1u);
    return b;
}
__device__ __forceinline__ void xcd_barrier_complete(unsigned* bar, unsigned x, unsigned& nloc, unsigned& nx) {
    const unsigned G = gridDim.x * gridDim.y * gridDim.z;
    unsigned sum, cnt, mine, sp = 0u;
    for (;;) {
        sum = 0u; cnt = 0u; mine = 0u;
#pragma unroll
        for (unsigned j = 0; j < 16; ++j) { const unsigned c = xb_ld(&bar[XB_XCNT(j)]); sum += c; cnt += (c > 0u) ? 1u : 0u; mine = (j == x) ? c : mine; }
        if (sum == G) break;
        __builtin_amdgcn_s_sleep(1);
        if ((++sp & 255u) == 0u) { if (xb_ld(&bar[XB_TMO])) break; if (sp > XB_SPIN_CAP) { atomicAdd(&bar[XB_TMO], 1u); break; } }
    }
    nloc = mine > 0u ? mine : 1u; nx = cnt > 0u ? cnt : 1u;
}
__device__ __forceinline__ void xcd_barrier(const XcdBarrier& b) {
    asm volatile("s_waitcnt vmcnt(0)" ::: "memory");
    __syncthreads();
    if (b.wave == 0 && lane_id() == 0) {
        unsigned* bar = b.bar;
        __builtin_amdgcn_s_waitcnt(0);
        unsigned nloc = b.st[0], nx = b.st[1];
        if (nloc == 0u) { xcd_barrier_complete(bar, b.x, nloc, nx); b.st[0] = nloc; b.st[1] = nx; }
        const unsigned old = xb_add(&bar[XB_XSUB(b.x)], 1u);
        const unsigned gen = old / nloc;
        if (old + 1u == (gen + 1u) * nloc) {
            __builtin_amdgcn_fence(__ATOMIC_RELEASE, "agent");
            asm volatile("s_waitcnt vmcnt(0)" ::: "memory");
            const unsigned og = xb_add(&bar[XB_TOP], 1u);
            const unsigned tg = og / nx;
            if (og + 1u == (tg + 1u) * nx) xb_add(&bar[XB_TOPGEN], 1u);
            else XB_SPIN(xb_ld(&bar[XB_TOPGEN]) == tg, bar);
            __builtin_amdgcn_fence(__ATOMIC_ACQUIRE, "agent");
            xb_add(&bar[XB_XGEN(b.x)], 1u);
            asm volatile("s_waitcnt vmcnt(0)" ::: "memory");
        } else {
            XB_SPIN(xb_ld(&bar[XB_XGEN(b.x)]) == gen, bar);
            __builtin_amdgcn_fence(__ATOMIC_ACQUIRE, "agent");
            asm volatile("s_waitcnt vmcnt(0)" ::: "memory");
        }
    }
    __syncthreads();
}

struct Args { const GAS float* in[28]; GAS float* out; GAS unsigned char* ws; int ph_lo, ph_hi; };
__device__ __forceinline__ const float* ain(const Args& A, int i) { return (const float*)A.in[i]; }
struct Frame {
    LAS unsigned char* lds;
    unsigned char* ldsg;
    volatile LAS unsigned* MISC;
    gu32* ctl;
    int tid, lane, wave;
    int vcu, G;
    float* out;
    unsigned char* ws;
};
enum { I_X = 0, I_C, I_CTX, I_CCTX, I_WMOD, I_BMOD, I_NMIX, I_NFFN, I_WIN, I_QN, I_KN, I_RPB, I_SGUN, I_SGUW, I_SGUB, I_CONVW, I_CONVB, I_ALOG, I_DTB, I_DSKIP, I_ONORM, I_WOUT, I_W13, I_W2, I_ROUTER, I_MW13, I_MW2, I_FNORM };

struct CvtIt { const float* W; bf16* WT; int K, N, drow0, k0, n0; float f8; };
__device__ __forceinline__ void cvt_load(const CvtIt& c, int lane, f32x4 (&v)[8]) {
    const int r8 = lane >> 3, c4 = (lane & 7) * 4;
    const bool ok = (c.n0 + c4) < c.N;
#pragma unroll
    for (int i = 0; i < 8; ++i) { v[i] = ok ? __builtin_nontemporal_load((const GAS f32x4*)(c.W + (size_t)(c.k0 + r8 + 8 * i) * c.N + c.n0 + c4)) : (f32x4){0.f, 0.f, 0.f, 0.f}; }
}
__device__ __forceinline__ void cvt_store(const CvtIt& c, LAS float* scr, int lane, const f32x4 (&v)[8]) {
    const int r8 = lane >> 3, c4 = (lane & 7) * 4;
#pragma unroll
    for (int i = 0; i < 8; ++i) { LAS float* s = scr + (r8 + 8 * i) * 33 + c4; s[0] = v[i][0]; s[1] = v[i][1]; s[2] = v[i][2]; s[3] = v[i][3]; }
    LDS_WAIT(); asm volatile("" ::: "memory");
    const int cc = lane & 7;
#pragma unroll
    for (int j = 0; j < 4; ++j) { const int n = (lane >> 3) + 8 * j; const LAS float* s = scr + (8 * cc) * 33 + n;
        v4u o; o.x = pk2(s[0 * 33], s[1 * 33]); o.y = pk2(s[2 * 33], s[3 * 33]); o.z = pk2(s[4 * 33], s[5 * 33]); o.w = pk2(s[6 * 33], s[7 * 33]);
        *(GAS v4u*)(c.WT + (size_t)(c.drow0 + n) * c.K + c.k0 + 8 * cc) = o; }
    LDS_WAIT(); asm volatile("" ::: "memory");
}
__device__ __forceinline__ int map13(int n0, int dff) { const int h = n0 >= dff ? 1 : 0, j = n0 - h * dff; return (j >> 7) * 256 + h * 128 + (j & 127); }
__device__ __forceinline__ void cvt8_load(const CvtIt& c, int lane, f32x4 (&v)[16]) {
    const int r8 = lane >> 3, c4 = (lane & 7) * 4;
#pragma unroll
    for (int i = 0; i < 16; ++i) v[i] = __builtin_nontemporal_load((const GAS f32x4*)(c.W + (size_t)(c.k0 + r8 + 8 * i) * c.N + c.n0 + c4));
}
__device__ __forceinline__ void cvt8_store(const CvtIt& c, LAS float* scr, int lane, const f32x4 (&v)[16]) {
    const int r8 = lane >> 3, c4 = (lane & 7) * 4;
#pragma unroll
    for (int i = 0; i < 16; ++i) { LAS float* s = scr + (r8 + 8 * i) * 33 + c4; s[0] = v[i][0]; s[1] = v[i][1]; s[2] = v[i][2]; s[3] = v[i][3]; }
    LDS_WAIT(); asm volatile("" ::: "memory");
    const int part = lane & 7; unsigned char* W8 = (unsigned char*)c.WT;
#pragma unroll
    for (int j = 0; j < 4; ++j) { const int n = (lane >> 3) + 8 * j; const LAS float* s = scr + (16 * part) * 33 + n; float x[16];
#pragma unroll
        for (int i = 0; i < 16; ++i) x[i] = s[i * 33] * c.f8;
        v4u o; o.x = pg8::pack_fp8x4(x[0], x[1], x[2], x[3]); o.y = pg8::pack_fp8x4(x[4], x[5], x[6], x[7]); o.z = pg8::pack_fp8x4(x[8], x[9], x[10], x[11]); o.w = pg8::pack_fp8x4(x[12], x[13], x[14], x[15]);
        *(GAS v4u*)(W8 + (size_t)(c.drow0 + n) * c.K + c.k0 + 16 * part) = o; }
    LDS_WAIT(); asm volatile("" ::: "memory");
}
__device__ __forceinline__ void cvt_decode(Frame& F, const Args& A, int it, CvtIt& c) {
    constexpr int I_IN = 32 * 161, I_OUT = 32 * 64;
    int r = it;
    if (r < 2 * I_IN) { const int l = r / I_IN; r -= l * I_IN; const int kb = r / 161, nb = r % 161;
        c = CvtIt{ain(A, I_WIN) + (size_t)l * DM * NIN, (bf16*)(F.ws + WS_WIN) + (size_t)l * NINP * DM, DM, NIN, 32 * nb, 64 * kb, 32 * nb, 0.f}; return; }
    r -= 2 * I_IN;
    if (r < 2 * I_OUT) { const int l = r / I_OUT; r -= l * I_OUT; const int kb = r / 64, nb = r % 64;
        c = CvtIt{ain(A, I_WOUT) + (size_t)l * DM * DM, (bf16*)(F.ws + WS_WOUT) + (size_t)l * DM * DM, DM, DM, 32 * nb, 64 * kb, 32 * nb, 0.f}; return; }
    r -= 2 * I_OUT;
    { const int kb = r / 352, nb = r % 352;
        c = CvtIt{ain(A, I_W13), (bf16*)(F.ws + WS_W13), DM, 2 * DFF, map13(32 * nb, DFF), 64 * kb, 32 * nb, 0.f}; }
}
constexpr int MOE_ITEMS = 8 * 16 * 448 + 8 * 56 * 64;
#ifndef DEF_PER_PHASE
#define DEF_PER_PHASE 31232
#endif
#ifndef G1_SLACK
#define G1_SLACK 4096
#endif
constexpr int G1_STREAM_WGS = 16;
constexpr int MG0_ITEMS = 7680, FF1_ITEMS = 3200, WO0_ITEMS = 3072;
constexpr int OFF_G1 = 2 * DEF_PER_PHASE, OFF_MG0 = OFF_G1 + 2 * G1_SLACK, OFF_FF1 = OFF_MG0 + MG0_ITEMS, OFF_WO0 = OFF_FF1 + FF1_ITEMS;
constexpr int MOE_DEFERRED = OFF_WO0 + WO0_ITEMS;
static_assert(MOE_DEFERRED <= MOE_ITEMS, "deferred MoE items");
__device__ __forceinline__ void cvt8m_decode(Frame& F, const Args& A, int idx, CvtIt& c) {
    constexpr int I_M13 = 16 * 448, I_M2 = 56 * 64;
    int r = idx;
    if (r < 8 * I_M13) { const int e = r / I_M13; r -= e * I_M13; const int kb = r / 448, nb = r % 448;
        c = CvtIt{ain(A, I_MW13) + (size_t)e * DM * 2 * DFE, (bf16*)(F.ws + WS_WM13 + (size_t)e * 2 * DFE * DM), DM, 2 * DFE, map13(32 * nb, DFE), 128 * kb, 32 * nb, 256.f}; return; }
    r -= 8 * I_M13;
    { const int e = r / I_M2; r -= e * I_M2; const int kb = r / 64, nb = r % 64;
        c = CvtIt{ain(A, I_MW2) + (size_t)e * DFE * DM, (bf16*)(F.ws + WS_WM2 + (size_t)e * DM * DFE), DFE, DM, 32 * nb, 128 * kb, 32 * nb, 512.f}; }
}
__device__ __forceinline__ void cvt8_decode(Frame& F, const Args& A, int it, CvtIt& c) {
    constexpr int I_2 = 44 * 64;
    if (it < I_2) { const int kb = it / 64, nb = it % 64;
        c = CvtIt{ain(A, I_W2), (bf16*)(F.ws + WS_W2), DFF, DM, 32 * nb, 128 * kb, 32 * nb, 512.f}; return; }
    cvt8m_decode(F, A, it - I_2 + MOE_DEFERRED, c);
}
__device__ __forceinline__ void cvt8_deferred(Frame& F, const Args& A, int base, int count, int w, int nw) {
    LAS float* scr = (LAS float*)(F.lds + F.wave * 17408);
    const int lane = F.lane, end = base + count;
    CvtIt ca, cb; f32x4 va[16], vb[16];
    int it = base + w;
    if (it < end) { cvt8m_decode(F, A, it, ca); cvt8_load(ca, lane, va); }
    while (it < end) {
        const bool hb = it + nw < end;
        if (hb) { cvt8m_decode(F, A, it + nw, cb); cvt8_load(cb, lane, vb); }
        cvt8_store(ca, scr, lane, va);
        if (!hb) break;
        const bool ha = it + 2 * nw < end;
        if (ha) { cvt8m_decode(F, A, it + 2 * nw, ca); cvt8_load(ca, lane, va); }
        cvt8_store(cb, scr, lane, vb);
        it += 2 * nw;
        if (!ha) break;
    }
}
__device__ __forceinline__ void pro_cvt(Frame& F, const Args& A) {
    LAS float* scr = (LAS float*)(F.lds + F.wave * 17408);
    const int gw = F.vcu * NWAVES + F.wave, NGW = F.G * NWAVES, lane = F.lane;
    { constexpr int NITEMS = 2 * 32 * 161 + 2 * 32 * 64 + 32 * 352;
      CvtIt ca, cb; f32x4 va[8], vb[8];
      int it = gw;
      if (it < NITEMS) { cvt_decode(F, A, it, ca); cvt_load(ca, lane, va); }
      while (it < NITEMS) {
          const bool hb = it + NGW < NITEMS;
          if (hb) { cvt_decode(F, A, it + NGW, cb); cvt_load(cb, lane, vb); }
          cvt_store(ca, scr, lane, va);
          if (!hb) break;
          const bool ha = it + 2 * NGW < NITEMS;
          if (ha) { cvt_decode(F, A, it + 2 * NGW, ca); cvt_load(ca, lane, va); }
          cvt_store(cb, scr, lane, vb);
          it += 2 * NGW;
          if (!ha) break;
      } }
    if (F.G != 256) cvt8_deferred(F, A, OFF_G1, MOE_DEFERRED - OFF_G1, gw, NGW);
    { constexpr int NITEMS = 44 * 64 + MOE_ITEMS - MOE_DEFERRED;
      CvtIt ca, cb; f32x4 va[16], vb[16];
      int it = gw;
      if (it < NITEMS) { cvt8_decode(F, A, it, ca); cvt8_load(ca, lane, va); }
      while (it < NITEMS) {
          const bool hb = it + NGW < NITEMS;
          if (hb) { cvt8_decode(F, A, it + NGW, cb); cvt8_load(cb, lane, vb); }
          cvt8_store(ca, scr, lane, va);
          if (!hb) break;
          const bool ha = it + 2 * NGW < NITEMS;
          if (ha) { cvt8_decode(F, A, it + 2 * NGW, ca); cvt8_load(ca, lane, va); }
          cvt8_store(cb, scr, lane, vb);
          it += 2 * NGW;
          if (!ha) break;
      } }
}
__device__ __forceinline__ void pro_mod(Frame& F, const Args& A) {
    const int gw = F.vcu * NWAVES + F.wave, NGW = F.G * NWAVES, lane = F.lane;
    float* modp = (float*)(F.ws + WS_MODP);
    for (int it = gw; it < 2 * 32 * 48; it += NGW) {
        const int l = it / (32 * 48), r = it % (32 * 48), ks = r / 48, cb = r % 48;
        const float* wm = ain(A, I_WMOD) + (size_t)l * DM * MODW + (size_t)(ks * 64) * MODW + cb * 256 + 4 * lane;
        f32x4 a0 = {0.f, 0.f, 0.f, 0.f}, a1 = a0, a2 = a0;
#pragma unroll 8
        for (int k = 0; k < 64; ++k) {
            const f32x4 w = __builtin_nontemporal_load((const GAS f32x4*)(wm + (size_t)k * MODW));
            const int kk = ks * 64 + k;
            const float s0 = silu1(ain(A, I_C)[kk]), s1 = silu1(ain(A, I_C)[DM + kk]), s2 = silu1(ain(A, I_CCTX)[kk]);
            a0 += w * s0; a1 += w * s1; a2 += w * s2;
        }
        float* o = modp + ((size_t)(l * 32 + ks) * 3) * MODW + cb * 256 + 4 * lane;
        *(GAS f32x4*)(o) = a0; *(GAS f32x4*)(o + MODW) = a1; *(GAS f32x4*)(o + 2 * MODW) = a2;
    }
}
__device__ __forceinline__ void pro_rope(Frame& F, const Args& A) {
    { bf16* sgw = (bf16*)(F.ws + WS_SGW);
      for (int idx = (F.vcu * NWAVES * 64) + F.tid; idx < 2 * 4 * 128 * 128; idx += F.G * NWAVES * 64) sgw[idx] = (bf16)f2bf(ain(A, I_SGUW)[idx]); }
    f32x2* rope = (f32x2*)(F.ws + WS_ROPE);
    for (int idx = (F.vcu * NWAVES * 64) + F.tid; idx < SEQ * 64; idx += F.G * NWAVES * 64) {
        const int t = idx >> 6, i = idx & 63;
        const float pos = (float)(i < 32 ? (t >> 6) : (t & 63));
        const float inv = powf(10000.0f, -(float)(i & 31) / 32.0f);
        const float ang = pos * inv;
        rope[idx] = (f32x2){cosf(ang), sinf(ang)};
    }
}
__device__ __forceinline__ void phase_pro_b(Frame& F, const Args& A) {
    const float* modp = (const float*)(F.ws + WS_MODP); float* mod = (float*)(F.ws + WS_MOD);
    for (int idx = (F.vcu * NWAVES * 64) + F.tid; idx < 2 * 3 * MODW; idx += F.G * NWAVES * 64) {
        const int l = idx / (3 * MODW), r = idx % (3 * MODW), j = r % MODW;
        float s = ain(A, I_BMOD)[l * MODW + j];
        for (int ks = 0; ks < 32; ++ks) s += modp[(size_t)(l * 32 + ks) * 3 * MODW + r];
        mod[idx] = s;
    }
}
template <bool O8 = false>
__device__ __forceinline__ void norm_mod_vals(const f32x4 (&v)[8], const float* __restrict__ gain, const float* __restrict__ sh, const float* __restrict__ sc, bf16* __restrict__ orow, int lane, f32x4 (&y)[8]) {
    float ss = 0.f;
#pragma unroll
    for (int j = 0; j < 8; ++j) ss += (v[j].x * v[j].x + v[j].y * v[j].y) + (v[j].z * v[j].z + v[j].w * v[j].w);
    const float r = 1.0f / sqrtf(wave_sum(ss) * (1.0f / DM) + EPS);
#pragma unroll
    for (int j = 0; j < 8; ++j) { const int c = 4 * lane + 256 * j;
        const f32x4 g = *(const GAS f32x4*)(gain + c), s1 = *(const GAS f32x4*)(sc + c), s0 = *(const GAS f32x4*)(sh + c);
        y[j] = (v[j] * r) * g * (s1 + 1.0f) + s0;
        if (O8) *(GAS unsigned*)((unsigned char*)orow + c) = pg8::pack_fp8x4(y[j].x * 4.f, y[j].y * 4.f, y[j].z * 4.f, y[j].w * 4.f);
        else { v2u o; o.x = pk2(y[j].x, y[j].y); o.y = pk2(y[j].z, y[j].w); *(GAS v2u*)(orow + c) = o; } }
}
template <bool O8 = false>
__device__ __forceinline__ void norm_mod_row(const float* __restrict__ xrow, const float* __restrict__ gain, const float* __restrict__ sh, const float* __restrict__ sc, bf16* __restrict__ orow, int lane, f32x4 (&y)[8]) {
    f32x4 v[8];
#pragma unroll
    for (int j = 0; j < 8; ++j) v[j] = *(const GAS f32x4*)(xrow + 4 * lane + 256 * j);
    norm_mod_vals<O8>(v, gain, sh, sc, orow, lane, y);
}
template <int NS>
__device__ __forceinline__ void ctx_row_from_parts(const float* base, const float* gate, const float* parts, int r, int lane, f32x4 (&v)[8]) {
#pragma unroll
    for (int j = 0; j < 8; ++j) { const int c = 4 * lane + 256 * j;
        f32x4 s = *(const GAS f32x4*)(parts + (size_t)r * DM + c);
#pragma unroll
        for (int k = 1; k < NS; ++k) s += *(const GAS f32x4*)(parts + ((size_t)k * MC + r) * DM + c);
        v[j] = *(const GAS f32x4*)(base + c) + *(const GAS f32x4*)(gate + c) * s; }
}
__device__ __forceinline__ const float* xrow_ptr(Frame& F, const Args& A, int l, int row) {
    if (l == 0) return row < ML ? ain(A, I_X) + (size_t)row * DM : ain(A, I_CTX) + (size_t)(row - ML) * DM;
    return (const float*)(F.ws + WS_XB) + (size_t)row * DM;
}
__device__ __forceinline__ int row_vec(int row) { return row < SEQ ? 0 : (row < ML ? 1 : 2); }
__device__ __forceinline__ void phase_n1(Frame& F, const Args& A, int l) {
    const int gw = F.vcu * NWAVES + F.wave, NGW = F.G * NWAVES;
    const float* mod = (const float*)(F.ws + WS_MOD) + (size_t)l * 3 * MODW;
    bf16* H = (bf16*)(F.ws + WS_H);
    for (int row = gw; row < MT; row += NGW) {
        const float* m = mod + row_vec(row) * MODW; f32x4 y[8];
        if (l == 1 && row >= ML) {
            f32x4 v[8];
            ctx_row_from_parts<11>((const float*)(F.ws + WS_XA) + (size_t)row * DM, (const float*)(F.ws + WS_MOD) + 2 * MODW + 5 * DM, (const float*)(F.ws + WS_PARTF), row - ML, F.lane, v);
            norm_mod_vals(v, ain(A, I_NMIX) + l * DM, m, m + DM, H + (size_t)row * DM, F.lane, y);
        } else norm_mod_row(xrow_ptr(F, A, l, row), ain(A, I_NMIX) + l * DM, m, m + DM, H + (size_t)row * DM, F.lane, y);
    }
}
template <bool TILE>
__device__ __forceinline__ void prep_one_row_impl(const bf16* __restrict__ P, bf16* __restrict__ QA, bf16* __restrict__ KA, bf16* __restrict__ VA, bf16* __restrict__ VNT, float* __restrict__ XBC, float* __restrict__ DT,
        bf16* __restrict__ VTB, bf16* __restrict__ VTA, bf16* __restrict__ BCB, bf16* __restrict__ XT, bf16* __restrict__ BT, const f32x2* __restrict__ rope, const float* __restrict__ qn, const float* __restrict__ kn,
        const float (&cwv)[16][5], const float (&cbv)[16], const float* __restrict__ sgun, const float* __restrict__ dtb, int row, int lane, LAS bf16* tile, int tok) {
    const bool lat = TILE ? true : row < ML;
    const int b = lat ? row / SEQ : (row - ML) / CTX, tpos = lat ? row % SEQ : (row - ML) % CTX, slen = lat ? SEQ : CTX;
    const int pos = lat ? CTX + tpos : tpos;
    const bf16* pr = P + (size_t)row * NINP;
    f32x2 cs = {1.f, 0.f}; if (lat) cs = rope[tpos * 64 + lane];
#pragma unroll
    for (int hh = 0; hh < 6; ++hh) {
        const int src = hh < 4 ? C_AQ + hh * 128 : C_AK + (hh - 4) * 128;
        const unsigned w = *(const GAS unsigned*)(pr + src + 2 * lane);
        const float v0 = bflo(w), v1 = bfhi(w);
        const float r = 1.0f / sqrtf(wave_sum(v0 * v0 + v1 * v1) * (1.0f / 128.f) + EPS);
        const float* gn = hh < 4 ? qn : kn;
        const float y0 = v0 * r * gn[2 * lane], y1 = v1 * r * gn[2 * lane + 1];
        const float o0 = y0 * cs.x - y1 * cs.y, o1 = y0 * cs.y + y1 * cs.x;
        bf16* dst = hh < 4 ? QA + (size_t)row * 512 + hh * 128 : KA + ((size_t)b * LK + pos) * 256 + (hh - 4) * 128;
        *(GAS unsigned*)(dst + 2 * lane) = pk2(o0, o1);
    }
    { const v2u w = *(const GAS v2u*)(pr + C_AV + 4 * lane);
      *(GAS v2u*)(VA + ((size_t)b * LK + pos) * 256 + 4 * lane) = w; }
#pragma unroll
    for (int i = 0; i < 8; ++i) { const int v = lane + 64 * i;
        if (TILE) tile[v * 34 + tok] = pr[C_BV + v];
        else VTB[((size_t)(b * 4 + (v >> 7)) * 128 + (v & 127)) * LK + pos] = pr[C_BV + v]; }
    if (!lat) {
#pragma unroll
        for (int i = 0; i < 4; ++i) { const int v = lane + 64 * i;
            VTA[((size_t)(b * 2 + (v >> 7)) * 128 + (v & 127)) * 256 + tpos] = pr[C_AV + v]; } }
    { const v4u w = *(const GAS v4u*)(pr + C_CV + 8 * lane);
      float g[8]; g[0] = gelu_fast(bflo(w.x)); g[1] = gelu_fast(bfhi(w.x)); g[2] = gelu_fast(bflo(w.y)); g[3] = gelu_fast(bfhi(w.y));
      g[4] = gelu_fast(bflo(w.z)); g[5] = gelu_fast(bfhi(w.z)); g[6] = gelu_fast(bflo(w.w)); g[7] = gelu_fast(bfhi(w.w));
      float ss = 0.f;
#pragma unroll
      for (int i = 0; i < 8; ++i) ss += g[i] * g[i];
      const float r = 1.0f / sqrtf(wave_sum(ss) * (1.0f / 512.f) + EPS);
      const float* sn = sgun + 8 * lane;
      bf16* vt = VNT + ((size_t)(row >> 7) * 512 + 8 * lane) * 128 + (row & 127);
#pragma unroll
      for (int i = 0; i < 8; ++i) { const bf16 o = (bf16)f2bf(g[i] * r * sn[i]);
          if (TILE) tile[(512 + 8 * lane + i) * 34 + tok] = o; else vt[i * 128] = o; } }
    int roff[5]; float mk[5];
#pragma unroll
    for (int k = 0; k < 5; ++k) { const int tt = tpos + k - 2; const bool ok = tt >= 0 && tt < slen; roff[k] = ok ? (k - 2) * NINP : 0; mk[k] = ok ? 1.f : 0.f; }
#pragma unroll
    for (int i0 = 0; i0 < 16; i0 += 8) {
        unsigned short tp[8][5];
#pragma unroll
        for (int ii = 0; ii < 8; ++ii) { const int ch = lane + 64 * (i0 + ii);
            const int col = i0 + ii < 8 ? C_DX + ch : (i0 + ii < 12 ? C_DB + (ch - 512) : C_DC + (ch - 768));
#pragma unroll
            for (int k = 0; k < 5; ++k) tp[ii][k] = pr[roff[k] + col]; }
#pragma unroll
        for (int ii = 0; ii < 8; ++ii) { const int ch = lane + 64 * (i0 + ii);
            float acc = cbv[i0 + ii];
#pragma unroll
            for (int k = 0; k < 5; ++k) acc += (cwv[i0 + ii][k] * mk[k]) * bf2f(tp[ii][k]);
            const float sv = silu_fast(acc);
            XBC[(size_t)row * 1024 + ch] = sv; const bf16 sb = (bf16)f2bf(sv);
            if (i0 + ii < 8) { if (TILE) tile[(1024 + ch) * 34 + tok] = sb; else XT[((size_t)b * 512 + ch) * LK + pos] = sb; }
            else { BCB[(size_t)row * 512 + (ch - 512)] = sb;
                if (i0 + ii < 12) { if (TILE) tile[(1536 + ch - 512) * 34 + tok] = sb; else BT[((size_t)b * 256 + (ch - 512)) * LK + pos] = sb; } }
        }
    }
    if (lane < 16) DT[(size_t)row * 16 + lane] = softplus1(bf2f(pr[C_DT + lane]) + dtb[lane]);
}
__device__ __forceinline__ void prep_two_rows(const bf16* __restrict__ P, bf16* __restrict__ QA, bf16* __restrict__ KA, bf16* __restrict__ VA, float* __restrict__ XBC, float* __restrict__ DT, bf16* __restrict__ BCB,
        const f32x2* __restrict__ rope, const float* __restrict__ qn, const float* __restrict__ kn, const float* __restrict__ cw, const float* __restrict__ cb, const float* __restrict__ sgun, const float* __restrict__ dtb,
        int row0, int row1, int lane, LAS bf16* tile, int tok0, int tok1) {
    const int row[2] = {row0, row1}, tok[2] = {tok0, tok1};
    int b[2], tpos[2], pos[2]; const bf16* pr[2];
#pragma unroll
    for (int q = 0; q < 2; ++q) { b[q] = row[q] / SEQ; tpos[q] = row[q] % SEQ; pos[q] = CTX + tpos[q]; pr[q] = P + (size_t)row[q] * NINP; }
    f32x2 cs[2]; unsigned qk[2][6]; v2u av[2]; unsigned short bvv[2][8]; v4u cvw[2]; unsigned short dtv[2];
#pragma unroll
    for (int q = 0; q < 2; ++q) {
        cs[q] = rope[tpos[q] * 64 + lane];
#pragma unroll
        for (int hh = 0; hh < 6; ++hh) qk[q][hh] = *(const GAS unsigned*)(pr[q] + (hh < 4 ? C_AQ + hh * 128 : C_AK + (hh - 4) * 128) + 2 * lane);
        av[q] = *(const GAS v2u*)(pr[q] + C_AV + 4 * lane);
#pragma unroll
        for (int i = 0; i < 8; ++i) bvv[q][i] = pr[q][C_BV + lane + 64 * i];
        cvw[q] = *(const GAS v4u*)(pr[q] + C_CV + 8 * lane);
        dtv[q] = pr[q][C_DT + (lane & 15)];
    }
    float gq_[6][2];
#pragma unroll
    for (int hh = 0; hh < 6; ++hh) { const float* gn = hh < 4 ? qn : kn; gq_[hh][0] = gn[2 * lane]; gq_[hh][1] = gn[2 * lane + 1]; }
    float sn[8];
#pragma unroll
    for (int i = 0; i < 8; ++i) sn[i] = sgun[8 * lane + i];
#pragma unroll
    for (int hh = 0; hh < 6; ++hh) {
        float v0[2], v1[2], ss[2];
#pragma unroll
        for (int q = 0; q < 2; ++q) { v0[q] = bflo(qk[q][hh]); v1[q] = bfhi(qk[q][hh]); ss[q] = v0[q] * v0[q] + v1[q] * v1[q]; }
        ss[0] = wave_sum(ss[0]); ss[1] = wave_sum(ss[1]);
#pragma unroll
        for (int q = 0; q < 2; ++q) { const float r = 1.0f / sqrtf(ss[q] * (1.0f / 128.f) + EPS);
            const float y0 = v0[q] * r * gq_[hh][0], y1 = v1[q] * r * gq_[hh][1];
            const float o0 = y0 * cs[q].x - y1 * cs[q].y, o1 = y0 * cs[q].y + y1 * cs[q].x;
            bf16* dst = hh < 4 ? QA + (size_t)row[q] * 512 + hh * 128 : KA + ((size_t)b[q] * LK + pos[q]) * 256 + (hh - 4) * 128;
            *(GAS unsigned*)(dst + 2 * lane) = pk2(o0, o1); }
    }
#pragma unroll
    for (int q = 0; q < 2; ++q) { *(GAS v2u*)(VA + ((size_t)b[q] * LK + pos[q]) * 256 + 4 * lane) = av[q];
#pragma unroll
        for (int i = 0; i < 8; ++i) tile[(lane + 64 * i) * 34 + tok[q]] = bvv[q][i]; }
    { float g[2][8], ss[2];
#pragma unroll
      for (int q = 0; q < 2; ++q) { const v4u w = cvw[q];
          g[q][0] = gelu_fast(bflo(w.x)); g[q][1] = gelu_fast(bfhi(w.x)); g[q][2] = gelu_fast(bflo(w.y)); g[q][3] = gelu_fast(bfhi(w.y));
          g[q][4] = gelu_fast(bflo(w.z)); g[q][5] = gelu_fast(bfhi(w.z)); g[q][6] = gelu_fast(bflo(w.w)); g[q][7] = gelu_fast(bfhi(w.w));
          ss[q] = 0.f;
#pragma unroll
          for (int i = 0; i < 8; ++i) ss[q] += g[q][i] * g[q][i]; }
      ss[0] = wave_sum(ss[0]); ss[1] = wave_sum(ss[1]);
#pragma unroll
      for (int q = 0; q < 2; ++q) { const float r = 1.0f / sqrtf(ss[q] * (1.0f / 512.f) + EPS);
#pragma unroll
          for (int i = 0; i < 8; ++i) tile[(512 + 8 * lane + i) * 34 + tok[q]] = (bf16)f2bf(g[q][i] * r * sn[i]); } }
#pragma unroll
    for (int q = 0; q < 2; ++q) if (lane < 16) DT[(size_t)row[q] * 16 + lane] = softplus1(bf2f(dtv[q]) + dtb[lane]);
    int roff[2][5]; float mk[2][5];
#pragma unroll
    for (int q = 0; q < 2; ++q)
#pragma unroll
        for (int k = 0; k < 5; ++k) { const int tt = tpos[q] + k - 2; const bool ok = tt >= 0 && tt < SEQ; roff[q][k] = ok ? (k - 2) * NINP : 0; mk[q][k] = ok ? 1.f : 0.f; }
#pragma unroll 1
    for (int i0 = 0; i0 < 16; i0 += 4) {
        unsigned short tp[2][4][5]; float wv[4][5], bv[4];
#pragma unroll
        for (int ii = 0; ii < 4; ++ii) { const int ch = lane + 64 * (i0 + ii); bv[ii] = cb[ch];
#pragma unroll
            for (int k = 0; k < 5; ++k) wv[ii][k] = cw[k * 1024 + ch]; }
#pragma unroll
        for (int q = 0; q < 2; ++q)
#pragma unroll
            for (int ii = 0; ii < 4; ++ii) { const int ch = lane + 64 * (i0 + ii);
                const int col = i0 + ii < 8 ? C_DX + ch : (i0 + ii < 12 ? C_DB + (ch - 512) : C_DC + (ch - 768));
#pragma unroll
                for (int k = 0; k < 5; ++k) tp[q][ii][k] = pr[q][roff[q][k] + col]; }
#pragma unroll
        for (int q = 0; q < 2; ++q)
#pragma unroll
            for (int ii = 0; ii < 4; ++ii) { const int ch = lane + 64 * (i0 + ii);
                float acc = bv[ii];
#pragma unroll
                for (int k = 0; k < 5; ++k) acc += (wv[ii][k] * mk[q][k]) * bf2f(tp[q][ii][k]);
                const float sv = silu_fast(acc);
                XBC[(size_t)row[q] * 1024 + ch] = sv; const bf16 sb = (bf16)f2bf(sv);
                if (i0 + ii < 8) tile[(1024 + ch) * 34 + tok[q]] = sb;
                else { BCB[(size_t)row[q] * 512 + (ch - 512)] = sb; if (i0 + ii < 12) tile[(1536 + ch - 512) * 34 + tok[q]] = sb; } }
    }
}
__device__ __forceinline__ void load_conv_w(const Args& A, int l, int lane, float (&cwv)[16][5], float (&cbv)[16]) {
    const float* cw = ain(A, I_CONVW) + (size_t)l * 5 * 1024; const float* cb = ain(A, I_CONVB) + l * 1024;
#pragma unroll
    for (int i = 0; i < 16; ++i) { cbv[i] = cb[lane + 64 * i];
#pragma unroll
        for (int k = 0; k < 5; ++k) cwv[i][k] = cw[k * 1024 + lane + 64 * i]; }
}
template <bool TILE>
__device__ __forceinline__ void prep_one_row(Frame& F, const Args& A, int l, int row, int lane, LAS bf16* tile, int tok, const float (&cwv)[16][5], const float (&cbv)[16]) {
    prep_one_row_impl<TILE>((const bf16*)(F.ws + WS_P), (bf16*)(F.ws + WS_QA), (bf16*)(F.ws + WS_KA), (bf16*)(F.ws + WS_VA), (bf16*)(F.ws + WS_VNT), (float*)(F.ws + WS_XBC), (float*)(F.ws + WS_DT),
        (bf16*)(F.ws + WS_VTB), (bf16*)(F.ws + WS_VTA), (bf16*)(F.ws + WS_BCB), (bf16*)(F.ws + WS_XT), (bf16*)(F.ws + WS_BT), (const f32x2*)(F.ws + WS_ROPE), ain(A, I_QN) + l * 128, ain(A, I_KN) + l * 128,
        cwv, cbv, ain(A, I_SGUN) + l * 512, ain(A, I_DTB) + l * 16, row, lane, tile, tok);
}
__device__ __forceinline__ void prep_rows(Frame& F, const Args& A, int l) {
    LAS bf16* tile = (LAS bf16*)F.lds;
    for (int t = F.vcu; t < ML / 32; t += F.G) {
        const int r0 = 32 * t;
#pragma unroll 1
        for (int i = 0; i < 4; i += 2)
            prep_two_rows((const bf16*)(F.ws + WS_P), (bf16*)(F.ws + WS_QA), (bf16*)(F.ws + WS_KA), (bf16*)(F.ws + WS_VA), (float*)(F.ws + WS_XBC), (float*)(F.ws + WS_DT), (bf16*)(F.ws + WS_BCB),
                          (const f32x2*)(F.ws + WS_ROPE), ain(A, I_QN) + l * 128, ain(A, I_KN) + l * 128, ain(A, I_CONVW) + (size_t)l * 5 * 1024, ain(A, I_CONVB) + l * 1024, ain(A, I_SGUN) + l * 512, ain(A, I_DTB) + l * 16,
                          r0 + F.wave + 8 * i, r0 + F.wave + 8 * i + 8, F.lane, tile, F.wave + 8 * i, F.wave + 8 * i + 8);
        LDS_WAIT(); __syncthreads();
        const int b = r0 / SEQ, pos0 = CTX + (r0 % SEQ);
        bf16* VTB = (bf16*)(F.ws + WS_VTB); bf16* VNT = (bf16*)(F.ws + WS_VNT); bf16* XT = (bf16*)(F.ws + WS_XT); bf16* BT = (bf16*)(F.ws + WS_BT);
#pragma unroll 2
        for (int k = 0; k < 14; ++k) { const int idx = F.tid + 512 * k, tc = idx >> 2, part = idx & 3;
            const LAS unsigned* sp = (const LAS unsigned*)(tile + tc * 34) + 4 * part;
            v4u o; o.x = sp[0]; o.y = sp[1]; o.z = sp[2]; o.w = sp[3];
            bf16* dst;
            if (tc < 512) dst = VTB + ((size_t)(b * 4 + (tc >> 7)) * 128 + (tc & 127)) * LK + pos0;
            else if (tc < 1024) dst = VNT + ((size_t)(r0 >> 7) * 512 + (tc - 512)) * 128 + (r0 & 127);
            else if (tc < 1536) dst = XT + ((size_t)b * 512 + (tc - 1024)) * LK + pos0;
            else dst = BT + ((size_t)b * 256 + (tc - 1536)) * LK + pos0;
            *(GAS v4u*)(dst + 8 * part) = o; }
        __syncthreads();
    }
    { const int gw = (F.G - 1 - F.vcu) * NWAVES + F.wave, NGW = F.G * NWAVES;
      float cwv[16][5], cbv[16]; load_conv_w(A, l, F.lane, cwv, cbv);
      for (int row = ML + gw; row < MT; row += NGW) prep_one_row<false>(F, A, l, row, F.lane, tile, 0, cwv, cbv); }
}
__device__ __forceinline__ void prep_cum(Frame& F, const Args& A, int l) {
    const int gw = F.vcu * NWAVES + F.wave, NGW = F.G * NWAVES, lane = F.lane;
    const bf16* P = (const bf16*)(F.ws + WS_P); float* CUM = (float*)(F.ws + WS_CUM); float* TOT = (float*)(F.ws + WS_TOT);
    const int off = F.G == 256 ? 56 * NWAVES : 0;
    for (int it = (gw + NGW - off) % NGW; it < 68 * 16; it += NGW) {
        const int rc = it >> 4, j = it & 15, d = j >> 3, rowbase = rc * 128;
        const float a = -expf(ain(A, I_ALOG)[l * 16 + j]), bias = ain(A, I_DTB)[l * 16 + j];
        const float v0 = softplus1(bf2f(P[(size_t)(rowbase + lane) * NINP + C_DT + j]) + bias) * a, v1 = softplus1(bf2f(P[(size_t)(rowbase + 64 + lane) * NINP + C_DT + j]) + bias) * a;
        float s0 = v0, s1 = v1;
#pragma unroll
        for (int o = 1; o < 64; o <<= 1) { const float t0 = lane_get(s0, (lane - o) & 63), t1 = lane_get(s1, (lane - o) & 63); if (lane >= o) { s0 += t0; s1 += t1; } }
        const float tot0 = lane_bcast(s0, 63), total = tot0 + lane_bcast(s1, 63);
        s1 += tot0;
        CUM[(size_t)(rowbase + lane) * 16 + j] = d ? total - (s0 - v0) : s0;
        CUM[(size_t)(rowbase + 64 + lane) * 16 + j] = d ? total - (s1 - v1) : s1;
        if (lane == 0) TOT[rc * 16 + j] = total;
    }
}
template <bool WIN, bool CL>
__device__ __forceinline__ void na_unit(const bf16* __restrict__ qp, const bf16* __restrict__ kb, const bf16* __restrict__ kc, int kcs, const bf16* __restrict__ VT, int vts, const float* __restrict__ rpb_h, int r, int n, float* __restrict__ outp, int lane, const LAS bf16* lk, const LAS bf16* lv, const bf16x8 (&qf)[4]) {
    const int lr = lane & 15, g = lane >> 4;
    constexpr int NTB = WIN ? 16 : 0, NT = NTB + 16;
    const int r0 = min(max(r - 4, 0), 56), bc0 = n == 0 ? 0 : (n == 1 ? 8 : (n == 2 ? 24 : 32));
    const int kperm = 8 * (lr >> 2) + (lr & 3);
    f32x4 acc[NT];
#pragma unroll
    for (int t0 = 0; t0 < NT; t0 += 4) {
        bf16x8 kf[4][4];
#pragma unroll
        for (int tt = 0; tt < 4; ++tt) { const int t = t0 + tt;
            if (CL && t >= NTB) { const LAS bf16* kp = lk + (32 * ((t - NTB) >> 1) + kperm + 4 * (t & 1)) * 136 + 8 * g;
#pragma unroll
                for (int ks = 0; ks < 4; ++ks) kf[tt][ks] = *(const LAS bf16x8*)(kp + 32 * ks); }
            else { const bf16* kp = ((t < NTB) ? kb + (size_t)((r0 + (t >> 1)) * 64 + bc0 + kperm + 4 * (t & 1)) * NINP : kc + (size_t)(32 * ((t - NTB) >> 1) + kperm + 4 * (t & 1)) * kcs) + 8 * g;
#pragma unroll
                for (int ks = 0; ks < 4; ++ks) kf[tt][ks] = *(const GAS bf16x8*)(kp + 32 * ks); } }
#pragma unroll
        for (int tt = 0; tt < 4; ++tt) { f32x4 a = {0.f, 0.f, 0.f, 0.f};
#pragma unroll
            for (int ks = 0; ks < 4; ++ks) a = __builtin_amdgcn_mfma_f32_16x16x32_bf16(kf[tt][ks], qf[ks], a, 0, 0, 0);
            acc[t0 + tt] = a; }
        __builtin_amdgcn_sched_barrier(0);
    }
    const int c = 16 * n + lr, c0 = min(max(c - 8, 0), 48);
    float m = -1e30f;
#pragma unroll
    for (int t = 0; t < NT; ++t)
#pragma unroll
        for (int rr = 0; rr < 4; ++rr) {
            float s = acc[t][rr] * 0.088388347648318440f;
            if (t < NTB) { const int kcol = bc0 + 8 * g + 4 * (t & 1) + rr, krow = r0 + (t >> 1); const bool valid = kcol >= c0 && kcol < c0 + 16;
                const int bi = valid ? (krow - r + 7) * 31 + (kcol - c + 15) : 0; const float bv = rpb_h[bi]; s = valid ? s + bv : -1e30f; }
            acc[t][rr] = s; m = fmaxf(m, s);
        }
    m = fmaxf(m, swz<16>(m)); m = max_x32(m);
    float lsum = 0.f;
    bf16x8 af[NT / 2];
#pragma unroll
    for (int kst = 0; kst < NT / 2; ++kst) {
        float pv[8];
#pragma unroll
        for (int rr = 0; rr < 4; ++rr) { pv[rr] = __expf(acc[2 * kst][rr] - m); pv[4 + rr] = __expf(acc[2 * kst + 1][rr] - m); }
#pragma unroll
        for (int i = 0; i < 8; ++i) lsum += pv[i];
        v4u aw; aw.x = pk2(pv[0], pv[1]); aw.y = pk2(pv[2], pv[3]); aw.z = pk2(pv[4], pv[5]); aw.w = pk2(pv[6], pv[7]);
        af[kst] = __builtin_bit_cast(bf16x8, aw);
    }
    lsum += swz<16>(lsum); lsum = sum_x32(lsum);
    f32x4 o[8];
#pragma unroll
    for (int dt = 0; dt < 8; ++dt) o[dt] = (f32x4){0.f, 0.f, 0.f, 0.f};
#pragma unroll
    for (int k0 = 0; k0 < NT / 2; k0 += 2) {
        v4u vv[2][8];
#pragma unroll
        for (int kk = 0; kk < 2; ++kk) { const int kst = k0 + kk;
            const int posbase = (2 * kst < NTB) ? CTX + (r0 + kst) * 64 + bc0 : 32 * (kst - NTB / 2);
#pragma unroll
            for (int dt = 0; dt < 8; ++dt) {
                if (CL && 2 * kst >= NTB) vv[kk][dt] = *(const LAS v4u*)(lv + (16 * dt + lr) * 264 + posbase + 8 * g);
                else vv[kk][dt] = *(const GAS v4u*)(VT + (size_t)(16 * dt + lr) * vts + posbase + 8 * g); } }
#pragma unroll
        for (int kk = 0; kk < 2; ++kk)
#pragma unroll
            for (int dt = 0; dt < 8; ++dt) o[dt] = __builtin_amdgcn_mfma_f32_16x16x32_bf16(af[k0 + kk], __builtin_bit_cast(bf16x8, vv[kk][dt]), o[dt], 0, 0, 0);
        __builtin_amdgcn_sched_barrier(0);
    }
    float linv[4];
#pragma unroll
    for (int rr = 0; rr < 4; ++rr) linv[rr] = 1.0f / lane_get(lsum, 4 * g + rr);
#pragma unroll
    for (int dt = 0; dt < 8; ++dt)
#pragma unroll
        for (int rr = 0; rr < 4; ++rr) outp[(size_t)(4 * g + rr) * DM + 16 * dt + lr] = o[dt][rr] * linv[rr];
}
__device__ __forceinline__ void rc_geom(int rc, int& b, int& pos0) { if (rc < 64) { b = rc >> 5; pos0 = CTX + (rc & 31) * 128; } else { b = (rc - 64) >> 1; pos0 = ((rc - 64) & 1) * 128; } }
__device__ __forceinline__ bf16x8 scale_frag(bf16x8 x, const LAS float* w) {
    const v4u u = __builtin_bit_cast(v4u, x); const f32x4 w0 = *(const LAS f32x4*)w, w1 = *(const LAS f32x4*)(w + 4);
    v4u o; o.x = pk2(bflo(u.x) * w0.x, bfhi(u.x) * w0.y); o.y = pk2(bflo(u.y) * w0.z, bfhi(u.y) * w0.w); o.z = pk2(bflo(u.z) * w1.x, bfhi(u.z) * w1.y); o.w = pk2(bflo(u.w) * w1.z, bfhi(u.w) * w1.w);
    return __builtin_bit_cast(bf16x8, o);
}
__device__ __forceinline__ void ssd_states_unit(Frame& F, int rc, int j16, LAS float* wt, int lane, const LAS bf16* lb) {
    const int d = j16 >> 3, hh = j16 & 7, g = hh >> 2, lr = lane & 15, gq = lane >> 4, rowbase = rc * 128;
    int b, pos0; rc_geom(rc, b, pos0);
    const float* CUM = (const float*)(F.ws + WS_CUM); const float* DT = (const float*)(F.ws + WS_DT); const float tot = ((const float*)(F.ws + WS_TOT))[rc * 16 + j16];
    wt[lane] = expf(tot - CUM[(size_t)(rowbase + lane) * 16 + j16]) * DT[(size_t)(rowbase + lane) * 16 + j16];
    wt[lane + 64] = expf(tot - CUM[(size_t)(rowbase + 64 + lane) * 16 + j16]) * DT[(size_t)(rowbase + 64 + lane) * 16 + j16];
    LDS_WAIT(); asm volatile("" ::: "memory");
    const bf16* XTp = (const bf16*)(F.ws + WS_XT) + ((size_t)b * 512 + hh * 64 + lr) * LK + pos0 + 8 * gq;
    float* ST = (float*)(F.ws + WS_ST) + (size_t)(rc * 16 + j16) * 8192 + (4 * gq) * 128 + lr;
#pragma unroll 1
    for (int nh = 0; nh < 2; ++nh) {
        f32x4 acc[4][4];
#pragma unroll
        for (int pt = 0; pt < 4; ++pt)
#pragma unroll
            for (int nt = 0; nt < 4; ++nt) acc[pt][nt] = (f32x4){0.f, 0.f, 0.f, 0.f};
#pragma unroll
        for (int ks = 0; ks < 4; ++ks) {
            bf16x8 af[4];
#pragma unroll
            for (int pt = 0; pt < 4; ++pt) af[pt] = scale_frag(*(const GAS bf16x8*)(XTp + (size_t)(16 * pt) * LK + 32 * ks), wt + 32 * ks + 8 * gq);
#pragma unroll
            for (int nt = 0; nt < 4; ++nt) { const bf16x8 bfr = *(const LAS bf16x8*)(lb + (g * 128 + 64 * nh + 16 * nt + lr) * 136 + 32 * ks + 8 * gq);
#pragma unroll
                for (int pt = 0; pt < 4; ++pt) acc[pt][nt] = __builtin_amdgcn_mfma_f32_16x16x32_bf16(af[pt], bfr, acc[pt][nt], 0, 0, 0); }
            if (ks & 1) __builtin_amdgcn_sched_barrier(0);
        }
        float* sp = ST + 64 * nh;
#pragma unroll
        for (int pt = 0; pt < 4; ++pt)
#pragma unroll
            for (int r = 0; r < 4; ++r)
#pragma unroll
                for (int nt = 0; nt < 4; ++nt) sp[(16 * pt + r) * 128 + 16 * nt] = acc[pt][nt][r];
    }
    asm volatile("" ::: "memory");
}
__device__ __forceinline__ void ssd_scan(Frame& F) {
    const float* ST = (const float*)(F.ws + WS_ST); const float* TOT = (const float*)(F.ws + WS_TOT); bf16* HIN = (bf16*)(F.ws + WS_HIN);
    const bool split = DEF_PER_PHASE > 0; if (split && (F.vcu & 1)) return;
    for (int idx = ((split ? F.vcu >> 1 : F.vcu) * NWAVES * 64) + F.tid; idx < 65536; idx += (split ? F.G >> 1 : F.G) * NWAVES * 64) {
        const int n4 = idx & 31, p = (idx >> 5) & 63, hh = (idx >> 11) & 7, d = (idx >> 14) & 1, b = idx >> 15;
        f32x4 run = {0.f, 0.f, 0.f, 0.f};
#pragma unroll 1
        for (int s0 = 0; s0 < 34; s0 += 17) {
            f32x4 sv[17]; float dec[17];
#pragma unroll
            for (int u = 0; u < 17; ++u) { const int step = s0 + u;
                const int rc = d == 0 ? (step < 2 ? 64 + 2 * b + step : 32 * b + step - 2) : (step < 2 ? 64 + 2 * b + 1 - step : 32 * b + 33 - step);
                sv[u] = *(const GAS f32x4*)(ST + (size_t)(rc * 16 + d * 8 + hh) * 8192 + p * 128 + 4 * n4); dec[u] = expf(TOT[rc * 16 + d * 8 + hh]); }
#pragma unroll
            for (int u = 0; u < 17; ++u) { const int step = s0 + u;
                const int rc = d == 0 ? (step < 2 ? 64 + 2 * b + step : 32 * b + step - 2) : (step < 2 ? 64 + 2 * b + 1 - step : 32 * b + 33 - step);
                v2u o; o.x = pk2(run.x, run.y); o.y = pk2(run.z, run.w);
                *(GAS v2u*)(HIN + (size_t)(rc * 16 + d * 8 + hh) * 8192 + p * 128 + 4 * n4) = o;
                run = run * dec[u] + sv[u]; }
        }
    }
}
__device__ __forceinline__ void ssd_out_unit(Frame& F, const Args& A, int l, int rc, int q, LAS float* tab, LAS float* ssq, int hh, int lane, const LAS bf16* lbb) {
    const int g = hh >> 2, lr = lane & 15, gq = lane >> 4, rowbase = rc * 128;
    int b, pos0; rc_geom(rc, b, pos0);
    const float* __restrict__ CUM = (const float*)(F.ws + WS_CUM); const float* __restrict__ DT = (const float*)(F.ws + WS_DT);
    const bf16* __restrict__ BCB = (const bf16*)(F.ws + WS_BCB);
    float tv[8];
#pragma unroll
    for (int k = 0; k < 2; ++k) { const size_t ro = (size_t)(rowbase + lane + 64 * k) * 16; tv[4 * k] = CUM[ro + hh]; tv[4 * k + 1] = CUM[ro + 8 + hh]; tv[4 * k + 2] = DT[ro + hh]; tv[4 * k + 3] = DT[ro + 8 + hh]; }
    bf16x8 cf[2][4];
#pragma unroll
    for (int it = 0; it < 2; ++it)
#pragma unroll
        for (int ks = 0; ks < 4; ++ks) cf[it][ks] = *(const GAS bf16x8*)(BCB + (size_t)(rowbase + 32 * q + 16 * it + lr) * 512 + 256 + g * 128 + 32 * ks + 8 * gq);
    const int jperm = 8 * (lr >> 2) + (lr & 3);
    f32x4 S[8][2];
#pragma unroll
    for (int jh = 0; jh < 2; ++jh) {
        bf16x8 bfr[4][4];
#pragma unroll
        for (int jj = 0; jj < 4; ++jj)
#pragma unroll
            for (int ks = 0; ks < 4; ++ks) bfr[jj][ks] = *(const LAS bf16x8*)(lbb + (32 * ((4 * jh + jj) >> 1) + jperm + 4 * (jj & 1)) * 264 + g * 128 + 32 * ks + 8 * gq);
        if (jh == 0) {
#pragma unroll
            for (int k = 0; k < 2; ++k) { const int t = lane + 64 * k; tab[t] = tv[4 * k]; tab[128 + t] = tv[4 * k + 1]; tab[256 + t] = tv[4 * k + 2]; tab[384 + t] = tv[4 * k + 3]; }
        }
#pragma unroll
        for (int jj = 0; jj < 4; ++jj) { f32x4 a0 = {0.f, 0.f, 0.f, 0.f}, a1 = a0;
#pragma unroll
            for (int ks = 0; ks < 4; ++ks) { a0 = __builtin_amdgcn_mfma_f32_16x16x32_bf16(bfr[jj][ks], cf[0][ks], a0, 0, 0, 0); a1 = __builtin_amdgcn_mfma_f32_16x16x32_bf16(bfr[jj][ks], cf[1][ks], a1, 0, 0, 0); }
            S[4 * jh + jj][0] = a0; S[4 * jh + jj][1] = a1; }
        __builtin_amdgcn_sched_barrier(0);
    }
    LDS_WAIT(); asm volatile("" ::: "memory");
    bf16x8 af[4][2];
#pragma unroll
    for (int it = 0; it < 2; ++it) {
        const int i = 32 * q + 16 * it + lr; const float c0i = tab[i], c1i = tab[128 + i];
#pragma unroll
        for (int kst = 0; kst < 4; ++kst) { float mv[8];
#pragma unroll
            for (int h2 = 0; h2 < 2; ++h2)
#pragma unroll
                for (int r = 0; r < 4; ++r) { const int jt = 2 * kst + h2, j = 32 * kst + 8 * gq + 4 * h2 + r;
                    const bool le = j <= i; const float arg = le ? c0i - tab[j] : c1i - tab[128 + j]; const float dts = le ? tab[256 + j] : tab[384 + j];
                    float fct = __expf(arg) * dts; if (j == i) fct += tab[384 + j];
                    mv[4 * h2 + r] = S[jt][it][r] * fct; }
            v4u aw; aw.x = pk2(mv[0], mv[1]); aw.y = pk2(mv[2], mv[3]); aw.z = pk2(mv[4], mv[5]); aw.w = pk2(mv[6], mv[7]); af[kst][it] = __builtin_bit_cast(bf16x8, aw); }
    }
    const bf16* __restrict__ XTp = (const bf16*)(F.ws + WS_XT) + ((size_t)b * 512 + hh * 64 + lr) * LK + pos0 + 8 * gq;
    v4u xfr[4][4];
#pragma unroll
    for (int kst = 0; kst < 4; ++kst)
#pragma unroll
        for (int pt = 0; pt < 4; ++pt) xfr[kst][pt] = *(const GAS v4u*)(XTp + (size_t)(16 * pt) * LK + 32 * kst);
    f32x4 y[2][4];
#pragma unroll
    for (int it = 0; it < 2; ++it)
#pragma unroll
        for (int pt = 0; pt < 4; ++pt) y[it][pt] = (f32x4){0.f, 0.f, 0.f, 0.f};
#pragma unroll
    for (int kst = 0; kst < 4; ++kst)
#pragma unroll
        for (int pt = 0; pt < 4; ++pt) { const bf16x8 bfr = __builtin_bit_cast(bf16x8, xfr[kst][pt]);
            y[0][pt] = __builtin_amdgcn_mfma_f32_16x16x32_bf16(af[kst][0], bfr, y[0][pt], 0, 0, 0); y[1][pt] = __builtin_amdgcn_mfma_f32_16x16x32_bf16(af[kst][1], bfr, y[1][pt], 0, 0, 0); }
    __builtin_amdgcn_sched_barrier(0);
#pragma unroll
    for (int d = 0; d < 2; ++d) {
        const bf16* __restrict__ HP = (const bf16*)(F.ws + WS_HIN) + (size_t)(rc * 16 + d * 8 + hh) * 8192 + (size_t)lr * 128 + 8 * gq;
        bf16x8 hf[4][4];
#pragma unroll
        for (int ks = 0; ks < 4; ++ks)
#pragma unroll
            for (int pt = 0; pt < 4; ++pt) hf[ks][pt] = *(const GAS bf16x8*)(HP + (size_t)(16 * pt) * 128 + 32 * ks);
        f32x4 t[2][4];
#pragma unroll
        for (int it = 0; it < 2; ++it)
#pragma unroll
            for (int pt = 0; pt < 4; ++pt) t[it][pt] = (f32x4){0.f, 0.f, 0.f, 0.f};
#pragma unroll
        for (int ks = 0; ks < 4; ++ks)
#pragma unroll
            for (int pt = 0; pt < 4; ++pt) { t[0][pt] = __builtin_amdgcn_mfma_f32_16x16x32_bf16(cf[0][ks], hf[ks][pt], t[0][pt], 0, 0, 0); t[1][pt] = __builtin_amdgcn_mfma_f32_16x16x32_bf16(cf[1][ks], hf[ks][pt], t[1][pt], 0, 0, 0); }
#pragma unroll
        for (int it = 0; it < 2; ++it)
#pragma unroll
            for (int r = 0; r < 4; ++r) { const float e = __expf(tab[128 * d + 32 * q + 16 * it + 4 * gq + r]);
#pragma unroll
                for (int pt = 0; pt < 4; ++pt) y[it][pt][r] += e * t[it][pt][r]; }
        __builtin_amdgcn_sched_barrier(0);
    }
    const float skip = ain(A, I_DSKIP)[l * 16 + hh] + ain(A, I_DSKIP)[l * 16 + 8 + hh];
    const float* __restrict__ XBC = (const float*)(F.ws + WS_XBC); const bf16* __restrict__ P = (const bf16*)(F.ws + WS_P);
    float xv[2][4][4]; unsigned short zv[2][4][4];
#pragma unroll
    for (int it = 0; it < 2; ++it)
#pragma unroll
        for (int r = 0; r < 4; ++r) { const size_t row = (size_t)(rowbase + 32 * q + 16 * it + 4 * gq + r);
#pragma unroll
            for (int pt = 0; pt < 4; ++pt) { const int ch = hh * 64 + 16 * pt + lr; xv[it][r][pt] = XBC[row * 1024 + ch]; zv[it][r][pt] = P[row * NINP + C_DZ + ch]; } }
#pragma unroll
    for (int it = 0; it < 2; ++it)
#pragma unroll
        for (int r = 0; r < 4; ++r) { float s = 0.f;
#pragma unroll
            for (int pt = 0; pt < 4; ++pt) { const float v = (y[it][pt][r] + skip * xv[it][r][pt]) * silu_fast(bf2f(zv[it][r][pt])); y[it][pt][r] = v; s += v * v; }
            s += swz<1>(s); s += swz<2>(s); s += swz<4>(s); s += swz<8>(s);
            if (lr == 0) ssq[hh * 32 + 16 * it + 4 * gq + r] = s; }
    LDS_WAIT(); __syncthreads();
    const float* __restrict__ on = ain(A, I_ONORM) + l * DM + 1536; bf16* __restrict__ OB = (bf16*)(F.ws + WS_OB);
    float gn[4];
#pragma unroll
    for (int pt = 0; pt < 4; ++pt) gn[pt] = on[hh * 64 + 16 * pt + lr];
#pragma unroll
    for (int it = 0; it < 2; ++it)
#pragma unroll
        for (int r = 0; r < 4; ++r) { const int ti = 16 * it + 4 * gq + r; float s = 0.f;
#pragma unroll
            for (int w = 0; w < 8; ++w) s += ssq[w * 32 + ti];
            const float rn = 1.0f / sqrtf(s * (1.0f / 512.f) + EPS); const size_t row = (size_t)(rowbase + 32 * q + ti);
#pragma unroll
            for (int pt = 0; pt < 4; ++pt) { const int ch = hh * 64 + 16 * pt + lr; OB[row * DM + 1536 + ch] = (bf16)f2bf(y[it][pt][r] * rn * gn[pt]); } }
    __syncthreads();
}
__device__ __forceinline__ void mixa_d1(Frame& F) {
    const int gw = F.vcu * NWAVES + F.wave, NGW = F.G * NWAVES, lane = F.lane;
    LAS float* wt = (LAS float*)(F.lds + 69632 + F.wave * 512);
    LAS bf16* lb = (LAS bf16*)F.lds;
    for (int it0 = F.vcu * NWAVES; it0 < 68 * 16; it0 += NGW) {
        const int rc = it0 >> 4; int b, pos0; rc_geom(rc, b, pos0);
        __syncthreads();
        { const bf16* bsrc = (const bf16*)(F.ws + WS_BT) + (size_t)b * 256 * LK + pos0;
#pragma unroll
          for (int k = 0; k < 8; ++k) { const int idx = F.tid + 512 * k, row = idx >> 4, part = idx & 15;
              *(LAS v4u*)(lb + row * 136 + 8 * part) = *(const GAS v4u*)(bsrc + (size_t)row * LK + 8 * part); } }
        LDS_WAIT(); __syncthreads();
        const int it = it0 + F.wave; int ln = lane; asm volatile("" : "+v"(ln)); ssd_states_unit(F, it >> 4, it & 15, wt, ln, lb);
    }
}
__device__ __forceinline__ void mixa_ctx(Frame& F) {
    const bf16* P = (const bf16*)(F.ws + WS_P); const bf16* QA = (const bf16*)(F.ws + WS_QA); const bf16* KA = (const bf16*)(F.ws + WS_KA);
    float* OM = (float*)(F.ws + WS_OM);
    LAS bf16* lk = (LAS bf16*)F.lds; LAS bf16* lv = (LAS bf16*)(F.lds + 69632);
    for (int gi = F.G - 1 - F.vcu; gi < 32; gi += F.G) {
        const int mixer = gi >> 4, b = (gi >> 3) & 1, h = (gi >> 1) & 3, qt = (gi & 1) * 8 + F.wave;
        const bf16* kc = mixer == 0 ? KA + (size_t)b * LK * 256 + (h >> 1) * 128 : P + (size_t)(ML + b * CTX) * NINP + C_BK + h * 128; const int kcs = mixer == 0 ? 256 : NINP;
        const bf16* vt = mixer == 0 ? (const bf16*)(F.ws + WS_VTA) + (size_t)(b * 2 + (h >> 1)) * 128 * 256 : (const bf16*)(F.ws + WS_VTB) + (size_t)(b * 4 + h) * 128 * LK; const int vts = mixer == 0 ? 256 : LK;
        __syncthreads();
#pragma unroll
        for (int k = 0; k < 8; ++k) { const int idx = F.tid + 512 * k, row = idx >> 4, part = idx & 15;
            *(LAS v4u*)(lk + row * 136 + 8 * part) = *(const GAS v4u*)(kc + (size_t)row * kcs + 8 * part); }
#pragma unroll
        for (int k = 0; k < 8; ++k) { const int idx = F.tid + 512 * k, row = idx >> 5, part = idx & 31;
            *(LAS v4u*)(lv + row * 264 + 8 * part) = *(const GAS v4u*)(vt + (size_t)row * vts + 8 * part); }
        LDS_WAIT(); __syncthreads();
        int ln = F.lane; asm volatile("" : "+v"(ln));
        const int row0 = ML + b * CTX + 16 * qt, lr = ln & 15;
        const bf16* qp = mixer == 0 ? QA + (size_t)(row0 + lr) * 512 + h * 128 : P + (size_t)(row0 + lr) * NINP + C_BQ + h * 128;
        bf16x8 qf[4];
#pragma unroll
        for (int ks = 0; ks < 4; ++ks) qf[ks] = *(const GAS bf16x8*)(qp + 8 * (ln >> 4) + 32 * ks);
        na_unit<false, true>(qp, nullptr, nullptr, 0, nullptr, 0, nullptr, 0, 0, OM + (size_t)row0 * DM + (mixer ? 512 : 0) + h * 128, ln, lk, lv, qf);
        __syncthreads();
    }
}
__device__ __forceinline__ void mixa_na(Frame& F, const Args& A, int l) {
    const bf16* P = (const bf16*)(F.ws + WS_P); float* OM = (float*)(F.ws + WS_OM);
    LAS bf16* lk = (LAS bf16*)F.lds; LAS bf16* lv = (LAS bf16*)(F.lds + 69632);
    for (int grp = F.vcu; grp < 256; grp += F.G) {
        const int b = grp >> 7, h = (grp >> 5) & 3;
        const int u = grp * 8 + F.wave, r = (u >> 2) & 63, n = u & 3; int ln = F.lane; asm volatile("" : "+v"(ln));
        const int row0 = b * SEQ + r * 64 + 16 * n;
        bf16x8 qf[4];
#pragma unroll
        for (int ks = 0; ks < 4; ++ks) qf[ks] = *(const GAS bf16x8*)(P + (size_t)(row0 + (ln & 15)) * NINP + C_BQ + h * 128 + 8 * (ln >> 4) + 32 * ks);
        __syncthreads();
        { const bf16* kc = P + (size_t)(ML + b * CTX) * NINP + C_BK + h * 128; const bf16* vt = (const bf16*)(F.ws + WS_VTB) + (size_t)(b * 4 + h) * 128 * LK;
          v4u tk[8], tv[8];
#pragma unroll
          for (int k = 0; k < 8; ++k) { const int idx = F.tid + 512 * k; tk[k] = *(const GAS v4u*)(kc + (size_t)(idx >> 4) * NINP + 8 * (idx & 15)); }
#pragma unroll
          for (int k = 0; k < 8; ++k) { const int idx = F.tid + 512 * k; tv[k] = *(const GAS v4u*)(vt + (size_t)(idx >> 5) * LK + 8 * (idx & 31)); }
#pragma unroll
          for (int k = 0; k < 8; ++k) { const int idx = F.tid + 512 * k; *(LAS v4u*)(lk + (idx >> 4) * 136 + 8 * (idx & 15)) = tk[k]; }
#pragma unroll
          for (int k = 0; k < 8; ++k) { const int idx = F.tid + 512 * k; *(LAS v4u*)(lv + (idx >> 5) * 264 + 8 * (idx & 31)) = tv[k]; } }
        LDS_WAIT(); __syncthreads();
        na_unit<true, true>(P + (size_t)(row0 + (ln & 15)) * NINP + C_BQ + h * 128, P + (size_t)(b * SEQ) * NINP + C_BK + h * 128, nullptr, 0,
                            (const bf16*)(F.ws + WS_VTB) + (size_t)(b * 4 + h) * 128 * LK, LK, ain(A, I_RPB) + (size_t)(l * 4 + h) * 15 * 31, r, n, OM + (size_t)row0 * DM + 512 + h * 128, ln, lk, lv, qf);
        __syncthreads();
    }
}
__device__ __forceinline__ void mixa_sgu(Frame& F, const Args& A, int l) {
    const bf16* P = (const bf16*)(F.ws + WS_P); float* OM = (float*)(F.ws + WS_OM);
    const int nunit = (l == 0 ? 68 : 64) * 4;
    for (int u = F.vcu; u < nunit; u += F.G) {
        int ln = F.lane; asm volatile("" : "+v"(ln));
        const int rc = u >> 2, g = u & 3, lr = ln & 15, gq = ln >> 4, w = F.wave;
        const bf16* Wp = (const bf16*)(F.ws + WS_SGW) + ((size_t)(l * 4 + g) * 128 + 16 * w + lr) * 128 + 8 * gq;
        bf16x8 af[4];
#pragma unroll
        for (int ks = 0; ks < 4; ++ks) af[ks] = *(const GAS bf16x8*)(Wp + 32 * ks);
        LAS bf16* lvt = (LAS bf16*)F.lds;
        __syncthreads();
        { const bf16* vsrc = (const bf16*)(F.ws + WS_VNT) + ((size_t)rc * 512 + g * 128) * 128;
#pragma unroll
          for (int k = 0; k < 4; ++k) { const int idx = F.tid + 512 * k, row = idx >> 4, part = idx & 15;
              *(LAS v4u*)(lvt + row * 136 + 8 * part) = *(const GAS v4u*)(vsrc + (size_t)row * 128 + 8 * part); } }
        const float sbl = *(const GAS float*)(ain(A, I_SGUB) + (l * 4 + g) * 128 + 16 * w + lr);
        v2u uq[8];
#pragma unroll
        for (int ct = 0; ct < 8; ++ct) uq[ct] = *(const GAS v2u*)(P + (size_t)(rc * 128 + 16 * w + lr) * NINP + C_CU + g * 128 + 16 * ct + 4 * gq);
        LDS_WAIT(); __syncthreads();
#pragma unroll
        for (int ch = 0; ch < 2; ++ch) {
            bf16x8 bfr[4][4];
#pragma unroll
            for (int cc = 0; cc < 4; ++cc)
#pragma unroll
                for (int ks = 0; ks < 4; ++ks) bfr[cc][ks] = *(const LAS bf16x8*)(lvt + (16 * (4 * ch + cc) + lr) * 136 + 32 * ks + 8 * gq);
#pragma unroll
            for (int cc = 0; cc < 4; ++cc) { const int ct = 4 * ch + cc;
                f32x4 acc = {0.f, 0.f, 0.f, 0.f};
#pragma unroll
                for (int ks = 0; ks < 4; ++ks) acc = __builtin_amdgcn_mfma_f32_16x16x32_bf16(bfr[cc][ks], af[ks], acc, 0, 0, 0);
                f32x4 o; o.x = gelu_fast(bflo(uq[ct].x)) * (acc[0] + sbl); o.y = gelu_fast(bfhi(uq[ct].x)) * (acc[1] + sbl); o.z = gelu_fast(bflo(uq[ct].y)) * (acc[2] + sbl); o.w = gelu_fast(bfhi(uq[ct].y)) * (acc[3] + sbl);
                *(GAS f32x4*)(OM + (size_t)(rc * 128 + 16 * w + lr) * DM + 1024 + g * 128 + 16 * ct + 4 * gq) = o; }
            __builtin_amdgcn_sched_barrier(0);
        }
    }
}
__device__ __forceinline__ void mixb_attn(Frame& F, const Args& A, int l) {
    const bf16* QA = (const bf16*)(F.ws + WS_QA); const bf16* KA = (const bf16*)(F.ws + WS_KA); const bf16* VA = (const bf16*)(F.ws + WS_VA);
    float* OM = (float*)(F.ws + WS_OM); float* AST = (float*)(F.ws + WS_AST);
    if (DEF_PER_PHASE > 0) {
        const int role = F.vcu & 1, idx = F.vcu >> 1, nhalf = F.G >> 1;
        if (role == 0) {
            for (int u = idx; u < 128; u += nhalf) {
                const int b = u >> 6, h = (u >> 4) & 3, qb = u & 15;
                const size_t row0 = (size_t)b * SEQ + qb * 256;
                att::attn_dense_body<att::bf16, 2048>((const att::bf16*)QA + row0 * 512 + h * 128, (const att::bf16*)KA + (size_t)b * LK * 256 + (h >> 1) * 128, (const att::bf16*)VA + (size_t)b * LK * 256 + (h >> 1) * 128,
                                                      OM + row0 * DM + h * 128, LK, (char*)F.ldsg, F.wave, AST + row0 * 8 + h * 2);
                __syncthreads();
            }
        } else cvt8_deferred(F, A, l * DEF_PER_PHASE, DEF_PER_PHASE, idx * NWAVES + F.wave, nhalf * NWAVES);
    } else {
        float* OM2 = (float*)(F.ws + WS_OM2);
        for (int u = F.vcu; u < 256; u += F.G) {
            const int b = u >> 7, h = (u >> 5) & 3, half = (u >> 4) & 1, qb = u & 15;
            const size_t row0 = (size_t)b * SEQ + qb * 256, k0 = (size_t)b * LK + half * (LK / 2);
            float* Ob = half ? OM2 + row0 * 512 + h * 128 : OM + row0 * DM + h * 128;
            if (half) att::attn_dense_body<att::bf16, 512>((const att::bf16*)QA + row0 * 512 + h * 128, (const att::bf16*)KA + k0 * 256 + (h >> 1) * 128, (const att::bf16*)VA + k0 * 256 + (h >> 1) * 128,
                                                       Ob, LK / 2, (char*)F.ldsg, F.wave, AST + ((size_t)ML + row0) * 8 + h * 2);
            else att::attn_dense_body<att::bf16, 2048>((const att::bf16*)QA + row0 * 512 + h * 128, (const att::bf16*)KA + k0 * 256 + (h >> 1) * 128, (const att::bf16*)VA + k0 * 256 + (h >> 1) * 128,
                                                       Ob, LK / 2, (char*)F.ldsg, F.wave, AST + row0 * 8 + h * 2);
            __syncthreads();
        }
    }
}
__device__ __forceinline__ void merge_d3(Frame& F, const Args& A, int l) {
    LAS float* tab = (LAS float*)(F.lds + F.wave * 2048); LAS float* ssq = (LAS float*)(F.lds + 16384);
    const int nunit = (l == 0 ? 68 : 64) * 4;
    LAS bf16* lbb = (LAS bf16*)(F.lds + 20480);
    for (int u = F.vcu; u < nunit; u += F.G) {
        __syncthreads();
        { const bf16* bsrc = (const bf16*)(F.ws + WS_BCB) + (size_t)((u >> 2) * 128) * 512;
#pragma unroll
          for (int k = 0; k < 8; ++k) { const int idx = F.tid + 512 * k, row = idx >> 5, part = idx & 31;
              *(LAS v4u*)(lbb + row * 264 + 8 * part) = *(const GAS v4u*)(bsrc + (size_t)row * 512 + 8 * part); } }
        LDS_WAIT(); __syncthreads();
        int ln = F.lane; asm volatile("" : "+v"(ln)); ssd_out_unit(F, A, l, u >> 2, u & 3, tab, ssq, F.wave, ln, lbb); }
}
__device__ __forceinline__ void merge_stream(Frame& F, const Args& A) {
    if (F.G == 256 && F.vcu >= 16) cvt8_deferred(F, A, OFF_MG0, MG0_ITEMS, (F.vcu - 16) * NWAVES + F.wave, 240 * NWAVES);
}
__device__ __forceinline__ void merge_abc(Frame& F, const Args& A, int l) {
    const int gw = F.vcu * NWAVES + F.wave, NGW = F.G * NWAVES, lane = F.lane;
    const float* OM = (const float*)(F.ws + WS_OM);
    bf16* OB = (bf16*)(F.ws + WS_OB);
    const float* on = ain(A, I_ONORM) + l * DM;
    const int nrow = l == 0 ? MT : ML;
    f32x4 gn[3][2];
#pragma unroll
    for (int g = 0; g < 3; ++g) { gn[g][0] = *(const GAS f32x4*)(on + g * 512 + 8 * lane); gn[g][1] = *(const GAS f32x4*)(on + g * 512 + 8 * lane + 4); }
    for (int row = gw; row < nrow; row += NGW) {
        f32x4 va[3], vc[3];
#pragma unroll
        for (int g = 0; g < 3; ++g) { va[g] = *(const GAS f32x4*)(OM + (size_t)row * DM + g * 512 + 8 * lane); vc[g] = *(const GAS f32x4*)(OM + (size_t)row * DM + g * 512 + 8 * lane + 4); }
        if (DEF_PER_PHASE == 0 && row < ML) {
            const float* AST = (const float*)(F.ws + WS_AST); const float* OM2 = (const float*)(F.ws + WS_OM2);
            const f32x2 s1 = *(const GAS f32x2*)(AST + (size_t)row * 8 + (lane >> 4) * 2), s2 = *(const GAS f32x2*)(AST + ((size_t)ML + row) * 8 + (lane >> 4) * 2);
            const float mm = fmaxf(s1.x, s2.x); constexpr float CC = 0.088388347648318440f * 1.4426950408889634f;
            const float w1 = s1.y * exp2f((s1.x - mm) * CC), w2 = s2.y * exp2f((s2.x - mm) * CC), inv = 1.0f / (w1 + w2);
            const f32x4 a2 = *(const GAS f32x4*)(OM2 + (size_t)row * 512 + 8 * lane), c2 = *(const GAS f32x4*)(OM2 + (size_t)row * 512 + 8 * lane + 4);
            va[0] = (va[0] * w1 + a2 * w2) * inv; vc[0] = (vc[0] * w1 + c2 * w2) * inv;
        }
        float ss[3];
#pragma unroll
        for (int g = 0; g < 3; ++g) ss[g] = (va[g].x * va[g].x + va[g].y * va[g].y) + (va[g].z * va[g].z + va[g].w * va[g].w) + (vc[g].x * vc[g].x + vc[g].y * vc[g].y) + (vc[g].z * vc[g].z + vc[g].w * vc[g].w);
#pragma unroll
        for (int g = 0; g < 3; ++g) ss[g] = wave_sum(ss[g]);
#pragma unroll
        for (int g = 0; g < 3; ++g) { const float r = 1.0f / sqrtf(ss[g] * (1.0f / 512.f) + EPS);
            const f32x4 x = va[g] * r * gn[g][0], y = vc[g] * r * gn[g][1];
            v4u o; o.x = pk2(x.x, x.y); o.y = pk2(x.z, x.w); o.z = pk2(y.x, y.y); o.w = pk2(y.z, y.w);
            *(GAS v4u*)(OB + (size_t)row * DM + g * 512 + 8 * lane) = o; }
    }
}
__device__ __forceinline__ void phase_n2(Frame& F, const Args& A, int l) {
    const int gw = F.vcu * NWAVES + F.wave, NGW = F.G * NWAVES, lane = F.lane;
    const float* mod = (const float*)(F.ws + WS_MOD) + (size_t)l * 3 * MODW;
    const float* XA = (const float*)(F.ws + WS_XA);
    bf16* H = (bf16*)(F.ws + WS_H);
    const int nrow = l == 0 ? MT : ML;
    for (int row = gw; row < nrow; row += NGW) {
        const float* m = mod + row_vec(row) * MODW; f32x4 y[8];
        if (row >= ML) {
            f32x4 v[8];
            ctx_row_from_parts<4>(ain(A, I_CTX) + (size_t)(row - ML) * DM, m + 2 * DM, (const float*)(F.ws + WS_PARTW), row - ML, lane, v);
            float* xo = (float*)(F.ws + WS_XA) + (size_t)row * DM;
#pragma unroll
            for (int j = 0; j < 8; ++j) *(GAS f32x4*)(xo + 4 * lane + 256 * j) = v[j];
            norm_mod_vals(v, ain(A, I_NFFN) + l * DM, m + 3 * DM, m + 4 * DM, H + (size_t)row * DM, lane, y);
        } else norm_mod_row(XA + (size_t)row * DM, ain(A, I_NFFN) + l * DM, m + 3 * DM, m + 4 * DM, H + (size_t)row * DM, lane, y);
    }
}
__device__ __forceinline__ void phase_n2_route(Frame& F, const Args& A) {
    const int gw = F.vcu * NWAVES + F.wave, NGW = F.G * NWAVES, lane = F.lane;
    const float* mod = (const float*)(F.ws + WS_MOD) + (size_t)3 * MODW;
    const float* XA = (const float*)(F.ws + WS_XA);
    bf16* H = (bf16*)(F.ws + WS_H);
    int* route = (int*)(F.ws + WS_ROUTE);
    LAS f32x4* rl = (LAS f32x4*)F.lds;
    for (int i = F.tid; i < 4096; i += NWAVES * 64) rl[i] = *(const GAS f32x4*)(ain(A, I_ROUTER) + 4 * i);
    LAS int* sel = (LAS int*)(F.lds + 65536);
    __syncthreads();
#pragma unroll 1
    for (int k = 0; k < 4; ++k) {
        const int row = gw + k * NGW; int ln = lane; asm volatile("" : "+v"(ln));
        const float* m = mod + row_vec(row) * MODW; f32x4 y[8];
        norm_mod_row(XA + (size_t)row * DM, ain(A, I_NFFN) + DM, m + 3 * DM, m + 4 * DM, H + (size_t)row * DM, ln, y);
        float lg[8];
#pragma unroll
        for (int e = 0; e < 8; ++e) lg[e] = 0.f;
#pragma unroll
        for (int j = 0; j < 8; ++j) {
#pragma unroll
            for (int i = 0; i < 4; ++i) { const int kk = 4 * ln + 256 * j + i;
                const f32x4 r0 = rl[2 * kk], r1 = rl[2 * kk + 1];
                const float yy = y[j][i];
                lg[0] += yy * r0.x; lg[1] += yy * r0.y; lg[2] += yy * r0.z; lg[3] += yy * r0.w; lg[4] += yy * r1.x; lg[5] += yy * r1.y; lg[6] += yy * r1.z; lg[7] += yy * r1.w; }
            __builtin_amdgcn_sched_barrier(0);
        }
#pragma unroll
        for (int e = 0; e < 8; ++e) lg[e] = wave_sum(lg[e]);
        int e0 = 0; float v0 = lg[0];
#pragma unroll
        for (int e = 1; e < 8; ++e) if (lg[e] > v0) { v0 = lg[e]; e0 = e; }
        int e1 = -1; float v1 = -3.4e38f;
#pragma unroll
        for (int e = 0; e < 8; ++e) if (e != e0 && lg[e] > v1) { v1 = lg[e]; e1 = e; }
        const float ex = expf(v1 - v0), w0 = 1.0f / (1.0f + ex), w1 = ex / (1.0f + ex);
        if (ln == 0) { LAS int* s = sel + (F.wave * 4 + k) * 4; s[0] = e0; s[1] = e1; s[2] = __builtin_bit_cast(int, w0); s[3] = __builtin_bit_cast(int, w1); }
    }
    LDS_WAIT(); __syncthreads();
    if (F.wave == 0) {
        const bool valid = lane < 32;
        const int e0 = valid ? sel[lane * 4] : -1, e1 = valid ? sel[lane * 4 + 1] : -1;
        const unsigned long long lt = (1ull << lane) - 1ull;
        int cnt_mine = 0, r0 = 0, r1 = 0;
#pragma unroll
        for (int e = 0; e < 8; ++e) { const unsigned long long b0 = __ballot(e0 == e), b1 = __ballot(e1 == e);
            const int c0 = __popcll(b0), c = c0 + __popcll(b1);
            if (lane == e) cnt_mine = c;
            if (e0 == e) r0 = __popcll(b0 & lt);
            if (e1 == e) r1 = c0 + __popcll(b1 & lt); }
        int base = 0;
        if (lane < 8) base = (int)__hip_atomic_fetch_add((unsigned*)(F.ctl + CW_CNT + 64 * lane), (unsigned)cnt_mine, RLX_AGENT);
        int b0v = 0, b1v = 0;
#pragma unroll
        for (int e = 0; e < 8; ++e) { const int be = __builtin_amdgcn_readlane(base, e); if (e0 == e) b0v = be; if (e1 == e) b1v = be; }
        if (valid) { const int row = (F.vcu * NWAVES + (lane >> 2)) + (lane & 3) * NGW;
            int* rr = route + (size_t)row * 8;
            rr[0] = e0; rr[1] = e1; rr[2] = b0v + r0; rr[3] = b1v + r1; rr[4] = sel[lane * 4 + 2]; rr[5] = sel[lane * 4 + 3]; }
    }
}
__device__ __forceinline__ void moe_tiles(Frame& F) {
    __syncthreads();
    if (F.tid == 0) { unsigned acc = 0;
        for (int e = 0; e < 8; ++e) { F.MISC[16 + e] = acc; const unsigned c = __hip_atomic_load((unsigned*)(F.ctl + CW_CNT + 64 * e), RLX_AGENT); acc += (c + 255u) >> 8; }
        F.MISC[24] = acc; }
    __syncthreads();
}
__device__ __forceinline__ void phase_gather(Frame& F) {
    const int gw = F.vcu * NWAVES + F.wave, NGW = F.G * NWAVES, lane = F.lane;
    moe_tiles(F);
    const bf16* H = (const bf16*)(F.ws + WS_H); bf16* HS = (bf16*)(F.ws + WS_HS);
    int* route = (int*)(F.ws + WS_ROUTE);
    for (int it = gw; it < ML * 2; it += NGW) {
        const int tok = it >> 1, k = it & 1;
        const int e = route[(size_t)tok * 8 + k], pos = route[(size_t)tok * 8 + 2 + k];
        const int slot = (int)F.MISC[16 + e] * 256 + pos;
        const v4u* src = (const v4u*)(H + (size_t)tok * DM) + 4 * lane;
        v4u o[2];
#pragma unroll
        for (int j = 0; j < 2; ++j) { const v4u a = src[2 * j], b2 = src[2 * j + 1];
            o[j].x = pg8::pack_fp8x4(bflo(a.x) * 4.f, bfhi(a.x) * 4.f, bflo(a.y) * 4.f, bfhi(a.y) * 4.f); o[j].y = pg8::pack_fp8x4(bflo(a.z) * 4.f, bfhi(a.z) * 4.f, bflo(a.w) * 4.f, bfhi(a.w) * 4.f);
            o[j].z = pg8::pack_fp8x4(bflo(b2.x) * 4.f, bfhi(b2.x) * 4.f, bflo(b2.y) * 4.f, bfhi(b2.y) * 4.f); o[j].w = pg8::pack_fp8x4(bflo(b2.z) * 4.f, bfhi(b2.z) * 4.f, bflo(b2.w) * 4.f, bfhi(b2.w) * 4.f); }
        v4u* dst = (v4u*)((unsigned char*)HS + (size_t)slot * DM) + 2 * lane;
        dst[0] = o[0]; dst[1] = o[1];
        if (lane == 0) route[(size_t)tok * 8 + 6 + k] = slot;
    }
}
__device__ __forceinline__ void phase_final(Frame& F, const Args& A) {
    const int gw = F.vcu * NWAVES + F.wave, NGW = F.G * NWAVES, lane = F.lane;
    const float* mod = (const float*)(F.ws + WS_MOD) + (size_t)1 * 3 * MODW;
    const float* XA = (const float*)(F.ws + WS_XA); const bf16* YM = (const bf16*)(F.ws + WS_YM);
    const int* route = (const int*)(F.ws + WS_ROUTE);
    const unsigned* tfb = (const unsigned*)(F.ctl + CW_TAIL);
    const float* YMP = (const float*)(F.ws + WS_YMP);
    f32x4 gn[8];
#pragma unroll
    for (int j = 0; j < 8; ++j) gn[j] = *(const GAS f32x4*)(ain(A, I_FNORM) + 4 * lane + 256 * j);
    for (int row = gw; row < ML; row += NGW) {
        const v4u rq = *(const GAS v4u*)(route + (size_t)row * 8 + 4);
        float w0 = __builtin_bit_cast(float, rq.x), w1 = __builtin_bit_cast(float, rq.y);
        asm volatile("v_mov_b32 %0, %1" : "=v"(w1) : "v"(rq.y));
        const int sl0 = __builtin_amdgcn_readfirstlane((int)rq.z), sl1 = __builtin_amdgcn_readfirstlane((int)rq.w);
        const unsigned fl = *(const GAS unsigned*)(tfb + (((lane & 8) ? sl1 : sl0) >> 8) * 8 + (lane & 7));
        const bf16* y0 = YM + (size_t)sl0 * DM; const bf16* y1 = YM + (size_t)sl1 * DM;
        const float* g2 = mod + row_vec(row) * MODW + 5 * DM;
        f32x4 v[8], g[8]; v2u ta[8], tb[8];
#pragma unroll
        for (int j = 0; j < 8; ++j) { const int c = 4 * lane + 256 * j;
            v[j] = *(const GAS f32x4*)(XA + (size_t)row * DM + c); g[j] = *(const GAS f32x4*)(g2 + c);
            ta[j] = *(const GAS v2u*)(y0 + c); tb[j] = *(const GAS v2u*)(y1 + c); }
        float ss = 0.f;
#pragma unroll
        for (int j = 0; j < 8; ++j) { const int c = 4 * lane + 256 * j;
            f32x4 a = f32x4{bflo(ta[j].x), bfhi(ta[j].x), bflo(ta[j].y), bfhi(ta[j].y)}, bb = f32x4{bflo(tb[j].x), bfhi(tb[j].x), bflo(tb[j].y), bfhi(tb[j].y)};
            {
                const int s0 = __builtin_amdgcn_readlane((int)fl, j), s1 = __builtin_amdgcn_readlane((int)fl, 8 + j);
                if (s0) { a = *(const GAS f32x4*)(YMP + (size_t)sl0 * DM + c); for (int k = 1; k < s0; ++k) a += *(const GAS f32x4*)(YMP + ((size_t)k * MSLOT + sl0) * DM + c); }
                if (s1) { bb = *(const GAS f32x4*)(YMP + (size_t)sl1 * DM + c); for (int k = 1; k < s1; ++k) bb += *(const GAS f32x4*)(YMP + ((size_t)k * MSLOT + sl1) * DM + c); } }
            v[j] = v[j] + g[j] * (a * w0 + bb * w1);
            ss += (v[j].x * v[j].x + v[j].y * v[j].y) + (v[j].z * v[j].z + v[j].w * v[j].w); }
        const float r = 1.0f / sqrtf(wave_sum(ss) * (1.0f / DM) + EPS);
#pragma unroll
        for (int j = 0; j < 8; ++j) { const int c = 4 * lane + 256 * j;
            *(GAS f32x4*)(F.out + (size_t)row * DM + c) = v[j] * r * gn[j]; }
    }
}

#ifndef MK_N_LAUNCHES
#define MK_N_LAUNCHES 1
#endif
constexpr int NPH = 24;
__global__ void __launch_bounds__(NWAVES * 64, 2) hymba_fwd(Args args) {
    extern __shared__ __attribute__((aligned(16))) unsigned char lds[];
#define MKFRAME() Frame F; { int t_ = wave_s * 64 + lane_id(); asm volatile("" : "+v"(t_)); size_t wo_ = 0; asm volatile("" : "+s"(wo_)); unsigned char* w_ = (unsigned char*)(args.ws + wo_);     unsigned lb_ = 0; asm volatile("" : "+s"(lb_)); \
    F.lds = (LAS unsigned char*)lds + lb_; F.ldsg = lds + lb_; F.MISC = (volatile LAS unsigned*)(F.lds + MISC_OFF); \
    F.tid = t_; F.lane = t_ & 63; F.wave = __builtin_amdgcn_readfirstlane(t_ >> 6); \
    F.G = gridDim.x; { const int bx = blockIdx.x; F.vcu = (F.G % 8 == 0) ? (bx % 8) * (F.G / 8) + bx / 8 : bx; } \
    F.ws = w_; F.out = (float*)args.out; F.ctl = (gu32*)(w_ + WS_CTL); }
    const int wave_s = __builtin_amdgcn_readfirstlane((int)threadIdx.x >> 6);
    for (int u = threadIdx.x; u < (LDS_BYTES - LDSCTL_OFF) / 4; u += NWAVES * 64) ((LAS unsigned*)((LAS unsigned char*)lds + LDSCTL_OFF))[u] = 0u;
    __syncthreads();
    const int lo = args.ph_lo, hi = args.ph_hi;
    const bool multi = (hi - lo) > 1;
    XcdBarrier bar; bar.bar = (unsigned*)(unsigned char*)(args.ws + WS_CTL) + CW_BAR; bar.x = 0; bar.st = nullptr;
    bar.wave = wave_s;
    if (multi) { bar = xcd_barrier_post((unsigned*)(unsigned char*)(args.ws + WS_CTL) + CW_BAR, (volatile LAS unsigned*)((LAS unsigned char*)lds + MISC_OFF) + 8); bar.wave = wave_s; }
#define IN(k) (lo <= (k) && (k) < hi)
#ifndef PROBE_MASK
#define PROBE_MASK 0ull
#endif
#define REP(k) ((int)((PROBE_MASK >> (k)) & 1ull) + 1)
#ifndef TIME_WG
#define TIME_WG 0
#endif
#ifndef TIME_PH
#define TIME_PH (-1)
#endif
#ifndef TIME_MULT
#define TIME_MULT 10
#endif
#define TSTAMP(k, slot) do { if (TIME_PH == (k) && blockIdx.x == TIME_WG && wave_s == 0) { const unsigned long long c_ = wall_clock64(); volatile LAS unsigned* m_ = (volatile LAS unsigned*)((LAS unsigned char*)lds + MISC_OFF); \
    m_[40 + 2 * (slot)] = (unsigned)c_; m_[41 + 2 * (slot)] = (unsigned)(c_ >> 32); } } while (0)
#define SEAM(k) do { if (rep_ == REP(k) - 1 && IN((k) + 1)) xcd_barrier(bar); if (rep_ == REP(k) - 1) TSTAMP(k, 1); } while (0)

    if (IN(0)) for (int rep_ = 0; rep_ < REP(0); ++rep_) { TSTAMP(0, 0); { MKFRAME(); pro_cvt(F, args); } { MKFRAME(); pro_mod(F, args); } { MKFRAME(); pro_rope(F, args); } SEAM(0); }
    if (IN(1)) for (int rep_ = 0; rep_ < REP(1); ++rep_) { TSTAMP(1, 0); MKFRAME(); phase_pro_b(F, args); SEAM(1); }
#define LAYER_BODY(l) do { \
        const int pb = l ? 12 : 2; \
        if (IN(pb + 0)) for (int rep_ = 0; rep_ < REP(pb + 0); ++rep_) { TSTAMP(pb + 0, 0); MKFRAME(); phase_n1(F, args, l); SEAM(pb + 0); } \
        if (IN(pb + 1)) for (int rep_ = 0; rep_ < REP(pb + 1); ++rep_) { TSTAMP(pb + 1, 0); \
            MKFRAME(); \
            pg8::Gemm g{(const pg8::bf16_t*)(F.ws + WS_H), (const pg8::bf16_t*)(F.ws + WS_WIN) + (size_t)l * NINP * DM, MT, NINP, DM, wave_s, DM / 64, 127, 127}; \
            const bool g1s = (G1_SLACK > 0 && F.G == 256); const int gG = g1s ? 256 - G1_STREAM_WGS : F.G; \
            if ((int)blockIdx.x < gG) { \
                pg8::StaticOrder S; S.init(MT, NINP, gG, (int)blockIdx.x); \
                pg8::EpiBf16Plain E{(pg8::bf16_t*)(F.ws + WS_P), NINP}; \
                pg8::gemm_phase<pg8::EpiBf16Plain, pg8::StaticOrder, PG8_ALIGN, PG8_SP2>(F.lds, g, S, E); \
            } else cvt8_deferred(F, args, 2 * DEF_PER_PHASE + l * G1_SLACK, G1_SLACK, ((int)blockIdx.x - gG) * NWAVES + F.wave, G1_STREAM_WGS * NWAVES); \
            SEAM(pb + 1); \
        } \
        if (IN(pb + 2)) for (int rep_ = 0; rep_ < REP(pb + 2); ++rep_) { TSTAMP(pb + 2, 0); TSTAMP(121 + 100 * l, 0); { MKFRAME(); prep_rows(F, args, l); } TSTAMP(121 + 100 * l, 1); TSTAMP(122 + 100 * l, 0); { MKFRAME(); prep_cum(F, args, l); } TSTAMP(122 + 100 * l, 1); SEAM(pb + 2); } \
        if (IN(pb + 3)) for (int rep_ = 0; rep_ < REP(pb + 3); ++rep_) { TSTAMP(pb + 3, 0); TSTAMP(101 + 100 * l, 0); { MKFRAME(); mixa_d1(F); } TSTAMP(101 + 100 * l, 1); TSTAMP(102 + 100 * l, 0); if (l == 0) { MKFRAME(); mixa_ctx(F); } TSTAMP(102 + 100 * l, 1); TSTAMP(103 + 100 * l, 0); { MKFRAME(); mixa_na(F, args, l); } TSTAMP(103 + 100 * l, 1); TSTAMP(104 + 100 * l, 0); { MKFRAME(); mixa_sgu(F, args, l); } TSTAMP(104 + 100 * l, 1); SEAM(pb + 3); } \
        if (IN(pb + 4)) for (int rep_ = 0; rep_ < REP(pb + 4); ++rep_) { TSTAMP(pb + 4, 0); TSTAMP(131 + 100 * l, 0); { MKFRAME(); ssd_scan(F); } TSTAMP(131 + 100 * l, 1); TSTAMP(132 + 100 * l, 0); { MKFRAME(); mixb_attn(F, args, l); } TSTAMP(132 + 100 * l, 1); SEAM(pb + 4); } \
        if (IN(pb + 5)) for (int rep_ = 0; rep_ < REP(pb + 5); ++rep_) { TSTAMP(pb + 5, 0); TSTAMP(111 + 100 * l, 0); { MKFRAME(); merge_d3(F, args, l); } TSTAMP(111 + 100 * l, 1); TSTAMP(112 + 100 * l, 0); { MKFRAME(); merge_abc(F, args, l); } TSTAMP(112 + 100 * l, 1); if (l == 0) { MKFRAME(); merge_stream(F, args); } SEAM(pb + 5); } \
        if (IN(pb + 6)) for (int rep_ = 0; rep_ < REP(pb + 6); ++rep_) { TSTAMP(pb + 6, 0); \
            MKFRAME(); \
            pg8::Gemm g{(const pg8::bf16_t*)(F.ws + WS_OB), (const pg8::bf16_t*)(F.ws + WS_WOUT) + (size_t)l * DM * DM, ML, DM, DM, wave_s, DM / 64, 127, 127}; \
            pg8::StaticOrder S; S.init(ML, DM, F.G, (int)blockIdx.x); \
            const float* bL = l == 0 ? (const float*)args.in[I_X] : (const float*)(F.ws + WS_XB); \
            const float* bC = l == 0 ? (const float*)args.in[I_CTX] : (const float*)(F.ws + WS_XB) + (size_t)ML * DM; \
            pg8::EpiResGate E{bL, bC, (float*)(F.ws + WS_XA), (const float*)(F.ws + WS_MOD) + (size_t)l * 3 * MODW + 2 * DM}; \
            pg8::gemm_phase<pg8::EpiResGate, pg8::StaticOrder, PG8_ALIGN, PG8_SP2>(F.lds, g, S, E); \
            if (l == 0) { \
                pg8::Gemm g2{(const pg8::bf16_t*)(F.ws + WS_OB) + (size_t)ML * DM, (const pg8::bf16_t*)(F.ws + WS_WOUT), MC, DM, DM, wave_s, 8, 127, 127}; \
                pg8::SplitOrder S2; S2.init(2, 8, 4, 1024, F.G, (int)blockIdx.x); \
                pg8::EpiPart E2{(float*)(F.ws + WS_PARTW), MC}; \
                pg8::gemm_phase<pg8::EpiPart, pg8::SplitOrder, PG8_ALIGN, PG8_SP2>(F.lds, g2, S2, E2); \
                if (F.G == 256 && (int)blockIdx.x >= 64) cvt8_deferred(F, args, OFF_WO0, WO0_ITEMS, ((int)blockIdx.x - 64) * NWAVES + F.wave, 192 * NWAVES); \
            } \
            SEAM(pb + 6); \
        } \
        if (IN(pb + 7)) for (int rep_ = 0; rep_ < REP(pb + 7); ++rep_) { TSTAMP(pb + 7, 0); MKFRAME(); if (l == 0) phase_n2(F, args, 0); else phase_n2_route(F, args); SEAM(pb + 7); } \
        if (l == 0) { \
        if (IN(10)) for (int rep_ = 0; rep_ < REP(10); ++rep_) { TSTAMP(10, 0); \
            MKFRAME(); \
            pg8::Gemm g{(const pg8::bf16_t*)(F.ws + WS_H), (const pg8::bf16_t*)(F.ws + WS_W13), MT, 2 * DFF, DM, wave_s, DM / 64, 127, 127}; \
            pg8::StaticOrder S; S.init(MT, 2 * DFF, F.G, (int)blockIdx.x); \
            pg8::EpiSwiglu8 E{(unsigned char*)(F.ws + WS_ACT), DFF, 8.0f}; \
            pg8::gemm_phase<pg8::EpiSwiglu8, pg8::StaticOrder, PG8_ALIGN, PG8_SP2>(F.lds, g, S, E); \
            if (F.G == 256 && (int)blockIdx.x >= 216) cvt8_deferred(F, args, OFF_FF1, FF1_ITEMS, ((int)blockIdx.x - 216) * NWAVES + F.wave, 40 * NWAVES); \
            SEAM(10); \
        } \
        if (IN(11)) for (int rep_ = 0; rep_ < REP(11); ++rep_) { TSTAMP(11, 0); \
            MKFRAME(); \
            pg8::Gemm g{(const pg8::bf16_t*)(F.ws + WS_ACT), (const pg8::bf16_t*)(F.ws + WS_W2), ML, DM, DFF / 2, wave_s, DFF / 128, 121, 121}; \
            pg8::StaticOrder S; S.init(ML, DM, F.G, (int)blockIdx.x); \
            pg8::EpiResGate E{(const float*)(F.ws + WS_XA), (const float*)(F.ws + WS_XA) + (size_t)ML * DM, (float*)(F.ws + WS_XB), (const float*)(F.ws + WS_MOD) + 5 * DM}; \
            {     \
                pg8::Gemm g2{(const pg8::bf16_t*)(F.ws + WS_ACT + (size_t)ML * DFF), (const pg8::bf16_t*)(F.ws + WS_W2), MC, DM, DFF / 2, wave_s, 4, 121, 121}; \
                pg8::SplitOrder S2; S2.init(2, 8, 11, 512, F.G, (int)blockIdx.x); \
                pg8::EpiPart E2{(float*)(F.ws + WS_PARTF), MC}; \
                pg8::gemm_phase<pg8::EpiPart, pg8::SplitOrder, PG8_ALIGN, PG8_SP2, true>(F.lds, g2, S2, E2); \
            } \
            pg8::gemm_phase<pg8::EpiResGate, pg8::StaticOrder, PG8_ALIGN, PG8_SP2, true>(F.lds, g, S, E); \
            SEAM(11); \
        } \
        } \
     \
    } while (0)
    LAYER_BODY(0);
    LAYER_BODY(1);
#undef LAYER_BODY
    if (IN(20)) for (int rep_ = 0; rep_ < REP(20); ++rep_) { TSTAMP(20, 0); MKFRAME(); phase_gather(F); SEAM(20); }
    if (IN(21)) for (int rep_ = 0; rep_ < REP(21); ++rep_) { TSTAMP(21, 0);
        MKFRAME();
        moe_tiles(F);
        pg8::Gemm g{(const pg8::bf16_t*)(F.ws + WS_HS), (const pg8::bf16_t*)(F.ws + WS_WM13), MSLOT, 2 * DFE, DM / 2, wave_s, DM / 128, 122, 122};
        pg8::MoeOrder S; S.init(F.MISC + 16, (2 * DFE) / 256, F.G, (int)blockIdx.x);
        pg8::EpiSwiglu8 E{(unsigned char*)(F.ws + WS_ACTM), DFE, 8.0f};
        pg8::gemm_phase<pg8::EpiSwiglu8, pg8::MoeOrder, PG8_ALIGN, PG8_SP2, true>(F.lds, g, S, E);
        SEAM(21);
    }
    if (IN(22)) for (int rep_ = 0; rep_ < REP(22); ++rep_) { TSTAMP(22, 0);
        MKFRAME();
        moe_tiles(F);
        pg8::Gemm g{(const pg8::bf16_t*)(F.ws + WS_ACTM), (const pg8::bf16_t*)(F.ws + WS_WM2), MSLOT, DM, DFE / 2, wave_s, DFE / 128, 121, 121};
        pg8::MoeOrder S; S.init(F.MISC + 16, DM / 256, F.G, (int)blockIdx.x);
        const int whole = (S.nwg / F.G) * F.G, tail = S.nwg - whole; S.hi = whole;
        pg8::EpiBf16Plain E{(pg8::bf16_t*)(F.ws + WS_YM), DM};
        pg8::gemm_phase<pg8::EpiBf16Plain, pg8::MoeOrder, PG8_ALIGN, PG8_SP2, true>(F.lds, g, S, E);
        if (tail > 0) {
            const int sp = tail * 4 <= F.G ? 4 : (tail * 2 <= F.G ? 2 : 1);
            pg8::Gemm g2{(const pg8::bf16_t*)(F.ws + WS_ACTM), (const pg8::bf16_t*)(F.ws + WS_WM2), MSLOT, DM, DFE / 2, wave_s, (DFE / 128) / sp, 121, 121};
            pg8::MoeTailOrder S2; S2.M = S; S2.M.hi = S.nwg; S2.lo = whole; S2.S = sp; S2.kbytes = DFE / sp;
            pg8::EpiPartFlag E2{(float*)(F.ws + WS_YMP), (size_t)MSLOT * DM, (unsigned*)(F.ctl + CW_TAIL), (unsigned)sp};
            pg8::gemm_phase<pg8::EpiPartFlag, pg8::MoeTailOrder, PG8_ALIGN, PG8_SP2, true>(F.lds, g2, S2, E2);
        }
        SEAM(22);
    }
    if (IN(23)) for (int rep_ = 0; rep_ < REP(23); ++rep_) { TSTAMP(23, 0); { MKFRAME(); phase_final(F, args); } TSTAMP(23, 1); }
    if (TIME_PH >= 0 && blockIdx.x == TIME_WG && wave_s == 0) { volatile LAS unsigned* m_ = (volatile LAS unsigned*)((LAS unsigned char*)lds + MISC_OFF);
        const unsigned long long t0_ = ((unsigned long long)m_[41] << 32) | m_[40], t1_ = ((unsigned long long)m_[43] << 32) | m_[42];
        const unsigned long long span_ = (t1_ > t0_ ? t1_ - t0_ : 0ull) * TIME_MULT, s_ = wall_clock64();
        while (wall_clock64() - s_ < span_ && span_ < 400000000ull) __builtin_amdgcn_s_sleep(8); }
#undef IN
#undef MKFRAME
#undef SEAM
}

extern "C" void kernel_launch(void* const* d_in, const int* in_sizes, int n_in, void* d_out, int out_size, void* d_ws, size_t ws_size, hipStream_t stream) {
    static int grid = 0;
    if (grid == 0) {
        if (n_in != 28 || out_size != ML * DM || ws_size < WS_END) { fprintf(stderr, "kernel_launch: unexpected shapes: n_in %d out %d ws %zu (need %zu)\n", n_in, out_size, ws_size, (size_t)WS_END); grid = -1; return; }
        int dev = 0, cus = 0, per_cu = 0;
        if (hipGetDevice(&dev) != hipSuccess || hipDeviceGetAttribute(&cus, hipDeviceAttributeMultiprocessorCount, dev) != hipSuccess) { grid = -1; return; }
        if (hipFuncSetAttribute((const void*)hymba_fwd, hipFuncAttributeMaxDynamicSharedMemorySize, LDS_BYTES) != hipSuccess) { fprintf(stderr, "kernel_launch: hipFuncSetAttribute failed\n"); grid = -1; return; }
        if (hipOccupancyMaxActiveBlocksPerMultiprocessor(&per_cu, (const void*)hymba_fwd, NWAVES * 64, LDS_BYTES) != hipSuccess || per_cu < 1)
            fprintf(stderr, "kernel_launch: note: occupancy query reports %d workgroups per CU\n", per_cu);
        (void)hipGetLastError();
        grid = cus;
    }
    if (grid < 0) return;
    if (hipMemsetAsync((char*)d_ws + WS_CTL, 0, CTL_ZERO_BYTES, stream) != hipSuccess) { fprintf(stderr, "kernel_launch: memset failed\n"); return; }
    Args a{};
    for (int i = 0; i < 28; ++i) a.in[i] = (const GAS float*)d_in[i];
    a.out = (GAS float*)d_out; a.ws = (GAS unsigned char*)d_ws;
#if MK_N_LAUNCHES == 1
    a.ph_lo = 0; a.ph_hi = NPH;
    hipLaunchKernelGGL(hymba_fwd, dim3(grid), dim3(NWAVES * 64), LDS_BYTES, stream, a);
#else
    for (int ph = 0; ph < NPH; ++ph) {
        a.ph_lo = ph; a.ph_hi = ph + 1;
        hipLaunchKernelGGL(hymba_fwd, dim3(grid), dim3(NWAVES * 64), LDS_BYTES, stream, a);
    }
#endif
    const hipError_t le = hipPeekAtLastError();
    if (le != hipSuccess) fprintf(stderr, "kernel_launch: launch failed: %s\n", hipGetErrorName(le));
}
```
